# Optimizing an MI355X kernel written in HIP

```python
import math
import jax
import jax.numpy as jnp
from jax import lax
import numpy as np

D_MODEL = 1024
BATCH = 4
SEQ = 8192
DEPTH = 1

MOBA_HEADS = 8
MOBA_HEAD_DIM = 64
MOBA_BLOCK = 256
MOBA_TOPK = 3
MOBA_Q_CHUNK = 64
DIFF_HEADS = 4
DIFF_HEAD_DIM = 64
ATTN_Q_BLOCK = 128
ROPE_THETA = 10000.0
N_GROUPS = 4
EXPERTS_PER_GROUP = 8
N_EXPERTS = N_GROUPS * EXPERTS_PER_GROUP
EXPERT_TOPK = 2
D_EXPERT = 512
NORM_EPS = 1e-6
NEG_INF = -1e30
MOBA_WIDTH = MOBA_HEADS * MOBA_HEAD_DIM
DIFF_QK_WIDTH = DIFF_HEADS * 2 * DIFF_HEAD_DIM
DIFF_V_WIDTH = DIFF_HEADS * 2 * DIFF_HEAD_DIM
_SEGMENTS = (MOBA_WIDTH, MOBA_WIDTH, MOBA_WIDTH, DIFF_QK_WIDTH, DIFF_QK_WIDTH, DIFF_V_WIDTH, D_MODEL, D_MODEL)
IN_WIDTH = sum(_SEGMENTS)
IN_SPLITS = tuple(int(s) for s in np.cumsum(_SEGMENTS)[:-1])

kernel_name = 'hybrid_moba_diffattn_hmoe_adaln'


def rmsnorm(x, g):
    xf = x.astype(jnp.float32)
    y = xf * lax.rsqrt(jnp.mean(xf * xf, axis=-1, keepdims=True) + NORM_EPS)
    return (y * g.astype(jnp.float32)).astype(x.dtype)


def rope_tables(seq, dim):
    inv = 1.0 / (ROPE_THETA ** (jnp.arange(0, dim, 2, dtype=jnp.float32) / dim))
    ang = jnp.arange(seq, dtype=jnp.float32)[:, None] * inv[None, :]
    return jnp.cos(ang), jnp.sin(ang)


def apply_rope(x, cos, sin):
    xf = x.astype(jnp.float32)
    half = x.shape[-1] // 2
    x1, x2 = xf[..., :half], xf[..., half:]
    return jnp.concatenate([x1 * cos - x2 * sin, x2 * cos + x1 * sin], axis=-1).astype(x.dtype)


def to_heads(t, n, d):
    b, s = t.shape[:2]
    return t.reshape(b, s, n, d).transpose(0, 2, 1, 3)


def moba_attention(q, k, v):
    B, H, S, dh = q.shape
    nb = -(-S // MOBA_BLOCK)
    topk = min(MOBA_TOPK, nb)
    pad = nb * MOBA_BLOCK - S
    kp = jnp.pad(k, ((0, 0), (0, 0), (0, pad), (0, 0)))
    vp = jnp.pad(v, ((0, 0), (0, 0), (0, pad), (0, 0)))
    k_blocks = kp.reshape(B, H, nb, MOBA_BLOCK, dh)
    v_blocks = vp.reshape(B, H, nb, MOBA_BLOCK, dh)
    k_mean = jnp.mean(k_blocks.astype(jnp.float32), axis=3)
    scale = dh ** -0.5
    nc = S // MOBA_Q_CHUNK
    q_chunks = q.reshape(B, H, nc, MOBA_Q_CHUNK, dh).transpose(2, 0, 1, 3, 4)
    starts = jnp.arange(nc, dtype=jnp.int32) * MOBA_Q_CHUNK
    b_idx = jnp.arange(B)[:, None, None, None]
    h_idx = jnp.arange(H)[None, :, None, None]
    block_ids = jnp.arange(nb, dtype=jnp.int32)
    own_offsets = jnp.arange(MOBA_BLOCK, dtype=jnp.int32)

    def chunk(args):
        qb, start = args
        blk = start // MOBA_BLOCK
        qpos = start + jnp.arange(MOBA_Q_CHUNK, dtype=jnp.int32)
        gate = jnp.einsum('bhqd,bhnd->bhqn', qb.astype(jnp.float32), k_mean)
        gate = jnp.where(block_ids < blk, gate, NEG_INF)
        _, sel = lax.top_k(gate, topk)
        valid = sel < blk
        ks = k_blocks[b_idx, h_idx, sel]
        vs = v_blocks[b_idx, h_idx, sel]
        s_sel = jnp.einsum('bhqd,bhqjnd->bhqjn', qb, ks).astype(jnp.float32) * scale
        s_sel = jnp.where(valid[..., None], s_sel, NEG_INF)
        s_sel = s_sel.reshape(B, H, MOBA_Q_CHUNK, topk * MOBA_BLOCK)
        k_own = lax.dynamic_slice_in_dim(kp, blk * MOBA_BLOCK, MOBA_BLOCK, axis=2)
        v_own = lax.dynamic_slice_in_dim(vp, blk * MOBA_BLOCK, MOBA_BLOCK, axis=2)
        s_own = jnp.einsum('bhqd,bhnd->bhqn', qb, k_own).astype(jnp.float32) * scale
        kpos = blk * MOBA_BLOCK + own_offsets
        s_own = jnp.where(kpos[None, :] <= qpos[:, None], s_own, NEG_INF)
        p = jax.nn.softmax(jnp.concatenate([s_sel, s_own], axis=-1), axis=-1).astype(v.dtype)
        p_sel = p[..., :topk * MOBA_BLOCK].reshape(B, H, MOBA_Q_CHUNK, topk, MOBA_BLOCK)
        p_own = p[..., topk * MOBA_BLOCK:]
        return (jnp.einsum('bhqjn,bhqjnd->bhqd', p_sel, vs)
                + jnp.einsum('bhqn,bhnd->bhqd', p_own, v_own))

    out = lax.map(chunk, (q_chunks, starts))
    return out.transpose(1, 2, 0, 3, 4).reshape(B, H, S, dh)


def diff_attention(q, k, v, lam):
    B, H2, S, dk = q.shape
    H = H2 // 2
    scale = dk ** -0.5
    nq = S // ATTN_Q_BLOCK
    q_blocks = q.reshape(B, H2, nq, ATTN_Q_BLOCK, dk).transpose(2, 0, 1, 3, 4)
    starts = jnp.arange(nq, dtype=jnp.int32) * ATTN_Q_BLOCK
    kpos = jnp.arange(S, dtype=jnp.int32)

    def block(args):
        qb, start = args
        s = jnp.einsum('bhqd,bhkd->bhqk', qb, k).astype(jnp.float32) * scale
        qpos = start + jnp.arange(ATTN_Q_BLOCK, dtype=jnp.int32)
        s = jnp.where(kpos[None, :] <= qpos[:, None], s, NEG_INF)
        p = jax.nn.softmax(s, axis=-1).reshape(B, H, 2, ATTN_Q_BLOCK, S)
        a = (p[:, :, 0] - lam * p[:, :, 1]).astype(v.dtype)
        return jnp.einsum('bhqk,bhkd->bhqd', a, v)

    out = lax.map(block, (q_blocks, starts))
    return out.transpose(1, 2, 0, 3, 4).reshape(B, H, S, 2 * dk)


def hierarchical_moe(h, w_group, b_group, w_expert, b_expert, w_gate, w_up, w_down):
    B, S, D = h.shape
    t = h.reshape(B * S, D)
    T = t.shape[0]
    g_prob = jax.nn.softmax((t @ w_group).astype(jnp.float32) + b_group, axis=-1)
    g_w, g_idx = lax.top_k(g_prob, 1)
    e_logits = ((t @ w_expert).astype(jnp.float32) + b_expert).reshape(T, N_GROUPS, EXPERTS_PER_GROUP)
    e_in_group = jnp.take_along_axis(e_logits, g_idx[:, :, None], axis=1)[:, 0]
    e_prob = jax.nn.softmax(e_in_group, axis=-1)
    e_w, e_idx = lax.top_k(e_prob, EXPERT_TOPK)
    e_w = e_w / jnp.sum(e_w, axis=-1, keepdims=True)
    weights = (g_w * e_w).reshape(-1)
    expert = (g_idx * EXPERTS_PER_GROUP + e_idx).reshape(-1)
    order = jnp.argsort(expert)
    tok = order // EXPERT_TOPK
    xs = t[tok]
    sizes = jnp.bincount(expert, length=N_EXPERTS).astype(jnp.int32)
    hid = jax.nn.silu(lax.ragged_dot(xs, w_gate, sizes)) * lax.ragged_dot(xs, w_up, sizes)
    out = lax.ragged_dot(hid.astype(xs.dtype), w_down, sizes)
    out = out * weights[order][:, None].astype(out.dtype)
    y = jnp.zeros_like(t).at[tok].add(out.astype(t.dtype))
    return y.reshape(B, S, D)


def setup_inputs(seed: int = 0) -> dict:
    key = jax.random.key(seed)
    ks = jax.random.split(key, 24)
    D = D_MODEL

    def nrm(k, shape, scale):
        return jax.random.normal(k, shape, jnp.float32) * scale

    return {
        'x': nrm(ks[0], (BATCH, SEQ, D), 1.0),
        'c': nrm(ks[1], (BATCH, D), 1.0),
        'w_ada': nrm(ks[2], (DEPTH, D, 6 * D), 0.5 * D ** -0.5),
        'b_ada': nrm(ks[3], (DEPTH, 6 * D), 0.02),
        'norm1_g': 1.0 + nrm(ks[4], (DEPTH, D), 0.02),
        'w_in': nrm(ks[5], (DEPTH, D, IN_WIDTH), D ** -0.5),
        'lambda_q1': nrm(ks[6], (DEPTH, DIFF_HEAD_DIM), 0.1),
        'lambda_k1': nrm(ks[7], (DEPTH, DIFF_HEAD_DIM), 0.1),
        'lambda_q2': nrm(ks[8], (DEPTH, DIFF_HEAD_DIM), 0.1),
        'lambda_k2': nrm(ks[9], (DEPTH, DIFF_HEAD_DIM), 0.1),
        'diff_subln_g': 1.0 + nrm(ks[10], (DEPTH, 2 * DIFF_HEAD_DIM), 0.02),
        'w_proj_moba': nrm(ks[11], (DEPTH, MOBA_WIDTH, D), MOBA_WIDTH ** -0.5),
        'w_proj_diff': nrm(ks[12], (DEPTH, DIFF_V_WIDTH, D), DIFF_V_WIDTH ** -0.5),
        'w_out': nrm(ks[13], (DEPTH, D, D), D ** -0.5),
        'norm2_g': 1.0 + nrm(ks[14], (DEPTH, D), 0.02),
        'w_group': nrm(ks[15], (DEPTH, D, N_GROUPS), D ** -0.5),
        'b_group': nrm(ks[16], (DEPTH, N_GROUPS), 0.01),
        'w_expert': nrm(ks[17], (DEPTH, D, N_EXPERTS), D ** -0.5),
        'b_expert': nrm(ks[18], (DEPTH, N_EXPERTS), 0.01),
        'w_gate': nrm(ks[19], (DEPTH, N_EXPERTS, D, D_EXPERT), D ** -0.5),
        'w_up': nrm(ks[20], (DEPTH, N_EXPERTS, D, D_EXPERT), D ** -0.5),
        'w_down': nrm(ks[21], (DEPTH, N_EXPERTS, D_EXPERT, D), D_EXPERT ** -0.5),
        'final_g': 1.0 + nrm(ks[22], (D,), 0.02),
    }


def reference(x, c, w_ada, b_ada, norm1_g, w_in, lambda_q1, lambda_k1, lambda_q2, lambda_k2,
              diff_subln_g, w_proj_moba, w_proj_diff, w_out, norm2_g, w_group, b_group,
              w_expert, b_expert, w_gate, w_up, w_down, final_g):
    S = x.shape[1]
    cos_m, sin_m = rope_tables(S, MOBA_HEAD_DIM)
    cos_d, sin_d = rope_tables(S, DIFF_HEAD_DIM)
    c_act = jax.nn.silu(c)
    for l in range(DEPTH):
        mod = c_act @ w_ada[l] + b_ada[l]
        sh1, sc1, g1, sh2, sc2, g2 = jnp.split(mod, 6, axis=-1)

        h = rmsnorm(x, norm1_g[l]) * (1.0 + sc1[:, None, :]) + sh1[:, None, :]
        proj = h @ w_in[l]
        q_m, k_m, v_m, q_d, k_d, v_d, gate_m, gate_d = jnp.split(proj, IN_SPLITS, axis=-1)

        qm = apply_rope(to_heads(q_m, MOBA_HEADS, MOBA_HEAD_DIM), cos_m, sin_m)
        km = apply_rope(to_heads(k_m, MOBA_HEADS, MOBA_HEAD_DIM), cos_m, sin_m)
        vm = to_heads(v_m, MOBA_HEADS, MOBA_HEAD_DIM)
        o_m = moba_attention(qm, km, vm)
        y_m = o_m.transpose(0, 2, 1, 3).reshape(x.shape[0], S, MOBA_WIDTH) @ w_proj_moba[l]

        lam_init = 0.8 - 0.6 * math.exp(-0.3 * l)
        lam = (jnp.exp(jnp.sum(lambda_q1[l].astype(jnp.float32) * lambda_k1[l].astype(jnp.float32)))
               - jnp.exp(jnp.sum(lambda_q2[l].astype(jnp.float32) * lambda_k2[l].astype(jnp.float32)))
               + lam_init)
        qd = apply_rope(to_heads(q_d, 2 * DIFF_HEADS, DIFF_HEAD_DIM), cos_d, sin_d)
        kd = apply_rope(to_heads(k_d, 2 * DIFF_HEADS, DIFF_HEAD_DIM), cos_d, sin_d)
        vd = to_heads(v_d, DIFF_HEADS, 2 * DIFF_HEAD_DIM)
        o_d = diff_attention(qd, kd, vd, lam)
        o_d = rmsnorm(o_d, diff_subln_g[l]) * (1.0 - lam_init)
        y_d = o_d.transpose(0, 2, 1, 3).reshape(x.shape[0], S, DIFF_V_WIDTH) @ w_proj_diff[l]

        merged = jax.nn.sigmoid(gate_m) * y_m + jax.nn.sigmoid(gate_d) * y_d
        x = x + g1[:, None, :] * (merged @ w_out[l])

        h2 = rmsnorm(x, norm2_g[l]) * (1.0 + sc2[:, None, :]) + sh2[:, None, :]
        y_ffn = hierarchical_moe(h2, w_group[l], b_group[l], w_expert[l], b_expert[l],
                                 w_gate[l], w_up[l], w_down[l])
        x = x + g2[:, None, :] * y_ffn
    return rmsnorm(x, final_g)
```

```cpp
#include <hip/hip_runtime.h>
#include <cstdint>
#include <cstdio>

namespace {

constexpr int NB = 4, S = 8192, D = 1024, T = NB * S;
constexpr int INW = 5120;
constexpr float EPS = 1e-6f;
constexpr float C2 = 0.125f * 1.4426950408889634f;
constexpr size_t MiB = 1ull << 20;
constexpr size_t WS_CTL = 0;
constexpr size_t WS_MOD = 1 * MiB;
constexpr size_t WS_LAM = 1 * MiB + 128 * 1024;
constexpr size_t WS_OFF = 1 * MiB + 132 * 1024;
constexpr size_t WS_KSUM = 1 * MiB + 256 * 1024;
constexpr size_t WS_MODP = 2 * MiB;
constexpr size_t WS_WR = 3 * MiB;
constexpr size_t WS_ROPE = 4 * MiB;
constexpr size_t WS_WIN = 6 * MiB;
constexpr size_t WS_WPM = 16 * MiB, WS_WPD = 17 * MiB, WS_WOUT = 18 * MiB;
constexpr size_t WS_WGU = 20 * MiB;
constexpr size_t WS_WD = 84 * MiB;
constexpr size_t WS_XN = 116 * MiB;
constexpr size_t WS_QM = 180 * MiB, WS_KM = 212 * MiB, WS_VM = 244 * MiB, WS_QD = 276 * MiB, WS_KD = 308 * MiB, WS_VD = 340 * MiB;
constexpr size_t WS_GM = 372 * MiB, WS_GD = 436 * MiB;
constexpr size_t WS_LIST = 500 * MiB;
constexpr size_t WS_TOKI = 504 * MiB;
constexpr size_t WS_TOKW = 504 * MiB + 256 * 1024;
constexpr size_t WS_SEL = 505 * MiB;
constexpr size_t WS_ROWSQ = 506 * MiB;
constexpr size_t WS_MERGED = 212 * MiB;
constexpr size_t WS_HID = 372 * MiB;
constexpr size_t WS_YB = 180 * MiB;
constexpr int CW_QCNT = 8192;
constexpr size_t DO_MLP = 96 * MiB, DO_QLIST = 104 * MiB;
constexpr int QL_PER_BH = 126976;
constexpr int CW_CNT = 1024;


#define GAS __attribute__((address_space(1)))
#define LAS __attribute__((address_space(3)))
typedef unsigned short bf16;
typedef unsigned v4u __attribute__((ext_vector_type(4)));
typedef float f32x4 __attribute__((ext_vector_type(4)));
typedef short bf16x8 __attribute__((ext_vector_type(8)));
typedef GAS unsigned gu32;
typedef GAS unsigned long long gu64;
#define RLX_AGENT __ATOMIC_RELAXED, __HIP_MEMORY_SCOPE_AGENT
#define LDS_WAIT() asm volatile("s_waitcnt lgkmcnt(0)" ::: "memory")
#define VM_WAIT() asm volatile("s_waitcnt vmcnt(0)" ::: "memory")
__device__ __forceinline__ unsigned f2bf(float f) { unsigned u = __builtin_bit_cast(unsigned, f); return (u + 0x7fffu + ((u >> 16) & 1u)) >> 16; }
__device__ __forceinline__ unsigned pk2(float lo, float hi) { return f2bf(lo) | (f2bf(hi) << 16); }
__device__ __forceinline__ float bf2f(bf16 v) { return __uint_as_float((unsigned)v << 16); }
#define XB_TMO      128
#define XB_XCNT(j)  (256  + 64 * (j))
#define XB_XSUB(j)  (1280 + 64 * (j))
#define XB_XGEN(j)  (2304 + 64 * (j))
#define XB_TOP      3328
#define XB_TOPGEN   3392
#define XCD_BAR_WORDS 3456
#define XB_SPIN_CAP (1u << 18)

__device__ __forceinline__ unsigned xb_ld(unsigned* p)              { return __hip_atomic_load(p, __ATOMIC_RELAXED, __HIP_MEMORY_SCOPE_AGENT); }
__device__ __forceinline__ unsigned xb_add(unsigned* p, unsigned v) { return __hip_atomic_fetch_add(p, v, __ATOMIC_RELAXED, __HIP_MEMORY_SCOPE_AGENT); }
__device__ __forceinline__ unsigned xb_xcc_id() { return (unsigned)__builtin_amdgcn_s_getreg((3 << 11) | 20) & 0xFu; }
#define XB_SPIN(cond, bar) do { unsigned _sp = 0; while (cond) { __builtin_amdgcn_s_sleep(1); \
    if ((++_sp & 255u) == 0u) { if (xb_ld(&(bar)[XB_TMO])) break; if (_sp > XB_SPIN_CAP) { atomicAdd(&(bar)[XB_TMO], 1u); break; } } } } while (0)

struct XcdBarrier {
    unsigned* bar; unsigned x;
    volatile LAS unsigned* st;
};

__device__ __forceinline__ XcdBarrier xcd_barrier_post(unsigned* bar, volatile LAS unsigned* st) {
    XcdBarrier b; b.bar = bar; b.x = xb_xcc_id(); b.st = st;
    if (threadIdx.x == 0) (void)xb_add(&bar[XB_XCNT(b.x)], 1u);
    return b;
}
__device__ __forceinline__ void xcd_barrier_complete(unsigned* bar, unsigned x, unsigned& nloc, unsigned& nx) {
    const unsigned G = gridDim.x * gridDim.y * gridDim.z;
    unsigned sum, cnt, mine, sp = 0u;
    for (;;) {
        sum = 0u; cnt = 0u; mine = 0u;
#pragma unroll
        for (unsigned j = 0; j < 16; ++j) { const unsigned c = xb_ld(&bar[XB_XCNT(j)]); sum += c; cnt += (c > 0u) ? 1u : 0u; mine = (j == x) ? c : mine; }
        if (sum == G) break;
        __builtin_amdgcn_s_sleep(1);
        if ((++sp & 255u) == 0u) { if (xb_ld(&bar[XB_TMO])) break; if (sp > XB_SPIN_CAP) { atomicAdd(&bar[XB_TMO], 1u); break; } }
    }
    nloc = mine > 0u ? mine : 1u; nx = cnt > 0u ? cnt : 1u;
}

__device__ __forceinline__ void xcd_barrier(const XcdBarrier& b) {
    asm volatile("s_waitcnt vmcnt(0)" ::: "memory");
    __syncthreads();
    if (threadIdx.x == 0) {
        unsigned* bar = b.bar;
        __builtin_amdgcn_s_waitcnt(0);
        unsigned nloc = b.st[0], nx = b.st[1];
        if (nloc == 0u) { xcd_barrier_complete(bar, b.x, nloc, nx); b.st[0] = nloc; b.st[1] = nx; }
        const unsigned old = xb_add(&bar[XB_XSUB(b.x)], 1u);
        const unsigned gen = old / nloc;
        if (old + 1u == (gen + 1u) * nloc) {
            __builtin_amdgcn_fence(__ATOMIC_RELEASE, "agent");
            asm volatile("s_waitcnt vmcnt(0)" ::: "memory");
            const unsigned og = xb_add(&bar[XB_TOP], 1u);
            const unsigned tg = og / nx;
            if (og + 1u == (tg + 1u) * nx) xb_add(&bar[XB_TOPGEN], 1u);
            else XB_SPIN(xb_ld(&bar[XB_TOPGEN]) == tg, bar);
            __builtin_amdgcn_fence(__ATOMIC_ACQUIRE, "agent");
            xb_add(&bar[XB_XGEN(b.x)], 1u);
            asm volatile("s_waitcnt vmcnt(0)" ::: "memory");
        } else {
            XB_SPIN(xb_ld(&bar[XB_XGEN(b.x)]) == gen, bar);
            __builtin_amdgcn_fence(__ATOMIC_ACQUIRE, "agent");
            asm volatile("s_waitcnt vmcnt(0)" ::: "memory");
        }
    }
    __syncthreads();
}


namespace pg8 {
#define PG8_LAS __attribute__((address_space(3)))
typedef unsigned short bf16_t;
typedef short bf16x8 __attribute__((ext_vector_type(8)));
typedef float f32x4 __attribute__((ext_vector_type(4)));
typedef unsigned u32x4 __attribute__((ext_vector_type(4)));
constexpr int BM = 256, BK = 64, HALF = 128, HTB = HALF * BK * 2  , STAGE_BYTES = 8 * HTB, NXCD = 8, WGM = 8;

__host__ __device__ __forceinline__ int lds_byte(int r, int c) { const int st = (r >> 4) * 2 + (c >> 5), rr = r & 15, cc = c & 31, ob = rr * 64 + cc * 2; return st * 1024 + (ob ^ (((ob >> 9) & 1) << 5)); }
__host__ __device__ __forceinline__ void stage_rc(int b, int& R, int& C) { const int st = b / 1024, sb = b % 1024, swz = sb ^ (((sb >> 9) & 1) << 5); R = (st >> 1) * 16 + swz / 64; C = (st & 1) * 32 + (swz % 64) / 2; }
__host__ __device__ __forceinline__ int perm32(int rho) { const int n = rho >> 4, i = rho & 15; return 8 * (i >> 2) + 4 * n + (i & 3); }

struct Unit { int pm, pn, e, lo, cnt; };
struct Gemm { const bf16_t* A; const bf16_t* Bt; int K; };

struct StaticOrder {
    int nM, nN, nwg, G, c;
    __host__ __device__ void init(int M, int N, int G_, int c_) { nM = M / BM; nN = N / BM; nwg = nM * nN; G = G_; c = c_; }
    __host__ __device__ bool next(int i, Unit& u) const {
        const long L = (long)i * G + c; if (L >= nwg) return false;
        int wgid = (int)L; { const int q = nwg / NXCD, r = nwg % NXCD, xcd = wgid % NXCD, off = wgid / NXCD; wgid = (xcd < r ? xcd * (q + 1) : r * (q + 1) + (xcd - r) * q) + off; }
        const int nig = WGM * nN, gid = wgid / nig, fm = gid * WGM, gsz = (nM - fm) < WGM ? (nM - fm) : WGM;
        u.pm = fm + ((wgid % nig) % gsz); u.pn = (wgid % nig) / gsz; u.e = 0; u.lo = 0; u.cnt = BM; return true;
    }
    __device__ __forceinline__ int arow(int, const Unit& u, int r) const { return u.pm * BM + r; }
    __device__ __forceinline__ int brow(const Unit& u) const { return u.pn * BM; }
    __device__ __forceinline__ void a_ready(const Unit&) const {}
    __device__ __forceinline__ void done(const Unit&) const {}
};
typedef float f32x2_t __attribute__((ext_vector_type(2))); typedef __bf16 bf16x2_t __attribute__((ext_vector_type(2)));
__device__ __forceinline__ unsigned cvt_pk_bf16(float lo, float hi) { f32x2_t v = {lo, hi}; bf16x2_t b = __builtin_convertvector(v, bf16x2_t); return __builtin_bit_cast(unsigned, b); }
struct MoeOrder {
    const PG8_LAS int* tbl; const PG8_LAS int* rowtab; int ntile, nN, G, c, Nexp; bool gather;
    __device__ __forceinline__ bool next(int i, Unit& u) const {
        const int L = i * G + c; if (L >= ntile * nN) return false;
        const int mt = L / nN; int e = 0;
        while (tbl[e + 1] <= mt) ++e;
        u.pm = mt; u.pn = L - mt * nN; u.e = e; u.lo = (mt - tbl[e]) * BM; u.cnt = tbl[40 + e] - u.lo; return true;
    }
    __device__ __forceinline__ int arow(int ui, const Unit& u, int r) const { return gather ? rowtab[ui * BM + r] : u.pm * BM + r; }
    __device__ __forceinline__ int brow(const Unit& u) const { return u.e * Nexp + u.pn * BM; }
    __device__ __forceinline__ void a_ready(const Unit&) const {}
    __device__ __forceinline__ void done(const Unit&) const {}
};
__device__ __forceinline__ float fast_sigmoid(float v) { return __builtin_amdgcn_rcpf(1.f + __builtin_amdgcn_exp2f(-1.4426950408889634f * v)); }
__device__ __forceinline__ u32x4 pack8(const f32x4& a, const f32x4& b) { u32x4 w; w.x = cvt_pk_bf16(a[0], a[1]); w.y = cvt_pk_bf16(a[2], a[3]); w.z = cvt_pk_bf16(b[0], b[1]); w.w = cvt_pk_bf16(b[2], b[3]); return w; }
__device__ __forceinline__ f32x4 bflo(unsigned a, unsigned b) { return (f32x4){__uint_as_float(a << 16), __uint_as_float(a & 0xffff0000u), __uint_as_float(b << 16), __uint_as_float(b & 0xffff0000u)}; }

struct EpiInProj {
    static constexpr bool PERM = true, AFTER_DRAIN = false;
    bf16_t* qkv;
    bf16_t* gates;
    float* ksum;
    const float* tab;
    int Trows, Srows; float c2;
    __device__ __forceinline__ void operator()(const f32x4 (&acc)[2][2][4][2], const Unit& u, int wr, int wc, int fr, int fq) const {
        const int pn = u.pn; const int rw = u.pm * BM + wr * 64 + fr;
        if (pn >= 12) {
            bf16_t* base = gates + (size_t)((pn - 12) >> 2) * ((size_t)Trows * 1024) + ((pn - 12) & 3) * 256 + wc * 32 + 8 * fq;
#pragma unroll
            for (int ai = 0; ai < 2; ++ai)
#pragma unroll
                for (int m = 0; m < 4; ++m) { bf16_t* rowp = base + (size_t)(rw + ai * HALF + m * 16) * 1024;
#pragma unroll
                    for (int bj = 0; bj < 2; ++bj) { f32x4 v0 = acc[ai][bj][m][0], v1 = acc[ai][bj][m][1];
#pragma unroll
                        for (int j = 0; j < 4; ++j) { v0[j] = fast_sigmoid(v0[j]); v1[j] = fast_sigmoid(v1[j]); }
                        *(u32x4*)(rowp + bj * HALF) = pack8(v0, v1); } }
            return;
        }
        const int seg = pn >> 1, ts = pn & 1;
        bf16_t* base = qkv + (size_t)seg * ((size_t)Trows * 512);
        if (seg == 2 || seg == 5) {
            bf16_t* b2 = base + ts * 256 + wc * 32 + 8 * fq;
#pragma unroll
            for (int ai = 0; ai < 2; ++ai)
#pragma unroll
                for (int m = 0; m < 4; ++m) { bf16_t* rowp = b2 + (size_t)(rw + ai * HALF + m * 16) * 512;
#pragma unroll
                    for (int bj = 0; bj < 2; ++bj) *(u32x4*)(rowp + bj * HALF) = pack8(acc[ai][bj][m][0], acc[ai][bj][m][1]); }
            return;
        }
        const float sc = (seg == 0 || seg == 3) ? c2 : 1.f;
        const int colh = (ts * 4 + wc) * 64 + 8 * fq;
        f32x4 ks[2][2];
#pragma unroll
        for (int a = 0; a < 2; ++a)
#pragma unroll
            for (int n = 0; n < 2; ++n) ks[a][n] = (f32x4){0.f, 0.f, 0.f, 0.f};
#pragma unroll
        for (int ai = 0; ai < 2; ++ai)
#pragma unroll
            for (int m = 0; m < 4; ++m) {
                const int r = rw + ai * HALF + m * 16, pos = r & (Srows - 1);
                const f32x4* tp = (const f32x4*)(tab + (size_t)pos * 64 + 16 * fq);
                const f32x4 t0 = tp[0], t1 = tp[1], t2 = tp[2], t3 = tp[3];
                f32x4 olo[2], ohi[2];
#pragma unroll
                for (int n = 0; n < 2; ++n) {
                    const f32x4 ta = n ? t2 : t0, tb = n ? t3 : t1;
                    const f32x4 cs = (f32x4){ta[0], ta[2], tb[0], tb[2]}, sn = (f32x4){ta[1], ta[3], tb[1], tb[3]};
                    const f32x4 lo = acc[ai][0][m][n], hi = acc[ai][1][m][n];
                    olo[n] = lo * cs - hi * sn; ohi[n] = hi * cs + lo * sn;
                }
                if (seg == 1) { ks[0][0] += olo[0]; ks[0][1] += olo[1]; ks[1][0] += ohi[0]; ks[1][1] += ohi[1]; }
                bf16_t* rowp = base + (size_t)r * 512 + colh;
                *(u32x4*)(rowp) = pack8(olo[0] * sc, olo[1] * sc); *(u32x4*)(rowp + 32) = pack8(ohi[0] * sc, ohi[1] * sc);
            }
        if (seg == 1) {
#pragma unroll
            for (int a = 0; a < 2; ++a)
#pragma unroll
                for (int n = 0; n < 2; ++n)
#pragma unroll
                    for (int j = 0; j < 4; ++j) { float v = ks[a][n][j]; v += __shfl_xor(v, 1); v += __shfl_xor(v, 2); v += __shfl_xor(v, 4); v += __shfl_xor(v, 8); ks[a][n][j] = v; }
            if (fr == 0) { float* kp = ksum + ((size_t)(wr * 128 + u.pm)) * 512 + colh; *(f32x4*)(kp) = ks[0][0]; *(f32x4*)(kp + 4) = ks[0][1]; *(f32x4*)(kp + 32) = ks[1][0]; *(f32x4*)(kp + 36) = ks[1][1]; }
        }
    }
};
template <int PASS> struct EpiGate {
    static constexpr bool PERM = true, AFTER_DRAIN = false;
    const bf16_t* G; bf16_t* out;
    __device__ __forceinline__ void operator()(const f32x4 (&acc)[2][2][4][2], const Unit& u, int wr, int wc, int fr, int fq) const {
        const int rw = u.pm * BM + wr * 64 + fr, col0 = u.pn * BM + wc * 32 + 8 * fq;
#pragma unroll
        for (int ai = 0; ai < 2; ++ai)
#pragma unroll
            for (int m = 0; m < 4; ++m)
#pragma unroll
                for (int bj = 0; bj < 2; ++bj) { const size_t off = (size_t)(rw + ai * HALF + m * 16) * 1024 + col0 + bj * HALF;
                    const u32x4 g = *(const u32x4*)(G + off);
                    f32x4 v0 = acc[ai][bj][m][0] * bflo(g.x, g.y), v1 = acc[ai][bj][m][1] * bflo(g.z, g.w);
                    if (PASS == 1) { const u32x4 p = __builtin_nontemporal_load((const u32x4*)(out + off)); v0 += bflo(p.x, p.y); v1 += bflo(p.z, p.w); }
                    *(u32x4*)(out + off) = pack8(v0, v1); }
    }
};
struct EpiResid {
    static constexpr bool PERM = true, AFTER_DRAIN = false;
    const float* x; const float* g1; float* x1; float* rowsq; int Srows;
    __device__ __forceinline__ void operator()(const f32x4 (&acc)[2][2][4][2], const Unit& u, int wr, int wc, int fr, int fq) const {
        const int rw = u.pm * BM + wr * 64 + fr, col0 = u.pn * BM + wc * 32 + 8 * fq, b = (u.pm * BM) / Srows;
        f32x4 gv[2][2];
#pragma unroll
        for (int bj = 0; bj < 2; ++bj)
#pragma unroll
            for (int n = 0; n < 2; ++n) gv[bj][n] = *(const f32x4*)(g1 + (size_t)b * 6144 + col0 + bj * HALF + n * 4);
#pragma unroll
        for (int ai = 0; ai < 2; ++ai)
#pragma unroll
            for (int m = 0; m < 4; ++m) { const int r = rw + ai * HALF + m * 16; const size_t off = (size_t)r * 1024 + col0; float s = 0.f;
#pragma unroll
                for (int bj = 0; bj < 2; ++bj)
#pragma unroll
                    for (int n = 0; n < 2; ++n) { const f32x4 xv = *(const f32x4*)(x + off + bj * HALF + n * 4); const f32x4 o = xv + gv[bj][n] * acc[ai][bj][m][n];
                        *(f32x4*)(x1 + off + bj * HALF + n * 4) = o; s += (o[0] * o[0] + o[1] * o[1]) + (o[2] * o[2] + o[3] * o[3]); }
                s += __shfl_xor(s, 16); s += __shfl_xor(s, 32);
                if (fq == 0) rowsq[(size_t)r * 16 + u.pn * 4 + wc] = s; }
    }
};
struct EpiMoeHid {
    static constexpr bool PERM = true, AFTER_DRAIN = false;
    bf16_t* hid;
    __device__ __forceinline__ void operator()(const f32x4 (&acc)[2][2][4][2], const Unit& u, int wr, int wc, int fr, int fq) const {
        const int rw = u.pm * BM + wr * 64 + fr, col0 = u.pn * 128 + wc * 32 + 8 * fq;
#pragma unroll
        for (int ai = 0; ai < 2; ++ai)
#pragma unroll
            for (int m = 0; m < 4; ++m) { f32x4 h[2];
#pragma unroll
                for (int n = 0; n < 2; ++n) { const f32x4 g = acc[ai][0][m][n], up = acc[ai][1][m][n];
#pragma unroll
                    for (int j = 0; j < 4; ++j) h[n][j] = g[j] * fast_sigmoid(g[j]) * up[j]; }
                *(u32x4*)(hid + (size_t)(rw + ai * HALF + m * 16) * 512 + col0) = pack8(h[0], h[1]); }
    }
};
struct EpiMoeDown {
    static constexpr bool PERM = true, AFTER_DRAIN = false;
    bf16_t* Yb; const int* list; const float* tokw; int Trows;
    __device__ __forceinline__ void operator()(const f32x4 (&acc)[2][2][4][2], const Unit& u, int wr, int wc, int fr, int fq) const {
        const int rl = wr * 64 + fr, col0 = u.pn * BM + wc * 32 + 8 * fq;
#pragma unroll
        for (int ai = 0; ai < 2; ++ai)
#pragma unroll
            for (int m = 0; m < 4; ++m) { const int rr = rl + ai * HALF + m * 16;
                float w = 0.f; if (rr < u.cnt) w = tokw[list[(size_t)u.e * Trows + u.lo + rr]];
                bf16_t* rowp = Yb + (size_t)(u.pm * BM + rr) * 1024 + col0;
#pragma unroll
                for (int bj = 0; bj < 2; ++bj) *(u32x4*)(rowp + bj * HALF) = pack8(acc[ai][bj][m][0] * w, acc[ai][bj][m][1] * w); }
    }
};
template <class Epi, class Sched, bool ALIGN_EPI = false, bool SP2 = false>
__device__ __forceinline__ void gemm_phase(PG8_LAS unsigned char* lds, const Gemm g, const Sched& S, const Epi& E) {
    const int tid = threadIdx.x, wid = __builtin_amdgcn_readfirstlane(tid >> 6), lane = tid & 63, wr = wid >> 2, wc = wid & 3, fr = lane & 15, fq = lane >> 4;
    const int K = g.K, nt = K / BK;
    unsigned voffB[2], CA2[2]; int RA[2];
#pragma unroll
    for (int i = 0; i < 2; ++i) { int R, C; stage_rc(tid * 16 + i * 8192, R, C); const int Rb = Epi::PERM ? ((R & ~31) + perm32(R & 31)) : R;
        RA[i] = R; CA2[i] = (unsigned)C * 2u; voffB[i] = (unsigned)(Rb * K + C) * 2u; }
    const unsigned K2 = (unsigned)K * 2u;
    const size_t kstep = (size_t)(BK * 2);
    const size_t hstep = (size_t)HALF * K * 2;
    const unsigned ldsw = (unsigned)wid * 1024u;
    const int aoff = lds_byte(wr * 64 + fr, fq * 8), boff = lds_byte(wc * 32 + fr, fq * 8);
#define PG8_SA(b, h) (((b) * 2 + (h)) * HTB)
#define PG8_SB(b, h) ((4 + (b) * 2 + (h)) * HTB)
#define PG8_STAGE(bufoff, gbase, voff) do { _Pragma("unroll") for (int _i = 0; _i < 2; ++_i) \
        __builtin_amdgcn_global_load_lds((const unsigned*)((const char*)(gbase) + (voff)[_i]), (PG8_LAS unsigned*)(lds + (bufoff) + ldsw + _i * 8192), 16, 0, 0); } while (0)
#define PG8_LDA(dst, b, h) do { _Pragma("unroll") for (int m = 0; m < 4; ++m) _Pragma("unroll") for (int k = 0; k < 2; ++k) dst[m][k] = *(const PG8_LAS bf16x8*)(lds + PG8_SA(b, h) + aoff + m * 2048 + k * 1024); } while (0)
#define PG8_LDB(dst, b, h) do { _Pragma("unroll") for (int n = 0; n < 2; ++n) _Pragma("unroll") for (int k = 0; k < 2; ++k) dst[n][k] = *(const PG8_LAS bf16x8*)(lds + PG8_SB(b, h) + boff + n * 2048 + k * 1024); } while (0)
#define PG8_MMA(ai, bj, At, Bt) do { __builtin_amdgcn_s_setprio(1); _Pragma("unroll") for (int m = 0; m < 4; ++m) _Pragma("unroll") for (int n = 0; n < 2; ++n) _Pragma("unroll") for (int k = 0; k < 2; ++k) \
        acc[ai][bj][m][n] = __builtin_amdgcn_mfma_f32_16x16x32_bf16(Bt[n][k], At[m][k], acc[ai][bj][m][n], 0, 0, 0); __builtin_amdgcn_s_setprio(0); } while (0)
#define PG8_WAIT_V(n) asm volatile("s_waitcnt vmcnt(" #n ")" ::: "memory")
#define PG8_WAIT_L(n) asm volatile("s_waitcnt lgkmcnt(" #n ")" ::: "memory")
#define PG8_BAR __builtin_amdgcn_s_barrier()
#define PG8_SCHED __builtin_amdgcn_sched_barrier(0)
    Unit cur, nxt; int ui = 0;
    if (!S.next(0, cur)) return;
    f32x4 acc[2][2][4][2];
#pragma unroll
    for (int a = 0; a < 2; ++a)
#pragma unroll
        for (int b = 0; b < 2; ++b)
#pragma unroll
            for (int m = 0; m < 4; ++m)
#pragma unroll
                for (int n = 0; n < 2; ++n) acc[a][b][m][n] = (f32x4){0.f, 0.f, 0.f, 0.f};
    bf16x8 At[4][2], B0[2][2], B1[2][2];
    unsigned vA0[2], vA1[2], nA0[2], nA1[2];
#pragma unroll
    for (int i = 0; i < 2; ++i) { vA0[i] = (unsigned)S.arow(0, cur, RA[i]) * K2 + CA2[i]; vA1[i] = (unsigned)S.arow(0, cur, HALF + RA[i]) * K2 + CA2[i]; }
    const char* const gA = (const char*)g.A; const char* cB = (const char*)g.Bt + (size_t)S.brow(cur) * K2;
    S.a_ready(cur);
    if constexpr (SP2) {
        PG8_STAGE(PG8_SB(0, 0), cB, voffB); PG8_STAGE(PG8_SB(0, 1), cB + hstep, voffB); PG8_STAGE(PG8_SA(0, 0), gA, vA0); PG8_STAGE(PG8_SA(0, 1), gA, vA1);
        if (wr == 1) PG8_BAR;
        PG8_WAIT_V(2); PG8_BAR;
        PG8_STAGE(PG8_SB(1, 0), cB + kstep, voffB); PG8_STAGE(PG8_SA(1, 0), gA + kstep, vA0); PG8_STAGE(PG8_SB(1, 1), cB + hstep + kstep, voffB);
        PG8_WAIT_V(6); PG8_BAR;
    } else {
        PG8_STAGE(PG8_SB(0, 0), cB, voffB); PG8_STAGE(PG8_SA(0, 0), gA, vA0); PG8_STAGE(PG8_SB(0, 1), cB + hstep, voffB); PG8_STAGE(PG8_SA(0, 1), gA, vA1);
        if (wr == 1) PG8_BAR;
        PG8_WAIT_V(4); PG8_BAR;
        PG8_STAGE(PG8_SB(1, 0), cB + kstep, voffB); PG8_STAGE(PG8_SA(1, 0), gA + kstep, vA0); PG8_STAGE(PG8_SB(1, 1), cB + hstep + kstep, voffB);
        PG8_WAIT_V(6); PG8_BAR;
    }
    for (;;) {
        const bool has_next = S.next(ui + 1, nxt);
#pragma unroll
        for (int i = 0; i < 2; ++i) { nA0[i] = has_next ? (unsigned)S.arow(ui + 1, nxt, RA[i]) * K2 + CA2[i] : vA0[i]; nA1[i] = has_next ? (unsigned)S.arow(ui + 1, nxt, HALF + RA[i]) * K2 + CA2[i] : vA1[i]; }
        const char* nB = has_next ? (const char*)g.Bt + (size_t)S.brow(nxt) * K2 : cB;
        for (int t = 0; t < nt; t += 2) {
            const bool last = (t == nt - 2);
            const char* a1 = gA + (size_t)(t + 1) * kstep;
            const char* a2 = last ? gA : gA + (size_t)(t + 2) * kstep; const unsigned x0[2] = {last ? nA0[0] : vA0[0], last ? nA0[1] : vA0[1]}, x1[2] = {last ? nA1[0] : vA1[0], last ? nA1[1] : vA1[1]}; const char* b2 = last ? nB : cB + (size_t)(t + 2) * kstep;
            const char* a3 = a2 + kstep; const char* b3 = b2 + kstep;
            if (last && has_next) S.a_ready(nxt);
            if constexpr (SP2) {
            PG8_LDB(B0, 0, 0); PG8_LDB(B1, 0, 1); PG8_SCHED; PG8_LDA(At, 0, 0); PG8_STAGE(PG8_SA(1, 1), a1, vA1);
            PG8_WAIT_V(8); PG8_WAIT_L(0); PG8_BAR; PG8_MMA(0, 0, At, B0); PG8_MMA(0, 1, At, B1); PG8_BAR; PG8_SCHED;
            PG8_LDA(At, 0, 1); PG8_STAGE(PG8_SB(0, 0), b2, voffB); PG8_STAGE(PG8_SB(0, 1), b2 + hstep, voffB); PG8_STAGE(PG8_SA(0, 0), a2, x0);
            PG8_WAIT_V(8); PG8_WAIT_L(0); PG8_BAR; PG8_MMA(1, 0, At, B0); PG8_MMA(1, 1, At, B1); PG8_BAR; PG8_SCHED;
            PG8_LDB(B0, 1, 0); PG8_LDB(B1, 1, 1); PG8_SCHED; PG8_LDA(At, 1, 0); PG8_STAGE(PG8_SA(0, 1), a2, x1);
            PG8_WAIT_V(8); PG8_WAIT_L(0); PG8_BAR; PG8_MMA(0, 0, At, B0); PG8_MMA(0, 1, At, B1); PG8_BAR; PG8_SCHED;
            PG8_LDA(At, 1, 1); PG8_STAGE(PG8_SB(1, 0), b3, voffB); PG8_STAGE(PG8_SB(1, 1), b3 + hstep, voffB); PG8_STAGE(PG8_SA(1, 0), a3, x0);
            PG8_WAIT_V(8); PG8_WAIT_L(0); PG8_BAR; PG8_MMA(1, 0, At, B0); PG8_MMA(1, 1, At, B1); PG8_BAR; PG8_SCHED;
            } else {
            PG8_LDB(B0, 0, 0); PG8_SCHED; PG8_LDA(At, 0, 0); PG8_STAGE(PG8_SA(1, 1), a1, vA1);
            PG8_WAIT_L(8); PG8_BAR; PG8_WAIT_L(0); PG8_MMA(0, 0, At, B0); PG8_BAR; PG8_SCHED;
            PG8_LDB(B1, 0, 1); PG8_STAGE(PG8_SB(0, 0), b2, voffB);
            PG8_BAR; PG8_WAIT_L(0); PG8_MMA(0, 1, At, B1); PG8_BAR;
            PG8_LDA(At, 0, 1); PG8_STAGE(PG8_SA(0, 0), a2, x0);
            PG8_BAR; PG8_WAIT_L(0); PG8_MMA(1, 0, At, B0); PG8_BAR; PG8_SCHED;
            PG8_STAGE(PG8_SB(0, 1), b2 + hstep, voffB);
            PG8_WAIT_V(6); PG8_BAR; PG8_MMA(1, 1, At, B1); PG8_BAR;
            PG8_LDB(B0, 1, 0); PG8_SCHED; PG8_LDA(At, 1, 0); PG8_STAGE(PG8_SA(0, 1), a2, x1);
            PG8_WAIT_L(8); PG8_BAR; PG8_WAIT_L(0); PG8_MMA(0, 0, At, B0); PG8_BAR; PG8_SCHED;
            PG8_LDB(B1, 1, 1); PG8_STAGE(PG8_SB(1, 0), b3, voffB);
            PG8_BAR; PG8_WAIT_L(0); PG8_MMA(0, 1, At, B1); PG8_BAR;
            PG8_LDA(At, 1, 1); PG8_STAGE(PG8_SA(1, 0), a3, x0);
            PG8_BAR; PG8_WAIT_L(0); PG8_MMA(1, 0, At, B0); PG8_BAR; PG8_SCHED;
            PG8_STAGE(PG8_SB(1, 1), b3 + hstep, voffB);
            PG8_WAIT_V(6); PG8_BAR; PG8_MMA(1, 1, At, B1); PG8_BAR;
            }
        }
        if constexpr (ALIGN_EPI) { if (wr == 0) PG8_BAR; }
        if constexpr (!Epi::AFTER_DRAIN) { E(acc, cur, wr, wc, fr, fq); S.done(cur); }
        if (!has_next) break;
#pragma unroll
        for (int a = 0; a < 2; ++a)
#pragma unroll
            for (int b = 0; b < 2; ++b)
#pragma unroll
                for (int m = 0; m < 4; ++m)
#pragma unroll
                    for (int n = 0; n < 2; ++n) acc[a][b][m][n] = (f32x4){0.f, 0.f, 0.f, 0.f};
        cur = nxt; cB = nB; ++ui;
#pragma unroll
        for (int i = 0; i < 2; ++i) { vA0[i] = nA0[i]; vA1[i] = nA1[i]; }
        if constexpr (ALIGN_EPI) { if (wr == 1) PG8_BAR; }
    }
    PG8_WAIT_V(0);
    if constexpr (!ALIGN_EPI) { if (wr == 0) PG8_BAR; }
    PG8_BAR;
    if constexpr (Epi::AFTER_DRAIN) { E.fused(acc, cur, wr, wc, fr, fq, lds, wid, lane); S.done(cur); }
#undef PG8_SA
#undef PG8_SB
#undef PG8_STAGE
#undef PG8_LDA
#undef PG8_LDB
#undef PG8_MMA
#undef PG8_WAIT_V
#undef PG8_WAIT_L
#undef PG8_BAR
#undef PG8_SCHED
}


}
namespace att {
typedef float f32x16 __attribute__((ext_vector_type(16)));
typedef short s16x4 __attribute__((ext_vector_type(4)));
typedef short v4i16_t __attribute__((ext_vector_type(4)));
typedef unsigned u32x4a __attribute__((ext_vector_type(4)));
constexpr int PITCH = 512;
constexpr int LDS_K = 0, LDS_V = 24576, LDS_WS = LDS_V + 4 * 16384, LDS_OST = LDS_WS + 2048, LDS_WT = LDS_OST + 8 * 4096, LDS_TOTAL = LDS_WT + 8 * 512, RES_V = 32768;
constexpr float THR = 5.0f;
__device__ __forceinline__ int crow(int r, int hi) { return (r & 3) + 8 * (r >> 2) + 4 * hi; }
__device__ __forceinline__ void glds16(const void* gsrc, unsigned lds_dst) { unsigned keep;
    asm volatile("s_mov_b32 %0, m0\n\ts_mov_b32 m0, %2\n\ts_nop 0\n\tglobal_load_lds_dwordx4 %1, off\n\ts_mov_b32 m0, %0" : "=&s"(keep) : "v"(gsrc), "s"(lds_dst) : "memory"); }
__device__ __forceinline__ f32x16 splat(float x) { f32x16 v;
#pragma unroll
    for (int r = 0; r < 16; ++r) v[r] = x;
    return v; }
typedef __attribute__((address_space(3))) const char* lds_cptr;
__device__ __forceinline__ s16x4 vtr(lds_cptr p) { return __builtin_bit_cast(s16x4, __builtin_amdgcn_ds_read_tr16_b64_v4i16((__attribute__((address_space(3))) v4i16_t*)p)); }
__device__ __forceinline__ float swapmax(float m) { auto rr = __builtin_amdgcn_permlane32_swap(__float_as_uint(m), __float_as_uint(m), false, false); return fmaxf(__uint_as_float(rr[0]), __uint_as_float(rr[1])); }
__device__ __forceinline__ float swapsum(float m) { auto rr = __builtin_amdgcn_permlane32_swap(__float_as_uint(m), __float_as_uint(m), false, false); return __uint_as_float(rr[0]) + __uint_as_float(rr[1]); }
__device__ __forceinline__ float max3a(float a, float b, float c) { float r; asm("v_max3_f32 %0, %1, %2, %3" : "=v"(r) : "v"(a), "v"(b), "v"(c)); return r; }
#define ATT_WAITBAR(N) asm volatile("s_waitcnt vmcnt(" #N ") lgkmcnt(0)\n\ts_barrier" ::: "memory")

template <int DV, int MODE, bool RES = false>
__device__ __forceinline__ void attn_unit(const int b, const int h, const int qb, const bf16* Qp, const bf16* __restrict__ Kp, const bf16* __restrict__ Vp, bf16* Op,
                                          const unsigned* __restrict__ sel, float* o1scr, const float lam, const float* __restrict__ subg, char* shm,
                                          const unsigned short* __restrict__ ql = nullptr, const int nvalid = 0, bf16* opart = nullptr, float* mlp = nullptr) {
    constexpr bool MOBA = (MODE != 1);
    constexpr int ND = DV / 32;
    const int tid = threadIdx.x, lane = tid & 63, r32 = lane & 31, hi = lane >> 5;
    const int wid = __builtin_amdgcn_readfirstlane(tid >> 6);
    const long rowbase = (long)b * S; const int q0 = qb * 256;
    const unsigned lds0 = (unsigned)(uintptr_t)shm;
    float* wsf = (float*)(shm + LDS_WS) + wid * 64;
    const lds_cptr shm3 = (lds_cptr)shm;
    const int NT = (MODE == 3 && RES) ? (wid >> 1) + 1 : ((MODE >= 2) ? 4 : 4 * (qb + 1));
    const int wbase = (RES && MODE == 2) ? 0 : wid * 32;
    const int qrel = wbase + r32;
#pragma unroll 1
    for (int comp = 0; comp < (MOBA ? 1 : 2); ++comp) {
        const int qkcol = MOBA ? h * 64 : (2 * h + comp) * 64, vcol = MOBA ? h * 64 : h * 128;
        const bf16* Kh = Kp + rowbase * PITCH + qkcol; const bf16* Vh = Vp + rowbase * PITCH + vcol;
        const bf16* ksrc = Kh + (long)lane * PITCH + wid * 8;
        const bf16* vsrc = Vh + (long)(16 * (wid & 3) + (lane >> 2)) * PITCH + (wid >> 2) * 32 + (lane & 3) * 8;
        const unsigned kdst = lds0 + LDS_K + wid * 1024, vdst = lds0 + LDS_V + wid * 1024;
#define ATT_KR0(n) (MODE == 2 ? q0 + 64 * (n) : ((n) < 4 ? q0 + 64 * (n) : 64 * ((n) - 4)))
#define ATT_DMA(n, ks_, vs_) do { const long kr_ = ATT_KR0(n); glds16(ksrc + kr_ * PITCH, (unsigned)__builtin_amdgcn_readfirstlane(kdst + (ks_) * 8192)); \
        glds16(vsrc + kr_ * PITCH, (unsigned)__builtin_amdgcn_readfirstlane(vdst + (vs_) * 16384)); \
        if (DV == 128) glds16(vsrc + kr_ * PITCH + 64, (unsigned)__builtin_amdgcn_readfirstlane(vdst + (vs_) * 16384 + 8192)); } while (0)
        if (!RES) { ATT_DMA(0, 0, 0); ATT_DMA(1, 1, 1); }
        int qi = q0 + qrel;
        if (MODE == 2) qi = (int)ql[qrel < nvalid ? qrel : 0];
        const bf16* Qw = Qp + (rowbase + qi) * PITCH + qkcol;
        bf16x8 qr[4];
#pragma unroll
        for (int d0 = 0; d0 < 4; ++d0) qr[d0] = *reinterpret_cast<const bf16x8*>(&Qw[d0 * 16 + hi * 8]);
        float mref = 0.f;
        f32x16 ol = splat(0.f);
        const bf16x8 ones = (bf16x8){0x3F80, 0x3F80, 0x3F80, 0x3F80, 0x3F80, 0x3F80, 0x3F80, 0x3F80};
        f32x16 o[ND];
#pragma unroll
        for (int d = 0; d < ND; ++d) o[d] = splat(0.f);
        int slot = 0, vslot = 0;
        u32x4a pw[4];
        constexpr int NPV = 4 * ND, NM = 4 + NPV;
        const int vlane = ((lane >> 4) & 1) * 32 + (lane & 3) * 8 + (4 * hi + ((lane & 15) >> 2)) * 64;
#define ATT_KLD(d0) do { kf[2 * (d0)] = *(const __attribute__((address_space(3))) bf16x8*)(kb + (d0) * 2048); kf[2 * (d0) + 1] = *(const __attribute__((address_space(3))) bf16x8*)(kb + (d0) * 2048 + 512); } while (0)
#define ATT_QK(P0, P1) do { const lds_cptr kb = shm3 + LDS_K + slot * 8192 + hi * 1024 + r32 * 16; bf16x8 kf[8]; \
        ATT_KLD(0); ATT_KLD(1); if (DV == 64) { ATT_KLD(2); ATT_KLD(3); } \
        const f32x16 cop = splat(-mref); __builtin_amdgcn_sched_barrier(0);   \
        P0 = __builtin_amdgcn_mfma_f32_32x32x16_bf16(kf[0], qr[0], cop, 0, 0, 0); P1 = __builtin_amdgcn_mfma_f32_32x32x16_bf16(kf[1], qr[0], cop, 0, 0, 0); \
        if (DV == 128) { ATT_KLD(2); ATT_KLD(3); __builtin_amdgcn_sched_barrier(0); } \
        _Pragma("unroll") for (int d0 = 1; d0 < 4; ++d0) { P0 = __builtin_amdgcn_mfma_f32_32x32x16_bf16(kf[2 * d0], qr[d0], P0, 0, 0, 0); P1 = __builtin_amdgcn_mfma_f32_32x32x16_bf16(kf[2 * d0 + 1], qr[d0], P1, 0, 0, 0); } } while (0)
#define ATT_MASK(P0, P1, n) do { if (MODE != 2 && (n) < 4 && (64 * (n) + 63 > wid * 32)) { const int kb0 = 64 * (n) + 4 * hi; \
        _Pragma("unroll") for (int r = 0; r < 16; ++r) { const int kv = kb0 + (r & 3) + 8 * (r >> 2); if (kv > qrel) P0[r] = -INFINITY; if (kv + 32 > qrel) P1[r] = -INFINITY; } } } while (0)
#define ATT_ROWMAX(P0, P1, RM) do { asm volatile("s_nop 15\n\ts_nop 7" : "+v"(P0), "+v"(P1)); \
        float a_ = max3a(P0[0], P0[1], P1[0]), b_ = max3a(P0[2], P0[3], P1[1]); a_ = max3a(a_, P1[2], P1[3]); \
        _Pragma("unroll") for (int r = 4; r < 16; r += 4) { a_ = max3a(a_, P0[r], P0[r + 1]); b_ = max3a(b_, P0[r + 2], P0[r + 3]); a_ = max3a(a_, P1[r], P1[r + 1]); b_ = max3a(b_, P1[r + 2], P1[r + 3]); } \
        RM = swapmax(fmaxf(a_, b_)); } while (0)
#define ATT_VOFF(j) (((j) >> 2) * 4096 + ((j) & 3) * 1024)
        { if (!RES) { if (DV == 128) ATT_WAITBAR(3); else ATT_WAITBAR(2); ATT_DMA(2, 2, 2); }
          f32x16 p0, p1; ATT_QK(p0, p1); ATT_MASK(p0, p1, 0);
          float rm; ATT_ROWMAX(p0, p1, rm); mref = rm;
#pragma unroll
          for (int r = 0; r < 16; ++r) { p0[r] = __builtin_amdgcn_exp2f(p0[r] - rm); p1[r] = __builtin_amdgcn_exp2f(p1[r] - rm); }
#pragma unroll
          for (int k = 0; k < 2; ++k)
#pragma unroll
              for (int j = 0; j < 4; ++j) { pw[k][j] = pg8::cvt_pk_bf16(p0[8 * k + 2 * j], p0[8 * k + 2 * j + 1]); pw[2 + k][j] = pg8::cvt_pk_bf16(p1[8 * k + 2 * j], p1[8 * k + 2 * j + 1]); }
          slot = 1; vslot = 1; }
#pragma unroll 1
        for (int n = 1; n < NT; ++n) {
            if (!RES) { if (n + 1 < NT) { if (DV == 128) ATT_WAITBAR(3); else ATT_WAITBAR(2); } else ATT_WAITBAR(0);
                if (n + 2 < NT) { const int s2 = slot + 2 >= 3 ? slot - 1 : slot + 2; ATT_DMA(n + 2, s2, (vslot + 2) & 3); } }
            f32x16 p0, p1; ATT_QK(p0, p1); ATT_MASK(p0, p1, n);
            float rm; ATT_ROWMAX(p0, p1, rm);
            bool resc = false; float fsc = 1.f;
            if (__any(rm > THR)) {
                const float dl = fmaxf(rm, 0.f); mref += dl; fsc = __builtin_amdgcn_exp2f(-dl); resc = true;
#pragma unroll
                for (int r = 0; r < 16; ++r) { p0[r] -= dl; p1[r] -= dl; } }
            { const lds_cptr vp = shm3 + (RES ? RES_V + ((vslot + 3) & 3) * 8192 : LDS_V + ((vslot + 3) & 3) * 16384) + vlane;
              s16x4 vlo[4], vhi[4]; u32x4a pwn[4];
#pragma unroll
              for (int j = 0; j < 4; ++j) { vlo[j] = vtr(vp + ATT_VOFF(j)); vhi[j] = vtr(vp + ATT_VOFF(j) + 512); }
              __builtin_amdgcn_sched_barrier(0);
#pragma unroll
              for (int g = 0; g < NM; ++g) {
                  if (g < 4) ol = __builtin_amdgcn_mfma_f32_32x32x16_bf16(__builtin_bit_cast(bf16x8, pw[g]), ones, ol, 0, 0, 0);
                  else { const int j = g - 4; const bf16x8 vf = (bf16x8){vlo[j & 3][0], vlo[j & 3][1], vlo[j & 3][2], vlo[j & 3][3], vhi[j & 3][0], vhi[j & 3][1], vhi[j & 3][2], vhi[j & 3][3]};
                      o[j >> 2] = __builtin_amdgcn_mfma_f32_32x32x16_bf16(__builtin_bit_cast(bf16x8, pw[j & 3]), vf, o[j >> 2], 0, 0, 0);
                      if (j + 4 < NPV) { vlo[j & 3] = vtr(vp + ATT_VOFF(j + 4)); vhi[j & 3] = vtr(vp + ATT_VOFF(j + 4) + 512); } }
                  const int npair = (DV == 128) ? (g < 16 ? 1 : 0) : (g < 4 ? 2 : 1);
                  const int pbase = (DV == 128) ? g : (g < 4 ? 2 * g : g + 4);
#pragma unroll
                  for (int q2 = 0; q2 < npair; ++q2) { const int pi = pbase + q2;
                      const float ea = __builtin_amdgcn_exp2f(pi < 8 ? p0[2 * pi] : p1[2 * pi - 16]), eb = __builtin_amdgcn_exp2f(pi < 8 ? p0[2 * pi + 1] : p1[2 * pi - 15]);
                      pwn[pi >> 2][pi & 3] = pg8::cvt_pk_bf16(ea, eb); }
                  __builtin_amdgcn_sched_barrier(0);
              }
#pragma unroll
              for (int k = 0; k < 4; ++k) pw[k] = pwn[k]; }
            if (resc) {
                if (hi == 0) wsf[r32] = fsc;
                asm volatile("s_waitcnt lgkmcnt(0)" ::: "memory");
#pragma unroll
                for (int r = 0; r < 16; ++r) { const float fr = wsf[crow(r, hi)]; ol[r] *= fr;
#pragma unroll
                    for (int d = 0; d < ND; ++d) o[d][r] *= fr; }
            }
            slot = RES ? slot + 1 : (slot == 2 ? 0 : slot + 1); vslot = (vslot + 1) & 3;
        }
        { const lds_cptr vp = shm3 + (RES ? RES_V + ((vslot + 3) & 3) * 8192 : LDS_V + ((vslot + 3) & 3) * 16384) + vlane;
#pragma unroll
          for (int ks = 0; ks < 4; ++ks) ol = __builtin_amdgcn_mfma_f32_32x32x16_bf16(__builtin_bit_cast(bf16x8, pw[ks]), ones, ol, 0, 0, 0);
#pragma unroll
          for (int j = 0; j < NPV; ++j) { const s16x4 vlo = vtr(vp + ATT_VOFF(j)), vhi = vtr(vp + ATT_VOFF(j) + 512);
              const bf16x8 vf = (bf16x8){vlo[0], vlo[1], vlo[2], vlo[3], vhi[0], vhi[1], vhi[2], vhi[3]};
              o[j >> 2] = __builtin_amdgcn_mfma_f32_32x32x16_bf16(__builtin_bit_cast(bf16x8, pw[j & 3]), vf, o[j >> 2], 0, 0, 0);
              if ((j & 7) == 7) __builtin_amdgcn_sched_barrier(0); } }
#undef ATT_QK
#undef ATT_KLD
#undef ATT_MASK
#undef ATT_ROWMAX
#undef ATT_VOFF
        int lane_e = lane, q0_e = q0 + wbase, h_e = h; asm volatile("" : "+v"(lane_e), "+v"(q0_e), "+v"(h_e));
        float rli[16];
#pragma unroll
        for (int r = 0; r < 16; ++r) rli[r] = __builtin_amdgcn_rcpf(ol[r]);
        bf16* stg = (bf16*)(shm + LDS_OST) + wid * 2048;
        if (MOBA) {
#pragma unroll
            for (int r = 0; r < 16; ++r) { const int orow = crow(r, hi);
#pragma unroll
                for (int d = 0; d < 2; ++d) stg[orow * 64 + d * 32 + (lane_e & 31)] = (bf16)f2bf(o[d][r] * rli[r]); }
            if (MODE == 0) {
                asm volatile("s_waitcnt lgkmcnt(0)" ::: "memory");
                bf16* Ow = Op + (rowbase + q0_e) * PITCH + h_e * 64;
#pragma unroll
                for (int i = 0; i < 4; ++i) { const int row = i * 8 + (lane_e >> 3), ch = lane_e & 7; const u32x4a v = *(const u32x4a*)(stg + row * 64 + ch * 8); *(u32x4a*)(Ow + (long)row * PITCH + ch * 8) = v; }
            } else {
                if ((lane_e & 31) == 0) {
#pragma unroll
                    for (int r = 0; r < 16; ++r) wsf[crow(r, hi)] = ol[r]; }
                int* dtab = (int*)wsf + 32;
                float* wt = (float*)(shm + LDS_WT) + wid * 128;
                asm volatile("s_waitcnt lgkmcnt(0)" ::: "memory");
                const size_t bhq = (size_t)(b * 8 + h_e) * S;
                if (MODE == 2) {
                    if (lane_e < 32) { const int slotr = (q0_e - q0) + lane_e; const int qq = (int)ql[slotr < nvalid ? slotr : 0];
                        int d = -1;
                        if (slotr < nvalid) { const unsigned smq = sel[bhq + qq]; d = (int)((bhq + qq) * 3) + __popc(smq & ((1u << qb) - 1u));
                            *(float2*)(mlp + (size_t)d * 2) = make_float2(mref, wsf[lane_e]); }
                        dtab[lane_e] = d; }
                    asm volatile("s_waitcnt lgkmcnt(0)" ::: "memory");
#pragma unroll
                    for (int i = 0; i < 4; ++i) { const int row = i * 8 + (lane_e >> 3), ch = lane_e & 7; const int d = dtab[row];
                        if (d >= 0) { const u32x4a v = *(const u32x4a*)(stg + row * 64 + ch * 8); *(u32x4a*)(opart + (size_t)d * 64 + ch * 8) = v; } }
                } else {
                    if (lane_e < 32) { const int qq = q0_e + lane_e; const unsigned smq = sel[bhq + qq]; const int ns = __popc(smq);
                        const float md = mref, ld = wsf[lane_e];
                        float mk[3], lk[3]; float M = md;
#pragma unroll
                        for (int k = 0; k < 3; ++k) { mk[k] = -INFINITY; lk[k] = 0.f; if (k < ns) { const float2 t = *(const float2*)(mlp + ((bhq + qq) * 3 + k) * 2); mk[k] = t.x; lk[k] = t.y; M = fmaxf(M, t.x); } }
                        float wd = ld * __builtin_amdgcn_exp2f(md - M), wk[3], tot = wd;
#pragma unroll
                        for (int k = 0; k < 3; ++k) { wk[k] = (k < ns) ? lk[k] * __builtin_amdgcn_exp2f(mk[k] - M) : 0.f; tot += wk[k]; }
                        const float inv = 1.f / tot;
                        *(f32x4*)(wt + lane_e * 4) = (f32x4){wd * inv, wk[0] * inv, wk[1] * inv, wk[2] * inv}; }
                    asm volatile("s_waitcnt lgkmcnt(0)" ::: "memory");
                    bf16* Ow = Op + (rowbase + q0_e) * PITCH + h_e * 64;
#pragma unroll
                    for (int i = 0; i < 4; ++i) { const int row = i * 8 + (lane_e >> 3), ch = lane_e & 7;
                        const f32x4 a = *(const f32x4*)(wt + row * 4); const u32x4a v = *(const u32x4a*)(stg + row * 64 + ch * 8);
                        f32x4 x0 = pg8::bflo(v.x, v.y) * a[0], x1 = pg8::bflo(v.z, v.w) * a[0];
                        const bf16* pp = opart + ((bhq + q0_e + row) * 3) * 64 + ch * 8;
#pragma unroll
                        for (int k = 0; k < 3; ++k) if (a[1 + k] != 0.f) { const u32x4a pv = *(const u32x4a*)(pp + k * 64); x0 += pg8::bflo(pv.x, pv.y) * a[1 + k]; x1 += pg8::bflo(pv.z, pv.w) * a[1 + k]; }
                        *(u32x4a*)(Ow + (long)row * PITCH + ch * 8) = pg8::pack8(x0, x1); }
                }
            }
        } else {
            float* scr = o1scr + (size_t)comp * 32768 + (size_t)wid * 4096 + lane_e;
#pragma unroll
            for (int d = 0; d < ND; ++d) { float* sp = scr + d * 1024; asm volatile("" : "+v"(sp));
#pragma unroll
                for (int r = 0; r < 16; ++r) sp[r * 64] = o[d][r] * rli[r]; }
            if (comp == 1) {
                asm volatile("s_waitcnt vmcnt(0)" ::: "memory");
                const int row = lane_e >> 1, hf = lane_e & 1;
                const int hi_r = (row >> 2) & 1, rr = (row & 3) | ((row >> 3) << 2);
                const float* A0 = o1scr + (size_t)wid * 4096 + rr * 64 + hi_r * 32 + hf * 2048;
                const float* B0 = A0 + 32768;
                f32x4 v[16]; float ssq = 0.f;
#pragma unroll
                for (int d2 = 0; d2 < 2; ++d2)
#pragma unroll
                    for (int c4 = 0; c4 < 8; ++c4) { const f32x4 a = __builtin_nontemporal_load((const f32x4*)(A0 + d2 * 1024 + c4 * 4)), bb = __builtin_nontemporal_load((const f32x4*)(B0 + d2 * 1024 + c4 * 4));
                        const f32x4 w = a - bb * lam; v[d2 * 8 + c4] = w; ssq += (w[0] * w[0] + w[1] * w[1]) + (w[2] * w[2] + w[3] * w[3]); }
                ssq += __shfl_xor(ssq, 1);
                const float rstd = rsqrtf(ssq * (1.f / 128.f) + EPS) * 0.8f;
                bf16* Ow = Op + (rowbase + q0_e + row) * PITCH + h_e * 128 + hf * 64;
#pragma unroll
                for (int k = 0; k < 8; ++k) { const f32x4 g0 = *(const f32x4*)(subg + hf * 64 + k * 8), g1 = *(const f32x4*)(subg + hf * 64 + k * 8 + 4);
                    *(u32x4a*)(Ow + k * 8) = pg8::pack8(v[2 * k] * g0 * rstd, v[2 * k + 1] * g1 * rstd); }
            }
        }
        if (RES) asm volatile("s_waitcnt lgkmcnt(0)" ::: "memory"); else
        asm volatile("s_waitcnt vmcnt(0) lgkmcnt(0)\n\ts_barrier" ::: "memory");
    }
#undef ATT_KR0
#undef ATT_DMA
}
__device__ __forceinline__ void moba_block_load(const bf16* __restrict__ Kp, const bf16* __restrict__ Vp, const int b, const int h, const int blk, char* shm) {
    const int tid = threadIdx.x, lane = tid & 63; const int wid = __builtin_amdgcn_readfirstlane(tid >> 6);
    const unsigned lds0 = (unsigned)(uintptr_t)shm;
    const bf16* ksrc = Kp + ((long)b * S + 256 * blk + lane) * PITCH + h * 64 + wid * 8;
    const bf16* vsrc = Vp + ((long)b * S + 256 * blk + 16 * (wid & 3) + (lane >> 2)) * PITCH + h * 64 + (wid >> 2) * 32 + (lane & 3) * 8;
    asm volatile("s_waitcnt lgkmcnt(0)\n\ts_barrier" ::: "memory");
#pragma unroll
    for (int n = 0; n < 4; ++n) { glds16(ksrc + (long)(64 * n) * PITCH, (unsigned)__builtin_amdgcn_readfirstlane(lds0 + n * 8192 + wid * 1024));
        glds16(vsrc + (long)(64 * n) * PITCH, (unsigned)__builtin_amdgcn_readfirstlane(lds0 + RES_V + n * 8192 + wid * 1024)); }
    asm volatile("s_waitcnt vmcnt(0)\n\ts_barrier" ::: "memory");
}
}

__device__ __forceinline__ float wave_sum(float v) {
#pragma unroll
    for (int o = 1; o < 64; o <<= 1) v += __shfl_xor(v, o);
    return v;
}
__device__ __forceinline__ void gate_wave(int b, int h, int chunk, int lane, const bf16* __restrict__ Qm, const float* __restrict__ ksum, unsigned* __restrict__ sel, unsigned* qcnt, unsigned short* qlist) {
    const int qpos = chunk * 64 + lane, blk = chunk >> 2;
    const size_t t = (size_t)b * S + qpos;
    float q[64];
#pragma unroll
    for (int d8 = 0; d8 < 8; ++d8) { const v4u v = *(const v4u*)(Qm + t * 512 + h * 64 + d8 * 8);
        q[d8 * 8] = __uint_as_float(v.x << 16); q[d8 * 8 + 1] = __uint_as_float(v.x & 0xffff0000u); q[d8 * 8 + 2] = __uint_as_float(v.y << 16); q[d8 * 8 + 3] = __uint_as_float(v.y & 0xffff0000u);
        q[d8 * 8 + 4] = __uint_as_float(v.z << 16); q[d8 * 8 + 5] = __uint_as_float(v.z & 0xffff0000u); q[d8 * 8 + 6] = __uint_as_float(v.w << 16); q[d8 * 8 + 7] = __uint_as_float(v.w & 0xffff0000u); }
    float v0 = -3e38f, v1 = -3e38f, v2 = -3e38f; int i0 = -1, i1 = -1, i2 = -1;
    for (int j = 0; j < blk; ++j) {
        const float* k0 = ksum + ((size_t)(b * 32 + j)) * 512 + h * 64;
        const float* k1 = k0 + 128 * 512;
        float g = 0.f;
#pragma unroll
        for (int d = 0; d < 64; ++d) g += q[d] * (k0[d] + k1[d]);
        if (g > v0) { v2 = v1; i2 = i1; v1 = v0; i1 = i0; v0 = g; i0 = j; }
        else if (g > v1) { v2 = v1; i2 = i1; v1 = g; i1 = j; }
        else if (g > v2) { v2 = g; i2 = j; }
    }
    unsigned m = 0u;
    if (i0 >= 0) m |= 1u << i0;
    if (i1 >= 0) m |= 1u << i1;
    if (i2 >= 0) m |= 1u << i2;
    sel[(size_t)(b * 8 + h) * S + qpos] = m;
    if (qcnt) {
        const int bh = b * 8 + h;
        for (int j = 0; j < blk; ++j) { const bool sj = (m >> j) & 1u; const unsigned long long bal = __ballot(sj);
            if (bal) { int base = 0; if (lane == 0) base = (int)atomicAdd(qcnt + bh * 32 + j, (unsigned)__popcll(bal)); base = __builtin_amdgcn_readfirstlane(base);
                if (sj) qlist[(size_t)bh * QL_PER_BH + 256 * (31 * j - (j * (j - 1)) / 2) + base + __popcll(bal & ((1ull << lane) - 1ull))] = (unsigned short)qpos; } }
    }
}
constexpr int NWAVES = 8;
constexpr int RING_OFF = 0, RING_BYTES = 131072;
constexpr int LDSCTL_OFF = RING_BYTES, MISC_OFF = LDSCTL_OFF + 320;
constexpr int TBL_OFF = LDSCTL_OFF + 512;
constexpr int ROWTAB_OFF = LDSCTL_OFF + 2048;
static_assert(att::LDS_TOTAL <= RING_BYTES && pg8::STAGE_BYTES <= RING_BYTES, "phase scratch fits the ring region");
constexpr int LDS_BYTES = 147456;
constexpr int CW_BAR = 4096;

struct Frame {
    LAS unsigned char* lds;
    volatile LAS unsigned* MISC;
    gu32* ctl;
    int tid, lane, wave, vcu, G;
};
struct Args { const float* in[23]; float* out; unsigned char* ws; int ph_lo, ph_hi, li, pad; };

template <int MODE> __device__ __forceinline__ int wmap(int c) {
    if (MODE == 1) { const int pn = c >> 8; const bool rp = (pn < 4) || (pn >= 6 && pn < 10); if (!rp) return c; const int o = c & 255; return (pn << 8) + (((o >> 5) & 1) << 7) + ((o >> 6) << 5) + (o & 31); }
    if (MODE == 2) return ((c >> 7) << 8) + (c & 127);
    if (MODE == 3) return ((c >> 7) << 8) + 128 + (c & 127);
    return c;
}
struct TrItem { const float* W; bf16* WT; int K, N, mode, item; };
__device__ __forceinline__ void tr_load(const TrItem& it, int lane, f32x4 (&v)[8]) {
    const int nblk = it.N / 32, kb = it.item / nblk, nb = it.item % nblk;
    const float* p = it.W + (size_t)(64 * kb + (lane >> 3)) * it.N + 32 * nb + 4 * (lane & 7);
#pragma unroll
    for (int i = 0; i < 8; ++i) v[i] = *(const GAS f32x4*)(p + (size_t)(8 * i) * it.N);
}
__device__ __forceinline__ void tr_store(const TrItem& it, int lane, const f32x4 (&v)[8], LAS float* scr) {
    const int nblk = it.N / 32, kb = it.item / nblk, nb = it.item % nblk, k0 = 64 * kb, n0 = 32 * nb;
#pragma unroll
    for (int i = 0; i < 8; ++i) { LAS float* d = scr + (8 * i + (lane >> 3)) * 33 + 4 * (lane & 7); d[0] = v[i][0]; d[1] = v[i][1]; d[2] = v[i][2]; d[3] = v[i][3]; }
    LDS_WAIT(); asm volatile("" ::: "memory");
    const int c = lane & 7;
#pragma unroll
    for (int j = 0; j < 4; ++j) { const int n = (lane >> 3) + 8 * j; const LAS float* s = scr + (8 * c) * 33 + n;
        v4u o; o.x = pk2(s[0 * 33], s[1 * 33]); o.y = pk2(s[2 * 33], s[3 * 33]); o.z = pk2(s[4 * 33], s[5 * 33]); o.w = pk2(s[6 * 33], s[7 * 33]);
        const int cc = n0 + n; const int row = it.mode == 1 ? wmap<1>(cc) : (it.mode == 2 ? wmap<2>(cc) : (it.mode == 3 ? wmap<3>(cc) : cc));
        *(GAS v4u*)(it.WT + (size_t)row * it.K + k0 + 8 * c) = o; }
    LDS_WAIT(); asm volatile("" ::: "memory");
}
__device__ __forceinline__ float silu_f(float v) { return v / (1.f + __expf(-v)); }

__device__ __forceinline__ void p0_prologue(Frame& F, const Args& args) {
    unsigned char* ws = args.ws;
    const int gw = F.vcu * NWAVES + F.wave, NGW = F.G * NWAVES, gt = gw * 64 + F.lane, NGT = NGW * 64;
    { const float* c = args.in[1]; const float* w = args.in[2]; float* modp = (float*)(ws + WS_MODP);
      LAS float* act = (LAS float*)(F.lds + RING_OFF + F.wave * 16384);
      for (int task = gw; task < 768; task += NGW) { const int n = (task % 96) * 64 + F.lane, ks = task / 96;
#pragma unroll
          for (int i = 0; i < 8; ++i) { const int idx = F.lane + 64 * i, bb = idx >> 7, kk = idx & 127; act[idx] = silu_f(c[bb * 1024 + ks * 128 + kk]); }
          LDS_WAIT(); asm volatile("" ::: "memory");
          float a0 = 0.f, a1 = 0.f, a2 = 0.f, a3 = 0.f;
#pragma unroll 8
          for (int kk = 0; kk < 128; ++kk) { const float wv = w[(size_t)(ks * 128 + kk) * 6144 + n];
              a0 += act[kk] * wv; a1 += act[128 + kk] * wv; a2 += act[256 + kk] * wv; a3 += act[384 + kk] * wv; }
          modp[(size_t)(ks * 4 + 0) * 6144 + n] = a0; modp[(size_t)(ks * 4 + 1) * 6144 + n] = a1; modp[(size_t)(ks * 4 + 2) * 6144 + n] = a2; modp[(size_t)(ks * 4 + 3) * 6144 + n] = a3;
          LDS_WAIT(); asm volatile("" ::: "memory"); } }
    { float2* tab = (float2*)(ws + WS_ROPE);
      for (int idx = gt; idx < S * 32; idx += NGT) { const int pos = idx >> 5, i = idx & 31;
          const float e = (float)(2 * i) / 64.f; const float inv = 1.0f / powf(10000.f, e); const float ang = (float)pos * inv;
          const double a = (double)ang; const double TWO_PI = 6.283185307179586476925286766559;
          const double n = rint(a / TWO_PI); const double r = a - n * TWO_PI; const double r2 = r * r;
          double sn = 0.0, cs = 0.0, ts = r, tc = 1.0;
          for (int k = 0; k < 16; ++k) { cs += tc; sn += ts; tc *= -r2 / (double)((2 * k + 1) * (2 * k + 2)); ts *= -r2 / (double)((2 * k + 2) * (2 * k + 3)); }
          tab[idx] = make_float2((float)cs, (float)sn); } }
    if (gt == 0) { float s1 = 0.f, s2 = 0.f; for (int i = 0; i < 64; ++i) { s1 += args.in[6][i] * args.in[7][i]; s2 += args.in[8][i] * args.in[9][i]; }
        *(float*)(ws + WS_LAM) = expf(s1) - expf(s2) + 0.2f; }
    { bf16* wr = (bf16*)(ws + WS_WR); const float* wg = args.in[15]; const float* we = args.in[17];
      for (int idx = gt; idx < 32 * 3 * 64 * 8; idx += NGT) { const int s = idx & 7, ln = (idx >> 3) & 63, nt = (idx >> 9) % 3, uu = idx / 1536;
          const int k = 32 * uu + 8 * (ln >> 4) + s, col = 16 * nt + (ln & 15);
          const float w = col < 4 ? wg[k * 4 + col] : (col < 36 ? we[k * 32 + col - 4] : 0.f);
          const unsigned hi = f2bf(w); const float rem = w - __uint_as_float(hi << 16);
          wr[idx] = (bf16)hi; wr[49152 + idx] = (bf16)f2bf(rem); } }
    LAS float* scr = (LAS float*)(F.lds + RING_OFF + F.wave * 16384);
    constexpr int I_IN = 16 * 160, I_PM = 8 * 32, I_PD = 8 * 32, I_OUT = 16 * 32, I_G = 32 * 256, I_U = 32 * 256, I_D = 32 * 256;
    constexpr int NITEMS = I_IN + I_PM + I_PD + I_OUT + I_G + I_U + I_D;
    unsigned char* wsb = ws;
#define TR_DECODE(IT, OUT) do { int r = (IT); \
        if (r < I_IN) { OUT = TrItem{args.in[5], (bf16*)(wsb + WS_WIN), 1024, 5120, 1, r}; break; } r -= I_IN; \
        if (r < I_PM) { OUT = TrItem{args.in[11], (bf16*)(wsb + WS_WPM), 512, 1024, 0, r}; break; } r -= I_PM; \
        if (r < I_PD) { OUT = TrItem{args.in[12], (bf16*)(wsb + WS_WPD), 512, 1024, 0, r}; break; } r -= I_PD; \
        if (r < I_OUT) { OUT = TrItem{args.in[13], (bf16*)(wsb + WS_WOUT), 1024, 1024, 0, r}; break; } r -= I_OUT; \
        if (r < I_G) { const int e = r >> 8; OUT = TrItem{args.in[19] + (size_t)e * 1024 * 512, (bf16*)(wsb + WS_WGU) + (size_t)e * 1024 * 1024, 1024, 512, 2, r & 255}; break; } r -= I_G; \
        if (r < I_U) { const int e = r >> 8; OUT = TrItem{args.in[20] + (size_t)e * 1024 * 512, (bf16*)(wsb + WS_WGU) + (size_t)e * 1024 * 1024, 1024, 512, 3, r & 255}; break; } r -= I_U; \
        { const int e = r >> 8; OUT = TrItem{args.in[21] + (size_t)e * 512 * 1024, (bf16*)(wsb + WS_WD) + (size_t)e * 1024 * 512, 512, 1024, 0, r & 255}; } } while (0)
    if (gw < NITEMS) {
        TrItem cur; TR_DECODE(gw, cur);
        f32x4 va[8], vb[8];
        tr_load(cur, F.lane, va);
        for (int it = gw; it < NITEMS; it += 2 * NGW) {
            TrItem nx1 = cur; const bool h1 = it + NGW < NITEMS; if (h1) { TR_DECODE(it + NGW, nx1); tr_load(nx1, F.lane, vb); }
            tr_store(cur, F.lane, va, scr);
            if (!h1) break;
            TrItem nx2 = nx1; const bool h2 = it + 2 * NGW < NITEMS; if (h2) { TR_DECODE(it + 2 * NGW, nx2); tr_load(nx2, F.lane, va); }
            tr_store(nx1, F.lane, vb, scr);
            if (!h2) break;
            cur = nx2;
        }
    }
#undef TR_DECODE
}
__device__ __forceinline__ void p1_xn(Frame& F, const Args& args) {
    unsigned char* ws = args.ws;
    LAS float* tA = (LAS float*)(F.lds + RING_OFF); LAS float* tS = tA + 1024;
    const int w = blockIdx.x, b = (w * 128) / S;
    const float* modp = (const float*)(ws + WS_MODP); const float* b_ada = args.in[3]; const float* g1n = args.in[4];
    for (int d = F.tid; d < 1024; d += NWAVES * 64) { float sc = b_ada[1024 + d], sh = b_ada[d];
#pragma unroll
        for (int p = 0; p < 8; ++p) { sc += modp[(size_t)(p * 4 + b) * 6144 + 1024 + d]; sh += modp[(size_t)(p * 4 + b) * 6144 + d]; }
        tA[d] = g1n[d] * (1.f + sc); tS[d] = sh; }
    if (F.tid < 96) { const int idx = w * 96 + F.tid, bb = idx / 6144, n = idx % 6144; float v = b_ada[n];
#pragma unroll
        for (int p = 0; p < 8; ++p) v += modp[(size_t)(p * 4 + bb) * 6144 + n];
        ((float*)(ws + WS_MOD))[idx] = v; }
    __syncthreads();
    const float* x = args.in[0]; bf16* XN = (bf16*)(ws + WS_XN);
    for (int i = 0; i < 16; ++i) {
        const int row = w * 128 + F.wave * 16 + i;
        const GAS f32x4* xr = (const GAS f32x4*)(x + (size_t)row * 1024) + F.lane;
        f32x4 v[4]; float ss = 0.f;
#pragma unroll
        for (int j = 0; j < 4; ++j) { v[j] = xr[64 * j]; ss += (v[j].x * v[j].x + v[j].y * v[j].y) + (v[j].z * v[j].z + v[j].w * v[j].w); }
        const float rstd = rsqrtf(wave_sum(ss) * (1.f / 1024.f) + EPS);
        GAS unsigned long long* o8 = (GAS unsigned long long*)(XN + (size_t)row * 1024) + F.lane;
#pragma unroll
        for (int j = 0; j < 4; ++j) { const f32x4 a = ((const LAS f32x4*)tA)[F.lane + 64 * j], s = ((const LAS f32x4*)tS)[F.lane + 64 * j];
            const f32x4 o = v[j] * rstd * a + s;
            o8[64 * j] = (unsigned long long)pg8::cvt_pk_bf16(o.x, o.y) | ((unsigned long long)pg8::cvt_pk_bf16(o.z, o.w) << 32); }
    }
}

__device__ __forceinline__ void moe_tables(Frame& F, const Args& args) {
    LAS int* tbl = (LAS int*)(F.lds + TBL_OFF);
    if (F.tid == 0) { const gu32* gc = F.ctl + CW_CNT; int o = 0;
        for (int e = 0; e < 32; ++e) { const int c = (int)__hip_atomic_load(gc + e, RLX_AGENT); tbl[e] = o; tbl[40 + e] = c; o += (c + 255) >> 8; }
        tbl[32] = o; }
    __syncthreads();
}
__device__ __forceinline__ void p7_router(Frame& F, const Args& args) {
    unsigned char* ws = args.ws;
    typedef float f32x4v __attribute__((ext_vector_type(4)));
    LAS float* tA = (LAS float*)(F.lds + RING_OFF); LAS float* tS = tA + 1024;
    LAS float* lgs = (LAS float*)(F.lds + RING_OFF + 8192) + F.wave * (16 * 48);
    LAS int* cntl = (LAS int*)(F.lds + RING_OFF + 8192 + 8 * 16 * 48 * 4); LAS int* basel = cntl + 32;
    const int w = blockIdx.x, b = (w * 128) / S;
    const float* mod = (const float*)(ws + WS_MOD); const float* g2n = args.in[14];
    for (int d = F.tid; d < 1024; d += NWAVES * 64) { tA[d] = g2n[d] * (1.f + mod[b * 6144 + 4096 + d]); tS[d] = mod[b * 6144 + 3072 + d]; }
    if (F.tid < 32) cntl[F.tid] = 0;
    __syncthreads();
    const int i16 = F.lane & 15, q = F.lane >> 4;
    const int row = w * 128 + F.wave * 16 + i16;
    const float* x1 = args.out; bf16* h2 = (bf16*)(ws + WS_XN); const bf16* wr = (const bf16*)(ws + WS_WR);
    float rstd;
    { const f32x4v* rp = (const f32x4v*)((const float*)(ws + WS_ROWSQ) + (size_t)row * 16); const f32x4v a = rp[0], c = rp[1], d = rp[2], e = rp[3];
      const float ss = ((a[0] + a[1]) + (a[2] + a[3])) + ((c[0] + c[1]) + (c[2] + c[3])) + ((d[0] + d[1]) + (d[2] + d[3])) + ((e[0] + e[1]) + (e[2] + e[3]));
      rstd = rsqrtf(ss * (1.f / 1024.f) + EPS); }
    f32x4v acc[3];
#pragma unroll
    for (int nt = 0; nt < 3; ++nt) acc[nt] = (f32x4v){0.f, 0.f, 0.f, 0.f};
    const float* xr = x1 + (size_t)row * 1024 + 8 * q;
    bf16* hr = h2 + (size_t)row * 1024 + 8 * q;
#pragma unroll 4
    for (int uu = 0; uu < 32; ++uu) {
        const f32x4v xa = *(const f32x4v*)(xr + 32 * uu), xb = *(const f32x4v*)(xr + 32 * uu + 4);
        const f32x4v aa = *(const LAS f32x4v*)(tA + 32 * uu + 8 * q), ab = *(const LAS f32x4v*)(tA + 32 * uu + 8 * q + 4);
        const f32x4v sa = *(const LAS f32x4v*)(tS + 32 * uu + 8 * q), sb = *(const LAS f32x4v*)(tS + 32 * uu + 8 * q + 4);
        const f32x4v ha = xa * rstd * aa + sa, hb = xb * rstd * ab + sb;
        const pg8::u32x4 hh = pg8::pack8(ha, hb);
        *(pg8::u32x4*)(hr + 32 * uu) = hh;
        const pg8::u32x4 hl = pg8::pack8(ha - pg8::bflo(hh.x, hh.y), hb - pg8::bflo(hh.z, hh.w));
        const bf16x8 ahi = __builtin_bit_cast(bf16x8, hh), alo = __builtin_bit_cast(bf16x8, hl);
#pragma unroll
        for (int nt = 0; nt < 3; ++nt) { const size_t bo = ((size_t)(uu * 3 + nt) * 64 + F.lane) * 8;
            const bf16x8 bhi = *(const bf16x8*)(wr + bo), blo = *(const bf16x8*)(wr + 49152 + bo);
            acc[nt] = __builtin_amdgcn_mfma_f32_16x16x32_bf16(ahi, bhi, acc[nt], 0, 0, 0);
            acc[nt] = __builtin_amdgcn_mfma_f32_16x16x32_bf16(alo, bhi, acc[nt], 0, 0, 0);
            acc[nt] = __builtin_amdgcn_mfma_f32_16x16x32_bf16(ahi, blo, acc[nt], 0, 0, 0); }
    }
#pragma unroll
    for (int nt = 0; nt < 3; ++nt)
#pragma unroll
        for (int r = 0; r < 4; ++r) lgs[(4 * q + r) * 48 + 16 * nt + i16] = acc[nt][r];
    LDS_WAIT(); asm volatile("" ::: "memory");
    int e0 = 0, e1 = 0, p0l = 0, p1l = 0; float w0 = 0.f, w1 = 0.f;
    if (F.lane < 16) {
        const LAS float* lr = lgs + F.lane * 48; const float* bg = args.in[16]; const float* be = args.in[18];
        float gl[4]; float gmx = -3e38f; int gi = 0;
#pragma unroll
        for (int i = 0; i < 4; ++i) { gl[i] = lr[i] + bg[i]; if (gl[i] > gmx) { gmx = gl[i]; gi = i; } }
        float gs = 0.f;
#pragma unroll
        for (int i = 0; i < 4; ++i) gs += expf(gl[i] - gmx);
        const float gw = 1.f / gs;
        float el[8]; float emx = -3e38f;
#pragma unroll
        for (int i = 0; i < 8; ++i) { el[i] = lr[4 + gi * 8 + i] + be[gi * 8 + i]; emx = fmaxf(emx, el[i]); }
        float es = 0.f, ep[8];
#pragma unroll
        for (int i = 0; i < 8; ++i) { ep[i] = expf(el[i] - emx); es += ep[i]; }
        int a0 = 0; float pa = -1.f;
#pragma unroll
        for (int i = 0; i < 8; ++i) if (ep[i] > pa) { pa = ep[i]; a0 = i; }
        int a1 = 0; float pb = -1.f;
#pragma unroll
        for (int i = 0; i < 8; ++i) if (i != a0 && ep[i] > pb) { pb = ep[i]; a1 = i; }
        pa /= es; pb /= es; const float sw = pa + pb;
        e0 = gi * 8 + a0; e1 = gi * 8 + a1; w0 = gw * (pa / sw); w1 = gw * (pb / sw);
        p0l = __hip_atomic_fetch_add(cntl + e0, 1, __ATOMIC_RELAXED, __HIP_MEMORY_SCOPE_WORKGROUP);
        p1l = __hip_atomic_fetch_add(cntl + e1, 1, __ATOMIC_RELAXED, __HIP_MEMORY_SCOPE_WORKGROUP);
    }
    __syncthreads();
    if (F.tid < 32) { const int c = cntl[F.tid]; basel[F.tid] = c ? (int)__hip_atomic_fetch_add(F.ctl + CW_CNT + F.tid, (unsigned)c, RLX_AGENT) : 0; }
    __syncthreads();
    if (F.lane < 16) {
        const int t = w * 128 + F.wave * 16 + F.lane;
        int* list = (int*)(ws + WS_LIST); int* toki = (int*)(ws + WS_TOKI); float* tokw = (float*)(ws + WS_TOKW);
        const int q0 = basel[e0] + p0l, q1 = basel[e1] + p1l;
        list[(size_t)e0 * T + q0] = t * 2; list[(size_t)e1 * T + q1] = t * 2 + 1;
        toki[t * 2] = (e0 << 20) | q0; toki[t * 2 + 1] = (e1 << 20) | q1; tokw[t * 2] = w0; tokw[t * 2 + 1] = w1;
    }
}
__device__ __forceinline__ void p10_final(Frame& F, const Args& args) {
    unsigned char* ws = args.ws;
    const LAS int* tbl = (const LAS int*)(F.lds + TBL_OFF);
    const int w = blockIdx.x, b = (w * 128) / S;
    const float* g2 = (const float*)(ws + WS_MOD) + (size_t)b * 6144 + 5120; const float* fg = args.in[22];
    const bf16* Yb = (const bf16*)(ws + WS_YB); const int* toki = (const int*)(ws + WS_TOKI);
    float* out = args.out;
    for (int i = 0; i < 16; ++i) {
        const int t = w * 128 + F.wave * 16 + i;
        const int i0 = toki[t * 2], i1 = toki[t * 2 + 1];
        const size_t ra = (size_t)(tbl[i0 >> 20] * 256 + (i0 & 0xfffff)), rb = (size_t)(tbl[i1 >> 20] * 256 + (i1 & 0xfffff));
        f32x4 v[4]; float ss = 0.f;
#pragma unroll
        for (int j = 0; j < 4; ++j) { const int d0 = (F.lane + 64 * j) * 4; const f32x4 xv = *(const f32x4*)(out + (size_t)t * 1024 + d0);
            const uint2 ya = *(const uint2*)(Yb + ra * 1024 + d0), yb = *(const uint2*)(Yb + rb * 1024 + d0); const f32x4 g = *(const f32x4*)(g2 + d0);
            v[j] = xv + g * (pg8::bflo(ya.x, ya.y) + pg8::bflo(yb.x, yb.y));
            ss += (v[j].x * v[j].x + v[j].y * v[j].y) + (v[j].z * v[j].z + v[j].w * v[j].w); }
        const float rstd = rsqrtf(wave_sum(ss) * (1.f / 1024.f) + EPS);
#pragma unroll
        for (int j = 0; j < 4; ++j) { const int d0 = (F.lane + 64 * j) * 4; const f32x4 g = *(const f32x4*)(fg + d0); *(f32x4*)(out + (size_t)t * 1024 + d0) = v[j] * rstd * g; }
    }
}

__global__ void __launch_bounds__(NWAVES * 64, 2) fwd(Args args) {
    extern __shared__ __attribute__((aligned(16))) unsigned char lds[];
    Frame F;
    F.lds = (LAS unsigned char*)lds;
    F.MISC = (volatile LAS unsigned*)(F.lds + MISC_OFF);
    F.tid = threadIdx.x; F.lane = F.tid & 63; F.wave = __builtin_amdgcn_readfirstlane(F.tid >> 6);
    F.G = gridDim.x; { const int bx = blockIdx.x; F.vcu = (F.G % 8 == 0) ? (bx % 8) * (F.G / 8) + bx / 8 : bx; }
    unsigned char* ws = args.ws;
    F.ctl = (gu32*)(ws + WS_CTL);
    for (int u = F.tid; u < (LDS_BYTES - LDSCTL_OFF) / 4; u += NWAVES * 64) ((LAS unsigned*)(F.lds + LDSCTL_OFF))[u] = 0u;
    __syncthreads();
    XcdBarrier bar = xcd_barrier_post((unsigned*)(F.ctl + CW_BAR) + args.li * XCD_BAR_WORDS, F.MISC + 8);
    const int lo = args.ph_lo, hi = args.ph_hi;
#define IN(k) (lo <= (k) && (k) < hi)
#define BOTH(k) (IN(k) && IN((k) + 1))
#define GRID_BAR() xcd_barrier(bar)

    if (IN(0)) { p0_prologue(F, args); if (BOTH(0)) GRID_BAR(); }
    if (IN(1)) { p1_xn(F, args); if (BOTH(1)) GRID_BAR(); }
    if (IN(2)) {
        __syncthreads();
        pg8::Gemm g{(const bf16*)(ws + WS_XN), (const bf16*)(ws + WS_WIN), 1024}; pg8::StaticOrder So; So.init(T, INW, F.G, (int)blockIdx.x);
        pg8::EpiInProj E{(bf16*)(ws + WS_QM), (bf16*)(ws + WS_GM), (float*)(ws + WS_KSUM), (const float*)(ws + WS_ROPE), T, S, C2};
        pg8::gemm_phase<pg8::EpiInProj, pg8::StaticOrder, true, true>(F.lds + RING_OFF, g, So, E);
        if (BOTH(2)) GRID_BAR();
    }
    if (IN(3)) {
        const int gw = F.vcu * NWAVES + F.wave, NGW = F.G * NWAVES;
        for (int t2 = gw; t2 < 2048; t2 += NGW) {
#pragma unroll 1
            for (int hf = 0; hf < 2; ++hf) { const int task = hf ? 4095 - t2 : t2; const int chunk = task >> 5, bh = task & 31;
                gate_wave(bh >> 3, bh & 7, chunk, F.lane, (const bf16*)(ws + WS_QM), (const float*)(ws + WS_KSUM), (unsigned*)(ws + WS_SEL), (unsigned*)(F.ctl + CW_QCNT), (unsigned short*)((char*)args.out + DO_QLIST)); }
        }
        if (BOTH(3)) GRID_BAR();
    }
    if (IN(4)) {
        __syncthreads();
        const float lam = *(const float*)(ws + WS_LAM);
        float* o1scr = (float*)(ws + WS_XN) + (size_t)blockIdx.x * 65536;
        bf16* opart = (bf16*)args.out; float* mlp = (float*)((char*)args.out + DO_MLP); const unsigned short* qlist = (const unsigned short*)((char*)args.out + DO_QLIST);
        LAS int* pre = (LAS int*)(F.lds + ROWTAB_OFF); LAS int* tot = pre + 1040;
        if (F.tid < 32) { int run = 0; for (int j = 0; j < 32; ++j) { pre[F.tid * 32 + j] = run; run += ((int)__hip_atomic_load(F.ctl + CW_QCNT + F.tid * 32 + j, RLX_AGENT) + 511) >> 9; } tot[F.tid] = run; }
        __syncthreads();
        if (F.tid == 0) { int run = 0; for (int i = 0; i < 32; ++i) { const int c = tot[i]; tot[i] = run; run += c; } tot[32] = run; }
        __syncthreads();
        for (int e = F.tid; e < 1024; e += NWAVES * 64) pre[e] += tot[e >> 5];
        if (F.tid == 0) pre[1024] = tot[32];
        __syncthreads();
        const int nitems = pre[1024];
#pragma unroll 1
        for (int I = F.vcu; I < nitems; I += F.G) {
            int lo_ = 0, hi_ = 1024;
            while (hi_ - lo_ > 1) { const int mid = (lo_ + hi_) >> 1; if (pre[mid] <= I) lo_ = mid; else hi_ = mid; }
            const int e = lo_, bh = e >> 5, j = e & 31, c = I - pre[e];
            const int cnt = (int)__hip_atomic_load(F.ctl + CW_QCNT + e, RLX_AGENT); int nv = cnt - 512 * c; nv = nv > 512 ? 512 : nv;
            att::moba_block_load((const bf16*)(ws + WS_KM), (const bf16*)(ws + WS_VM), bh >> 3, bh & 7, j, (char*)lds + RING_OFF);
            const unsigned short* ql = qlist + (size_t)bh * QL_PER_BH + 256 * (31 * j - (j * (j - 1)) / 2) + 512 * c;
#pragma unroll 1
            for (int g = F.wave; g * 32 < nv; g += NWAVES)
                att::attn_unit<64, 2, true>(bh >> 3, bh & 7, j, (const bf16*)(ws + WS_QM), (const bf16*)(ws + WS_KM), (const bf16*)(ws + WS_VM), nullptr, (const unsigned*)(ws + WS_SEL), nullptr, 0.f, nullptr,
                                            (char*)lds + RING_OFF, ql + g * 32, nv - g * 32 < 32 ? nv - g * 32 : 32, opart, mlp);
        }
        __syncthreads();
        { const int u = F.vcu, bh = u >> 4, s = u & 15;
#pragma unroll 1
          for (int kk = 0; kk < 2; ++kk) att::attn_unit<128, 1>(bh >> 2, bh & 3, (kk & 1) ? s : 31 - s, (const bf16*)(ws + WS_QD), (const bf16*)(ws + WS_KD), (const bf16*)(ws + WS_VD), (bf16*)(ws + WS_QD),
                                                                   nullptr, o1scr, lam, args.in[10], (char*)lds + RING_OFF); }
        GRID_BAR();
#pragma unroll 1
        for (int k = 0; k < 4; ++k) { const int u = F.vcu * 4 + k, bh = u >> 5, qb = u & 31;
            att::moba_block_load((const bf16*)(ws + WS_KM), (const bf16*)(ws + WS_VM), bh >> 3, bh & 7, qb, (char*)lds + RING_OFF);
            att::attn_unit<64, 3, true>(bh >> 3, bh & 7, qb, (const bf16*)(ws + WS_QM), (const bf16*)(ws + WS_KM), (const bf16*)(ws + WS_VM), (bf16*)(ws + WS_QM), (const unsigned*)(ws + WS_SEL), nullptr, 0.f, nullptr,
                                        (char*)lds + RING_OFF, nullptr, 0, opart, mlp); }
        __syncthreads();
        if (BOTH(4)) GRID_BAR();
    }
    if (IN(5)) {
        __syncthreads();
        pg8::StaticOrder So; So.init(T, 1024, F.G, (int)blockIdx.x);
        { pg8::Gemm g{(const bf16*)(ws + WS_QM), (const bf16*)(ws + WS_WPM), 512}; pg8::EpiGate<0> E{(const bf16*)(ws + WS_GM), (bf16*)(ws + WS_MERGED)};
          pg8::gemm_phase<pg8::EpiGate<0>, pg8::StaticOrder, true, true>(F.lds + RING_OFF, g, So, E); }
        __syncthreads();
        { pg8::Gemm g{(const bf16*)(ws + WS_QD), (const bf16*)(ws + WS_WPD), 512}; pg8::EpiGate<1> E{(const bf16*)(ws + WS_GD), (bf16*)(ws + WS_MERGED)};
          pg8::gemm_phase<pg8::EpiGate<1>, pg8::StaticOrder, true, true>(F.lds + RING_OFF, g, So, E); }
        if (BOTH(5)) GRID_BAR();
    }
    if (IN(6)) {
        __syncthreads();
        pg8::StaticOrder So; So.init(T, 1024, F.G, (int)blockIdx.x);
        pg8::Gemm g{(const bf16*)(ws + WS_MERGED), (const bf16*)(ws + WS_WOUT), 1024};
        pg8::EpiResid E{args.in[0], (const float*)(ws + WS_MOD) + 2048, args.out, (float*)(ws + WS_ROWSQ), S};
        pg8::gemm_phase<pg8::EpiResid, pg8::StaticOrder, true, true>(F.lds + RING_OFF, g, So, E);
        if (BOTH(6)) GRID_BAR();
    }
    if (IN(7)) { __syncthreads(); p7_router(F, args); if (BOTH(7)) GRID_BAR(); }
    if (IN(8)) {
        __syncthreads(); moe_tables(F, args);
        const LAS int* tbl = (const LAS int*)(F.lds + TBL_OFF); LAS int* rowtab = (LAS int*)(F.lds + ROWTAB_OFF);
        pg8::MoeOrder Mo{tbl, rowtab, tbl[32], 4, F.G, (int)blockIdx.x, 1024, true};
        { pg8::Unit u; const int* list = (const int*)(ws + WS_LIST);
          for (int ui = 0; ui < 8 && Mo.next(ui, u); ++ui)
              for (int r = F.tid; r < 256; r += NWAVES * 64) { const int rr = r < u.cnt ? r : u.cnt - 1; rowtab[ui * 256 + r] = list[(size_t)u.e * T + u.lo + rr] >> 1; } }
        __syncthreads();
        pg8::Gemm g{(const bf16*)(ws + WS_XN), (const bf16*)(ws + WS_WGU), 1024};
        pg8::EpiMoeHid E{(bf16*)(ws + WS_HID)};
        pg8::gemm_phase<pg8::EpiMoeHid, pg8::MoeOrder, true, true>(F.lds + RING_OFF, g, Mo, E);
        if (BOTH(8)) GRID_BAR();
    }
    if (IN(9)) {
        __syncthreads(); moe_tables(F, args);
        const LAS int* tbl = (const LAS int*)(F.lds + TBL_OFF);
        pg8::MoeOrder Mo{tbl, nullptr, tbl[32], 4, F.G, (int)blockIdx.x, 1024, false};
        pg8::Gemm g{(const bf16*)(ws + WS_HID), (const bf16*)(ws + WS_WD), 512};
        pg8::EpiMoeDown E{(bf16*)(ws + WS_YB), (const int*)(ws + WS_LIST), (const float*)(ws + WS_TOKW), T};
        pg8::gemm_phase<pg8::EpiMoeDown, pg8::MoeOrder, true, true>(F.lds + RING_OFF, g, Mo, E);
        if (BOTH(9)) GRID_BAR();
    }
    if (IN(10)) { __syncthreads(); moe_tables(F, args); p10_final(F, args); }
#undef IN
#undef BOTH
}
}


extern "C" void kernel_launch(void* const* d_in, const int* in_sizes, int n_in, void* d_out, int out_size, void* d_ws, size_t ws_size, hipStream_t stream) {
    char* ws = (char*)d_ws; float* out = (float*)d_out;
    static int grid = 0;
    if (grid == 0) {
        int dev = 0, cus = 0, per_cu = 0;
        if (hipGetDevice(&dev) != hipSuccess || hipDeviceGetAttribute(&cus, hipDeviceAttributeMultiprocessorCount, dev) != hipSuccess) { fprintf(stderr, "kernel_launch: device query failed\n"); grid = -1; return; }
        if (hipFuncSetAttribute((const void*)fwd, hipFuncAttributeMaxDynamicSharedMemorySize, LDS_BYTES) != hipSuccess) { fprintf(stderr, "kernel_launch: hipFuncSetAttribute failed\n"); grid = -1; return; }
        if (hipOccupancyMaxActiveBlocksPerMultiprocessor(&per_cu, (const void*)fwd, NWAVES * 64, LDS_BYTES) != hipSuccess || per_cu < 1) fprintf(stderr, "kernel_launch: occupancy query reports %d\n", per_cu);
        (void)hipGetLastError();
        grid = cus < 256 ? cus : 256;
        if (ws_size < 512 * MiB || n_in != 23 || out_size != T * D) { fprintf(stderr, "kernel_launch: built for 23 inputs, %d outputs and >= 512 MiB of workspace\n", T * D); grid = -1; return; }
    }
    if (grid < 0) return;
    (void)hipMemsetAsync(ws + WS_CTL, 0, 64 * 1024, stream);
    Args a{};
    for (int i = 0; i < 23; ++i) a.in[i] = (const float*)d_in[i];
    a.out = out; a.ws = (unsigned char*)d_ws;
    a.ph_lo = 0; a.ph_hi = 11; a.li = 0; a.pad = 0;
    hipLaunchKernelGGL(fwd, dim3(grid), dim3(NWAVES * 64), LDS_BYTES, stream, a);
}
```

```cpp
#include <hip/hip_runtime.h>
#include <cstdint>
#include <cstdio>

namespace {

constexpr int NB = 4, S = 8192, D = 1024, T = NB * S;
constexpr int INW = 5120;
constexpr float EPS = 1e-6f;
constexpr float C2 = 0.125f * 1.4426950408889634f;
constexpr size_t MiB = 1ull << 20;
constexpr size_t WS_CTL = 0;
constexpr size_t WS_MOD = 1 * MiB;
constexpr size_t WS_LAM = 1 * MiB + 128 * 1024;
constexpr size_t WS_OFF = 1 * MiB + 132 * 1024;
constexpr size_t WS_KSUM = 1 * MiB + 256 * 1024;
constexpr size_t WS_MODP = 2 * MiB;
constexpr size_t WS_WR = 3 * MiB;
constexpr size_t WS_ROPE = 4 * MiB;
constexpr size_t WS_WIN = 6 * MiB;
constexpr size_t WS_WPM = 16 * MiB, WS_WPD = 17 * MiB, WS_WOUT = 18 * MiB;
constexpr size_t WS_WGU = 20 * MiB;
constexpr size_t WS_WD = 84 * MiB;
constexpr size_t WS_XN = 116 * MiB;
constexpr size_t WS_QM = 180 * MiB, WS_KM = 212 * MiB, WS_VM = 244 * MiB, WS_QD = 276 * MiB, WS_KD = 308 * MiB, WS_VD = 340 * MiB;
constexpr size_t WS_GM = 372 * MiB, WS_GD = 436 * MiB;
constexpr size_t WS_LIST = 500 * MiB;
constexpr size_t WS_TOKI = 504 * MiB;
constexpr size_t WS_TOKW = 504 * MiB + 256 * 1024;
constexpr size_t WS_SEL = 505 * MiB;
constexpr size_t WS_ROWSQ = 506 * MiB;
constexpr size_t WS_MERGED = 212 * MiB;
constexpr size_t WS_HID = 372 * MiB;
constexpr size_t WS_YB = 180 * MiB;
constexpr int CW_QCNT = 8192;
constexpr size_t DO_MLP = 96 * MiB, DO_QLIST = 104 * MiB;
constexpr int QL_PER_BH = 126976;
constexpr int CW_CNT = 1024;


#define GAS __attribute__((address_space(1)))
#define LAS __attribute__((address_space(3)))
typedef unsigned short bf16;
typedef unsigned v4u __attribute__((ext_vector_type(4)));
typedef float f32x4 __attribute__((ext_vector_type(4)));
typedef short bf16x8 __attribute__((ext_vector_type(8)));
typedef GAS unsigned gu32;
typedef GAS unsigned long long gu64;
#define RLX_AGENT __ATOMIC_RELAXED, __HIP_MEMORY_SCOPE_AGENT
#define LDS_WAIT() asm volatile("s_waitcnt lgkmcnt(0)" ::: "memory")
#define VM_WAIT() asm volatile("s_waitcnt vmcnt(0)" ::: "memory")
__device__ __forceinline__ unsigned f2bf(float f) { unsigned u = __builtin_bit_cast(unsigned, f); return (u + 0x7fffu + ((u >> 16) & 1u)) >> 16; }
__device__ __forceinline__ unsigned pk2(float lo, float hi) { return f2bf(lo) | (f2bf(hi) << 16); }
__device__ __forceinline__ float bf2f(bf16 v) { return __uint_as_float((unsigned)v << 16); }
#define XB_TMO      128
#define XB_XCNT(j)  (256  + 64 * (j))
#define XB_XSUB(j)  (1280 + 64 * (j))
#define XB_XGEN(j)  (2304 + 64 * (j))
#define XB_TOP      3328
#define XB_TOPGEN   3392
#define XCD_BAR_WORDS 3456
#define XB_SPIN_CAP (1u << 18)

__device__ __forceinline__ unsigned xb_ld(unsigned* p)              { return __hip_atomic_load(p, __ATOMIC_RELAXED, __HIP_MEMORY_SCOPE_AGENT); }
__device__ __forceinline__ unsigned xb_add(unsigned* p, unsigned v) { return __hip_atomic_fetch_add(p, v, __ATOMIC_RELAXED, __HIP_MEMORY_SCOPE_AGENT); }
__device__ __forceinline__ unsigned xb_xcc_id() { return (unsigned)__builtin_amdgcn_s_getreg((3 << 11) | 20) & 0xFu; }
#define XB_SPIN(cond, bar) do { unsigned _sp = 0; while (cond) { __builtin_amdgcn_s_sleep(1); \
    if ((++_sp & 255u) == 0u) { if (xb_ld(&(bar)[XB_TMO])) break; if (_sp > XB_SPIN_CAP) { atomicAdd(&(bar)[XB_TMO], 1u); break; } } } } while (0)

struct XcdBarrier {
    unsigned* bar; unsigned x;
    volatile LAS unsigned* st;
};

__device__ __forceinline__ XcdBarrier xcd_barrier_post(unsigned* bar, volatile LAS unsigned* st) {
    XcdBarrier b; b.bar = bar; b.x = xb_xcc_id(); b.st = st;
    if (threadIdx.x == 0) (void)xb_add(&bar[XB_XCNT(b.x)], 1u);
    return b;
}
__device__ __forceinline__ void xcd_barrier_complete(unsigned* bar, unsigned x, unsigned& nloc, unsigned& nx) {
    const unsigned G = gridDim.x * gridDim.y * gridDim.z;
    unsigned sum, cnt, mine, sp = 0u;
    for (;;) {
        sum = 0u; cnt = 0u; mine = 0u;
#pragma unroll
        for (unsigned j = 0; j < 16; ++j) { const unsigned c = xb_ld(&bar[XB_XCNT(j)]); sum += c; cnt += (c > 0u) ? 1u : 0u; mine = (j == x) ? c : mine; }
        if (sum == G) break;
        __builtin_amdgcn_s_sleep(1);
        if ((++sp & 255u) == 0u) { if (xb_ld(&bar[XB_TMO])) break; if (sp > XB_SPIN_CAP) { atomicAdd(&bar[XB_TMO], 1u); break; } }
    }
    nloc = mine > 0u ? mine : 1u; nx = cnt > 0u ? cnt : 1u;
}

__device__ __forceinline__ void xcd_barrier(const XcdBarrier& b) {
    asm volatile("s_waitcnt vmcnt(0)" ::: "memory");
    __syncthreads();
    if (threadIdx.x == 0) {
        unsigned* bar = b.bar;
        __builtin_amdgcn_s_waitcnt(0);
        unsigned nloc = b.st[0], nx = b.st[1];
        if (nloc == 0u) { xcd_barrier_complete(bar, b.x, nloc, nx); b.st[0] = nloc; b.st[1] = nx; }
        const unsigned old = xb_add(&bar[XB_XSUB(b.x)], 1u);
        const unsigned gen = old / nloc;
        if (old + 1u == (gen + 1u) * nloc) {
            __builtin_amdgcn_fence(__ATOMIC_RELEASE, "agent");
            asm volatile("s_waitcnt vmcnt(0)" ::: "memory");
            const unsigned og = xb_add(&bar[XB_TOP], 1u);
            const unsigned tg = og / nx;
            if (og + 1u == (tg + 1u) * nx) xb_add(&bar[XB_TOPGEN], 1u);
            else XB_SPIN(xb_ld(&bar[XB_TOPGEN]) == tg, bar);
            __builtin_amdgcn_fence(__ATOMIC_ACQUIRE, "agent");
            xb_add(&bar[XB_XGEN(b.x)], 1u);
            asm volatile("s_waitcnt vmcnt(0)" ::: "memory");
        } else {
            XB_SPIN(xb_ld(&bar[XB_XGEN(b.x)]) == gen, bar);
            __builtin_amdgcn_fence(__ATOMIC_ACQUIRE, "agent");
            asm volatile("s_waitcnt vmcnt(0)" ::: "memory");
        }
    }
    __syncthreads();
}


namespace pg8 {
#define PG8_LAS __attribute__((address_space(3)))
typedef unsigned short bf16_t;
typedef short bf16x8 __attribute__((ext_vector_type(8)));
typedef float f32x4 __attribute__((ext_vector_type(4)));
typedef unsigned u32x4 __attribute__((ext_vector_type(4)));
constexpr int BM = 256, BK = 64, HALF = 128, HTB = HALF * BK * 2  , STAGE_BYTES = 8 * HTB, NXCD = 8, WGM = 8;

__host__ __device__ __forceinline__ int lds_byte(int r, int c) { const int st = (r >> 4) * 2 + (c >> 5), rr = r & 15, cc = c & 31, ob = rr * 64 + cc * 2; return st * 1024 + (ob ^ (((ob >> 9) & 1) << 5)); }
__host__ __device__ __forceinline__ void stage_rc(int b, int& R, int& C) { const int st = b / 1024, sb = b % 1024, swz = sb ^ (((sb >> 9) & 1) << 5); R = (st >> 1) * 16 + swz / 64; C = (st & 1) * 32 + (swz % 64) / 2; }
__host__ __device__ __forceinline__ int perm32(int rho) { const int n = rho >> 4, i = rho & 15; return 8 * (i >> 2) + 4 * n + (i & 3); }

struct Unit { int pm, pn, e, lo, cnt; };
struct Gemm { const bf16_t* A; const bf16_t* Bt; int K; };

struct StaticOrder {
    int nM, nN, nwg, G, c;
    __host__ __device__ void init(int M, int N, int G_, int c_) { nM = M / BM; nN = N / BM; nwg = nM * nN; G = G_; c = c_; }
    __host__ __device__ bool next(int i, Unit& u) const {
        const long L = (long)i * G + c; if (L >= nwg) return false;
        int wgid = (int)L; { const int q = nwg / NXCD, r = nwg % NXCD, xcd = wgid % NXCD, off = wgid / NXCD; wgid = (xcd < r ? xcd * (q + 1) : r * (q + 1) + (xcd - r) * q) + off; }
        const int nig = WGM * nN, gid = wgid / nig, fm = gid * WGM, gsz = (nM - fm) < WGM ? (nM - fm) : WGM;
        u.pm = fm + ((wgid % nig) % gsz); u.pn = (wgid % nig) / gsz; u.e = 0; u.lo = 0; u.cnt = BM; return true;
    }
    __device__ __forceinline__ int arow(int, const Unit& u, int r) const { return u.pm * BM + r; }
    __device__ __forceinline__ int brow(const Unit& u) const { return u.pn * BM; }
    __device__ __forceinline__ void a_ready(const Unit&) const {}
    __device__ __forceinline__ void done(const Unit&) const {}
};
typedef float f32x2_t __attribute__((ext_vector_type(2))); typedef __bf16 bf16x2_t __attribute__((ext_vector_type(2)));
__device__ __forceinline__ unsigned cvt_pk_bf16(float lo, float hi) { f32x2_t v = {lo, hi}; bf16x2_t b = __builtin_convertvector(v, bf16x2_t); return __builtin_bit_cast(unsigned, b); }
struct MoeOrder {
    const PG8_LAS int* tbl; const PG8_LAS int* rowtab; int ntile, nN, G, c, Nexp; bool gather;
    __device__ __forceinline__ bool next(int i, Unit& u) const {
        const int L = i * G + c; if (L >= ntile * nN) return false;
        const int mt = L / nN; int e = 0;
        while (tbl[e + 1] <= mt) ++e;
        u.pm = mt; u.pn = L - mt * nN; u.e = e; u.lo = (mt - tbl[e]) * BM; u.cnt = tbl[40 + e] - u.lo; return true;
    }
    __device__ __forceinline__ int arow(int ui, const Unit& u, int r) const { return gather ? rowtab[ui * BM + r] : u.pm * BM + r; }
    __device__ __forceinline__ int brow(const Unit& u) const { return u.e * Nexp + u.pn * BM; }
    __device__ __forceinline__ void a_ready(const Unit&) const {}
    __device__ __forceinline__ void done(const Unit&) const {}
};
__device__ __forceinline__ float fast_sigmoid(float v) { return __builtin_amdgcn_rcpf(1.f + __builtin_amdgcn_exp2f(-1.4426950408889634f * v)); }
__device__ __forceinline__ u32x4 pack8(const f32x4& a, const f32x4& b) { u32x4 w; w.x = cvt_pk_bf16(a[0], a[1]); w.y = cvt_pk_bf16(a[2], a[3]); w.z = cvt_pk_bf16(b[0], b[1]); w.w = cvt_pk_bf16(b[2], b[3]); return w; }
__device__ __forceinline__ f32x4 bflo(unsigned a, unsigned b) { return (f32x4){__uint_as_float(a << 16), __uint_as_float(a & 0xffff0000u), __uint_as_float(b << 16), __uint_as_float(b & 0xffff0000u)}; }

struct EpiInProj {
    static constexpr bool PERM = true, AFTER_DRAIN = false;
    bf16_t* qkv;
    bf16_t* gates;
    float* ksum;
    const float* tab;
    int Trows, Srows; float c2;
    __device__ __forceinline__ void operator()(const f32x4 (&acc)[2][2][4][2], const Unit& u, int wr, int wc, int fr, int fq) const {
        const int pn = u.pn; const int rw = u.pm * BM + wr * 64 + fr;
        if (pn >= 12) {
            bf16_t* base = gates + (size_t)((pn - 12) >> 2) * ((size_t)Trows * 1024) + ((pn - 12) & 3) * 256 + wc * 32 + 8 * fq;
#pragma unroll
            for (int ai = 0; ai < 2; ++ai)
#pragma unroll
                for (int m = 0; m < 4; ++m) { bf16_t* rowp = base + (size_t)(rw + ai * HALF + m * 16) * 1024;
#pragma unroll
                    for (int bj = 0; bj < 2; ++bj) { f32x4 v0 = acc[ai][bj][m][0], v1 = acc[ai][bj][m][1];
#pragma unroll
                        for (int j = 0; j < 4; ++j) { v0[j] = fast_sigmoid(v0[j]); v1[j] = fast_sigmoid(v1[j]); }
                        *(u32x4*)(rowp + bj * HALF) = pack8(v0, v1); } }
            return;
        }
        const int seg = pn >> 1, ts = pn & 1;
        bf16_t* base = qkv + (size_t)seg * ((size_t)Trows * 512);
        if (seg == 2 || seg == 5) {
            bf16_t* b2 = base + ts * 256 + wc * 32 + 8 * fq;
#pragma unroll
            for (int ai = 0; ai < 2; ++ai)
#pragma unroll
                for (int m = 0; m < 4; ++m) { bf16_t* rowp = b2 + (size_t)(rw + ai * HALF + m * 16) * 512;
#pragma unroll
                    for (int bj = 0; bj < 2; ++bj) *(u32x4*)(rowp + bj * HALF) = pack8(acc[ai][bj][m][0], acc[ai][bj][m][1]); }
            return;
        }
        const float sc = (seg == 0 || seg == 3) ? c2 : 1.f;
        const int colh = (ts * 4 + wc) * 64 + 8 * fq;
        f32x4 ks[2][2];
#pragma unroll
        for (int a = 0; a < 2; ++a)
#pragma unroll
            for (int n = 0; n < 2; ++n) ks[a][n] = (f32x4){0.f, 0.f, 0.f, 0.f};
#pragma unroll
        for (int ai = 0; ai < 2; ++ai)
#pragma unroll
            for (int m = 0; m < 4; ++m) {
                const int r = rw + ai * HALF + m * 16, pos = r & (Srows - 1);
                const f32x4* tp = (const f32x4*)(tab + (size_t)pos * 64 + 16 * fq);
                const f32x4 t0 = tp[0], t1 = tp[1], t2 = tp[2], t3 = tp[3];
                f32x4 olo[2], ohi[2];
#pragma unroll
                for (int n = 0; n < 2; ++n) {
                    const f32x4 ta = n ? t2 : t0, tb = n ? t3 : t1;
                    const f32x4 cs = (f32x4){ta[0], ta[2], tb[0], tb[2]}, sn = (f32x4){ta[1], ta[3], tb[1], tb[3]};
                    const f32x4 lo = acc[ai][0][m][n], hi = acc[ai][1][m][n];
                    olo[n] = lo * cs - hi * sn; ohi[n] = hi * cs + lo * sn;
                }
                if (seg == 1) { ks[0][0] += olo[0]; ks[0][1] += olo[1]; ks[1][0] += ohi[0]; ks[1][1] += ohi[1]; }
                bf16_t* rowp = base + (size_t)r * 512 + colh;
                *(u32x4*)(rowp) = pack8(olo[0] * sc, olo[1] * sc); *(u32x4*)(rowp + 32) = pack8(ohi[0] * sc, ohi[1] * sc);
            }
        if (seg == 1) {
#pragma unroll
            for (int a = 0; a < 2; ++a)
#pragma unroll
                for (int n = 0; n < 2; ++n)
#pragma unroll
                    for (int j = 0; j < 4; ++j) { float v = ks[a][n][j]; v += __shfl_xor(v, 1); v += __shfl_xor(v, 2); v += __shfl_xor(v, 4); v += __shfl_xor(v, 8); ks[a][n][j] = v; }
            if (fr == 0) { float* kp = ksum + ((size_t)(wr * 128 + u.pm)) * 512 + colh; *(f32x4*)(kp) = ks[0][0]; *(f32x4*)(kp + 4) = ks[0][1]; *(f32x4*)(kp + 32) = ks[1][0]; *(f32x4*)(kp + 36) = ks[1][1]; }
        }
    }
};
template <int PASS> struct EpiGate {
    static constexpr bool PERM = true, AFTER_DRAIN = false;
    const bf16_t* G; bf16_t* out;
    __device__ __forceinline__ void operator()(const f32x4 (&acc)[2][2][4][2], const Unit& u, int wr, int wc, int fr, int fq) const {
        const int rw = u.pm * BM + wr * 64 + fr, col0 = u.pn * BM + wc * 32 + 8 * fq;
#pragma unroll
        for (int ai = 0; ai < 2; ++ai) {
            u32x4 g[4][2], p[4][2];
#pragma unroll
            for (int m = 0; m < 4; ++m)
#pragma unroll
                for (int bj = 0; bj < 2; ++bj) { const size_t off = (size_t)(rw + ai * HALF + m * 16) * 1024 + col0 + bj * HALF;
                    g[m][bj] = *(const u32x4*)(G + off); if (PASS == 1) p[m][bj] = __builtin_nontemporal_load((const u32x4*)(out + off)); }
#pragma unroll
            for (int m = 0; m < 4; ++m)
#pragma unroll
                for (int bj = 0; bj < 2; ++bj) { const size_t off = (size_t)(rw + ai * HALF + m * 16) * 1024 + col0 + bj * HALF;
                    f32x4 v0 = acc[ai][bj][m][0] * bflo(g[m][bj].x, g[m][bj].y), v1 = acc[ai][bj][m][1] * bflo(g[m][bj].z, g[m][bj].w);
                    if (PASS == 1) { v0 += bflo(p[m][bj].x, p[m][bj].y); v1 += bflo(p[m][bj].z, p[m][bj].w); }
                    *(u32x4*)(out + off) = pack8(v0, v1); }
        }
    }
};
struct EpiResid {
    static constexpr bool PERM = true, AFTER_DRAIN = false;
    const float* x; const float* g1; float* x1; float* rowsq; int Srows;
    __device__ __forceinline__ void operator()(const f32x4 (&acc)[2][2][4][2], const Unit& u, int wr, int wc, int fr, int fq) const {
        const int rw = u.pm * BM + wr * 64 + fr, col0 = u.pn * BM + wc * 32 + 8 * fq, b = (u.pm * BM) / Srows;
        f32x4 gv[2][2];
#pragma unroll
        for (int bj = 0; bj < 2; ++bj)
#pragma unroll
            for (int n = 0; n < 2; ++n) gv[bj][n] = *(const f32x4*)(g1 + (size_t)b * 6144 + col0 + bj * HALF + n * 4);
#pragma unroll
        for (int ai = 0; ai < 2; ++ai) {
            f32x4 xv[4][2][2];
#pragma unroll
            for (int m = 0; m < 4; ++m) { const size_t off = (size_t)(rw + ai * HALF + m * 16) * 1024 + col0;
#pragma unroll
                for (int bj = 0; bj < 2; ++bj)
#pragma unroll
                    for (int n = 0; n < 2; ++n) xv[m][bj][n] = *(const f32x4*)(x + off + bj * HALF + n * 4); }
#pragma unroll
            for (int m = 0; m < 4; ++m) { const int r = rw + ai * HALF + m * 16; const size_t off = (size_t)r * 1024 + col0; float s = 0.f;
#pragma unroll
                for (int bj = 0; bj < 2; ++bj)
#pragma unroll
                    for (int n = 0; n < 2; ++n) { const f32x4 o = xv[m][bj][n] + gv[bj][n] * acc[ai][bj][m][n];
                        *(f32x4*)(x1 + off + bj * HALF + n * 4) = o; s += (o[0] * o[0] + o[1] * o[1]) + (o[2] * o[2] + o[3] * o[3]); }
                s += __shfl_xor(s, 16); s += __shfl_xor(s, 32);
                if (fq == 0) rowsq[(size_t)r * 16 + u.pn * 4 + wc] = s; }
        }
    }
};
struct EpiMoeHid {
    static constexpr bool PERM = true, AFTER_DRAIN = false;
    bf16_t* hid;
    __device__ __forceinline__ void operator()(const f32x4 (&acc)[2][2][4][2], const Unit& u, int wr, int wc, int fr, int fq) const {
        const int rw = u.pm * BM + wr * 64 + fr, col0 = u.pn * 128 + wc * 32 + 8 * fq;
#pragma unroll
        for (int ai = 0; ai < 2; ++ai)
#pragma unroll
            for (int m = 0; m < 4; ++m) { f32x4 h[2];
#pragma unroll
                for (int n = 0; n < 2; ++n) { const f32x4 g = acc[ai][0][m][n], up = acc[ai][1][m][n];
#pragma unroll
                    for (int j = 0; j < 4; ++j) h[n][j] = g[j] * fast_sigmoid(g[j]) * up[j]; }
                *(u32x4*)(hid + (size_t)(rw + ai * HALF + m * 16) * 512 + col0) = pack8(h[0], h[1]); }
    }
};
struct EpiMoeDown {
    static constexpr bool PERM = true, AFTER_DRAIN = false;
    bf16_t* Yb; const int* list; const float* tokw; int Trows;
    __device__ __forceinline__ void operator()(const f32x4 (&acc)[2][2][4][2], const Unit& u, int wr, int wc, int fr, int fq) const {
        const int rl = wr * 64 + fr, col0 = u.pn * BM + wc * 32 + 8 * fq;
        int le[2][4]; float w[2][4];
#pragma unroll
        for (int ai = 0; ai < 2; ++ai)
#pragma unroll
            for (int m = 0; m < 4; ++m) { const int rr = rl + ai * HALF + m * 16; le[ai][m] = list[(size_t)u.e * Trows + u.lo + (rr < u.cnt ? rr : 0)]; }
#pragma unroll
        for (int ai = 0; ai < 2; ++ai)
#pragma unroll
            for (int m = 0; m < 4; ++m) { const int rr = rl + ai * HALF + m * 16; const float tw = tokw[le[ai][m]]; w[ai][m] = rr < u.cnt ? tw : 0.f; }
#pragma unroll
        for (int ai = 0; ai < 2; ++ai)
#pragma unroll
            for (int m = 0; m < 4; ++m) { const int rr = rl + ai * HALF + m * 16;
                bf16_t* rowp = Yb + (size_t)(u.pm * BM + rr) * 1024 + col0;
#pragma unroll
                for (int bj = 0; bj < 2; ++bj) *(u32x4*)(rowp + bj * HALF) = pack8(acc[ai][bj][m][0] * w[ai][m], acc[ai][bj][m][1] * w[ai][m]); }
    }
};

template <class Epi, class Sched, bool ALIGN_EPI = false, bool SP2 = false>
__device__ __forceinline__ void gemm_phase(PG8_LAS unsigned char* lds, const Gemm g, const Sched& S, const Epi& E) {
    const int tid = threadIdx.x, wid = __builtin_amdgcn_readfirstlane(tid >> 6), lane = tid & 63, wr = wid >> 2, wc = wid & 3, fr = lane & 15, fq = lane >> 4;
    const int K = g.K, nt = K / BK;
    unsigned voffB[2], CA2[2]; int RA[2];
#pragma unroll
    for (int i = 0; i < 2; ++i) { int R, C; stage_rc(tid * 16 + i * 8192, R, C); const int Rb = Epi::PERM ? ((R & ~31) + perm32(R & 31)) : R;
        RA[i] = R; CA2[i] = (unsigned)C * 2u; voffB[i] = (unsigned)(Rb * K + C) * 2u; }
    const unsigned K2 = (unsigned)K * 2u;
    const size_t kstep = (size_t)(BK * 2);
    const size_t hstep = (size_t)HALF * K * 2;
    const unsigned ldsw = (unsigned)wid * 1024u;
    const int aoff = lds_byte(wr * 64 + fr, fq * 8), boff = lds_byte(wc * 32 + fr, fq * 8);
#define PG8_SA(b, h) (((b) * 2 + (h)) * HTB)
#define PG8_SB(b, h) ((4 + (b) * 2 + (h)) * HTB)
#define PG8_STAGE(bufoff, gbase, voff) do { _Pragma("unroll") for (int _i = 0; _i < 2; ++_i) \
        __builtin_amdgcn_global_load_lds((const unsigned*)((const char*)(gbase) + (voff)[_i]), (PG8_LAS unsigned*)(lds + (bufoff) + ldsw + _i * 8192), 16, 0, 0); } while (0)
#define PG8_LDA(dst, b, h) do { _Pragma("unroll") for (int m = 0; m < 4; ++m) _Pragma("unroll") for (int k = 0; k < 2; ++k) dst[m][k] = *(const PG8_LAS bf16x8*)(lds + PG8_SA(b, h) + aoff + m * 2048 + k * 1024); } while (0)
#define PG8_LDB(dst, b, h) do { _Pragma("unroll") for (int n = 0; n < 2; ++n) _Pragma("unroll") for (int k = 0; k < 2; ++k) dst[n][k] = *(const PG8_LAS bf16x8*)(lds + PG8_SB(b, h) + boff + n * 2048 + k * 1024); } while (0)
#define PG8_MMA(ai, bj, At, Bt) do { __builtin_amdgcn_s_setprio(1); _Pragma("unroll") for (int m = 0; m < 4; ++m) _Pragma("unroll") for (int n = 0; n < 2; ++n) _Pragma("unroll") for (int k = 0; k < 2; ++k) \
        acc[ai][bj][m][n] = __builtin_amdgcn_mfma_f32_16x16x32_bf16(Bt[n][k], At[m][k], acc[ai][bj][m][n], 0, 0, 0); __builtin_amdgcn_s_setprio(0); } while (0)
#define PG8_WAIT_V(n) asm volatile("s_waitcnt vmcnt(" #n ")" ::: "memory")
#define PG8_WAIT_L(n) asm volatile("s_waitcnt lgkmcnt(" #n ")" ::: "memory")
#define PG8_BAR __builtin_amdgcn_s_barrier()
#define PG8_SCHED __builtin_amdgcn_sched_barrier(0)
    Unit cur, nxt; int ui = 0;
    if (!S.next(0, cur)) return;
    f32x4 acc[2][2][4][2];
#pragma unroll
    for (int a = 0; a < 2; ++a)
#pragma unroll
        for (int b = 0; b < 2; ++b)
#pragma unroll
            for (int m = 0; m < 4; ++m)
#pragma unroll
                for (int n = 0; n < 2; ++n) acc[a][b][m][n] = (f32x4){0.f, 0.f, 0.f, 0.f};
    bf16x8 At[4][2], B0[2][2], B1[2][2];
    unsigned vA0[2], vA1[2], nA0[2], nA1[2];
#pragma unroll
    for (int i = 0; i < 2; ++i) { vA0[i] = (unsigned)S.arow(0, cur, RA[i]) * K2 + CA2[i]; vA1[i] = (unsigned)S.arow(0, cur, HALF + RA[i]) * K2 + CA2[i]; }
    const char* const gA = (const char*)g.A; const char* cB = (const char*)g.Bt + (size_t)S.brow(cur) * K2;
    S.a_ready(cur);
    if constexpr (SP2) {
        PG8_STAGE(PG8_SB(0, 0), cB, voffB); PG8_STAGE(PG8_SB(0, 1), cB + hstep, voffB); PG8_STAGE(PG8_SA(0, 0), gA, vA0); PG8_STAGE(PG8_SA(0, 1), gA, vA1);
        if (wr == 1) PG8_BAR;
        PG8_WAIT_V(2); PG8_BAR;
        PG8_STAGE(PG8_SB(1, 0), cB + kstep, voffB); PG8_STAGE(PG8_SA(1, 0), gA + kstep, vA0); PG8_STAGE(PG8_SB(1, 1), cB + hstep + kstep, voffB);
        PG8_WAIT_V(6); PG8_BAR;
    } else {
        PG8_STAGE(PG8_SB(0, 0), cB, voffB); PG8_STAGE(PG8_SA(0, 0), gA, vA0); PG8_STAGE(PG8_SB(0, 1), cB + hstep, voffB); PG8_STAGE(PG8_SA(0, 1), gA, vA1);
        if (wr == 1) PG8_BAR;
        PG8_WAIT_V(4); PG8_BAR;
        PG8_STAGE(PG8_SB(1, 0), cB + kstep, voffB); PG8_STAGE(PG8_SA(1, 0), gA + kstep, vA0); PG8_STAGE(PG8_SB(1, 1), cB + hstep + kstep, voffB);
        PG8_WAIT_V(6); PG8_BAR;
    }
    for (;;) {
        const bool has_next = S.next(ui + 1, nxt);
#pragma unroll
        for (int i = 0; i < 2; ++i) { nA0[i] = has_next ? (unsigned)S.arow(ui + 1, nxt, RA[i]) * K2 + CA2[i] : vA0[i]; nA1[i] = has_next ? (unsigned)S.arow(ui + 1, nxt, HALF + RA[i]) * K2 + CA2[i] : vA1[i]; }
        const char* nB = has_next ? (const char*)g.Bt + (size_t)S.brow(nxt) * K2 : cB;
        for (int t = 0; t < nt; t += 2) {
            const bool last = (t == nt - 2);
            const char* a1 = gA + (size_t)(t + 1) * kstep;
            const char* a2 = last ? gA : gA + (size_t)(t + 2) * kstep; const unsigned x0[2] = {last ? nA0[0] : vA0[0], last ? nA0[1] : vA0[1]}, x1[2] = {last ? nA1[0] : vA1[0], last ? nA1[1] : vA1[1]}; const char* b2 = last ? nB : cB + (size_t)(t + 2) * kstep;
            const char* a3 = a2 + kstep; const char* b3 = b2 + kstep;
            if (last && has_next) S.a_ready(nxt);
            if constexpr (SP2) {
            PG8_LDB(B0, 0, 0); PG8_LDB(B1, 0, 1); PG8_SCHED; PG8_LDA(At, 0, 0); PG8_STAGE(PG8_SA(1, 1), a1, vA1);
            PG8_WAIT_V(8); PG8_WAIT_L(0); PG8_BAR; PG8_MMA(0, 0, At, B0); PG8_MMA(0, 1, At, B1); PG8_BAR; PG8_SCHED;
            PG8_LDA(At, 0, 1); PG8_STAGE(PG8_SB(0, 0), b2, voffB); PG8_STAGE(PG8_SB(0, 1), b2 + hstep, voffB); PG8_STAGE(PG8_SA(0, 0), a2, x0);
            PG8_WAIT_V(8); PG8_WAIT_L(0); PG8_BAR; PG8_MMA(1, 0, At, B0); PG8_MMA(1, 1, At, B1); PG8_BAR; PG8_SCHED;
            PG8_LDB(B0, 1, 0); PG8_LDB(B1, 1, 1); PG8_SCHED; PG8_LDA(At, 1, 0); PG8_STAGE(PG8_SA(0, 1), a2, x1);
            PG8_WAIT_V(8); PG8_WAIT_L(0); PG8_BAR; PG8_MMA(0, 0, At, B0); PG8_MMA(0, 1, At, B1); PG8_BAR; PG8_SCHED;
            PG8_LDA(At, 1, 1); PG8_STAGE(PG8_SB(1, 0), b3, voffB); PG8_STAGE(PG8_SB(1, 1), b3 + hstep, voffB); PG8_STAGE(PG8_SA(1, 0), a3, x0);
            PG8_WAIT_V(8); PG8_WAIT_L(0); PG8_BAR; PG8_MMA(1, 0, At, B0); PG8_MMA(1, 1, At, B1); PG8_BAR; PG8_SCHED;
            } else {
            PG8_LDB(B0, 0, 0); PG8_SCHED; PG8_LDA(At, 0, 0); PG8_STAGE(PG8_SA(1, 1), a1, vA1);
            PG8_WAIT_L(8); PG8_BAR; PG8_WAIT_L(0); PG8_MMA(0, 0, At, B0); PG8_BAR; PG8_SCHED;
            PG8_LDB(B1, 0, 1); PG8_STAGE(PG8_SB(0, 0), b2, voffB);
            PG8_BAR; PG8_WAIT_L(0); PG8_MMA(0, 1, At, B1); PG8_BAR;
            PG8_LDA(At, 0, 1); PG8_STAGE(PG8_SA(0, 0), a2, x0);
            PG8_BAR; PG8_WAIT_L(0); PG8_MMA(1, 0, At, B0); PG8_BAR; PG8_SCHED;
            PG8_STAGE(PG8_SB(0, 1), b2 + hstep, voffB);
            PG8_WAIT_V(6); PG8_BAR; PG8_MMA(1, 1, At, B1); PG8_BAR;
            PG8_LDB(B0, 1, 0); PG8_SCHED; PG8_LDA(At, 1, 0); PG8_STAGE(PG8_SA(0, 1), a2, x1);
            PG8_WAIT_L(8); PG8_BAR; PG8_WAIT_L(0); PG8_MMA(0, 0, At, B0); PG8_BAR; PG8_SCHED;
            PG8_LDB(B1, 1, 1); PG8_STAGE(PG8_SB(1, 0), b3, voffB);
            PG8_BAR; PG8_WAIT_L(0); PG8_MMA(0, 1, At, B1); PG8_BAR;
            PG8_LDA(At, 1, 1); PG8_STAGE(PG8_SA(1, 0), a3, x0);
            PG8_BAR; PG8_WAIT_L(0); PG8_MMA(1, 0, At, B0); PG8_BAR; PG8_SCHED;
            PG8_STAGE(PG8_SB(1, 1), b3 + hstep, voffB);
            PG8_WAIT_V(6); PG8_BAR; PG8_MMA(1, 1, At, B1); PG8_BAR;
            }
        }
        if constexpr (ALIGN_EPI) { if (wr == 0) PG8_BAR; }
        if constexpr (!Epi::AFTER_DRAIN) { E(acc, cur, wr, wc, fr, fq); S.done(cur); }
        if (!has_next) break;
#pragma unroll
        for (int a = 0; a < 2; ++a)
#pragma unroll
            for (int b = 0; b < 2; ++b)
#pragma unroll
                for (int m = 0; m < 4; ++m)
#pragma unroll
                    for (int n = 0; n < 2; ++n) acc[a][b][m][n] = (f32x4){0.f, 0.f, 0.f, 0.f};
        cur = nxt; cB = nB; ++ui;
#pragma unroll
        for (int i = 0; i < 2; ++i) { vA0[i] = nA0[i]; vA1[i] = nA1[i]; }
        if constexpr (ALIGN_EPI) { if (wr == 1) PG8_BAR; }
    }
    PG8_WAIT_V(0);
    if constexpr (!ALIGN_EPI) { if (wr == 0) PG8_BAR; }
    PG8_BAR;
    if constexpr (Epi::AFTER_DRAIN) { E.fused(acc, cur, wr, wc, fr, fq, lds, wid, lane); S.done(cur); }
#undef PG8_SA
#undef PG8_SB
#undef PG8_STAGE
#undef PG8_LDA
#undef PG8_LDB
#undef PG8_MMA
#undef PG8_WAIT_V
#undef PG8_WAIT_L
#undef PG8_BAR
#undef PG8_SCHED
}


}
namespace att {
typedef float f32x16 __attribute__((ext_vector_type(16)));
typedef short s16x4 __attribute__((ext_vector_type(4)));
typedef short v4i16_t __attribute__((ext_vector_type(4)));
typedef unsigned u32x4a __attribute__((ext_vector_type(4)));
constexpr int PITCH = 512;
constexpr int LDS_K = 0, LDS_V = 24576, LDS_WS = LDS_V + 4 * 16384, LDS_OST = LDS_WS + 2048, LDS_WT = LDS_OST + 8 * 4096, LDS_TOTAL = LDS_WT + 8 * 512, RES_V = 32768;
constexpr float THR = 5.0f;
__device__ __forceinline__ int crow(int r, int hi) { return (r & 3) + 8 * (r >> 2) + 4 * hi; }
__device__ __forceinline__ void glds16(const void* gsrc, unsigned lds_dst) { unsigned keep;
    asm volatile("s_mov_b32 %0, m0\n\ts_mov_b32 m0, %2\n\ts_nop 0\n\tglobal_load_lds_dwordx4 %1, off\n\ts_mov_b32 m0, %0" : "=&s"(keep) : "v"(gsrc), "s"(lds_dst) : "memory"); }
__device__ __forceinline__ f32x16 splat(float x) { f32x16 v;
#pragma unroll
    for (int r = 0; r < 16; ++r) v[r] = x;
    return v; }
typedef __attribute__((address_space(3))) const char* lds_cptr;
__device__ __forceinline__ s16x4 vtr(lds_cptr p) { return __builtin_bit_cast(s16x4, __builtin_amdgcn_ds_read_tr16_b64_v4i16((__attribute__((address_space(3))) v4i16_t*)p)); }
__device__ __forceinline__ float swapmax(float m) { auto rr = __builtin_amdgcn_permlane32_swap(__float_as_uint(m), __float_as_uint(m), false, false); return fmaxf(__uint_as_float(rr[0]), __uint_as_float(rr[1])); }
__device__ __forceinline__ float swapsum(float m) { auto rr = __builtin_amdgcn_permlane32_swap(__float_as_uint(m), __float_as_uint(m), false, false); return __uint_as_float(rr[0]) + __uint_as_float(rr[1]); }
__device__ __forceinline__ float max3a(float a, float b, float c) { float r; asm("v_max3_f32 %0, %1, %2, %3" : "=v"(r) : "v"(a), "v"(b), "v"(c)); return r; }
#define ATT_WAITBAR(N) asm volatile("s_waitcnt vmcnt(" #N ") lgkmcnt(0)\n\ts_barrier" ::: "memory")

template <int DV, int MODE, bool RES = false>
__device__ __forceinline__ void attn_unit(const int b, const int h, const int qb, const bf16* Qp, const bf16* __restrict__ Kp, const bf16* __restrict__ Vp, bf16* Op,
                                          const unsigned* __restrict__ sel, float* o1scr, const float lam, const float* __restrict__ subg, char* shm,
                                          const unsigned short* __restrict__ ql = nullptr, const int nvalid = 0, bf16* opart = nullptr, float* mlp = nullptr, const bool blk_sync = false) {
    constexpr bool MOBA = (MODE != 1);
    constexpr int ND = DV / 32;
    const int tid = threadIdx.x, lane = tid & 63, r32 = lane & 31, hi = lane >> 5;
    const int wid = __builtin_amdgcn_readfirstlane(tid >> 6);
    const long rowbase = (long)b * S; const int q0 = qb * 256;
    const unsigned lds0 = (unsigned)(uintptr_t)shm;
    float* wsf = (float*)(shm + LDS_WS) + wid * 64;
    const lds_cptr shm3 = (lds_cptr)shm;
    const int NT = (MODE == 3 && RES) ? (wid >> 1) + 1 : ((MODE >= 2) ? 4 : 4 * (qb + 1));
    const int wbase = (RES && MODE == 2) ? 0 : wid * 32;
    const int qrel = wbase + r32;
#pragma unroll 1
    for (int comp = 0; comp < (MOBA ? 1 : 2); ++comp) {
        const int qkcol = MOBA ? h * 64 : (2 * h + comp) * 64, vcol = MOBA ? h * 64 : h * 128;
        const bf16* Kh = Kp + rowbase * PITCH + qkcol; const bf16* Vh = Vp + rowbase * PITCH + vcol;
        const bf16* ksrc = Kh + (long)lane * PITCH + wid * 8;
        const bf16* vsrc = Vh + (long)(16 * (wid & 3) + (lane >> 2)) * PITCH + (wid >> 2) * 32 + (lane & 3) * 8;
        const unsigned kdst = lds0 + LDS_K + wid * 1024, vdst = lds0 + LDS_V + wid * 1024;
#define ATT_KR0(n) (MODE == 2 ? q0 + 64 * (n) : ((n) < 4 ? q0 + 64 * (n) : 64 * ((n) - 4)))
#define ATT_DMA(n, ks_, vs_) do { const long kr_ = ATT_KR0(n); glds16(ksrc + kr_ * PITCH, (unsigned)__builtin_amdgcn_readfirstlane(kdst + (ks_) * 8192)); \
        glds16(vsrc + kr_ * PITCH, (unsigned)__builtin_amdgcn_readfirstlane(vdst + (vs_) * 16384)); \
        if (DV == 128) glds16(vsrc + kr_ * PITCH + 64, (unsigned)__builtin_amdgcn_readfirstlane(vdst + (vs_) * 16384 + 8192)); } while (0)
        if (!RES) { ATT_DMA(0, 0, 0); ATT_DMA(1, 1, 1); }
        int qi = q0 + qrel;
        if (MODE == 2) qi = (int)ql[qrel < nvalid ? qrel : 0];
        const bf16* Qw = Qp + (rowbase + qi) * PITCH + qkcol;
        bf16x8 qr[4];
#pragma unroll
        for (int d0 = 0; d0 < 4; ++d0) qr[d0] = *reinterpret_cast<const bf16x8*>(&Qw[d0 * 16 + hi * 8]);
        unsigned smq3 = 0u; float2 ml3[3] = {make_float2(-INFINITY, 0.f), make_float2(-INFINITY, 0.f), make_float2(-INFINITY, 0.f)};
        if (MODE == 3 && lane < 32) { const size_t qx = (size_t)(b * 8 + h) * S + q0 + wid * 32 + lane; smq3 = sel[qx]; const int ns = __popc(smq3);
#pragma unroll
            for (int k = 0; k < 3; ++k) if (k < ns) ml3[k] = *(const float2*)(mlp + (qx * 3 + k) * 2); }
        if (RES && blk_sync) asm volatile("s_waitcnt vmcnt(0)\n\ts_barrier" ::: "memory");
        float mref = 0.f;
        f32x16 ol = splat(0.f);
        const bf16x8 ones = (bf16x8){0x3F80, 0x3F80, 0x3F80, 0x3F80, 0x3F80, 0x3F80, 0x3F80, 0x3F80};
        f32x16 o[ND];
#pragma unroll
        for (int d = 0; d < ND; ++d) o[d] = splat(0.f);
        int slot = 0, vslot = 0;
        u32x4a pw[4];
        constexpr int NPV = 4 * ND, NM = 4 + NPV;
        const int vlane = ((lane >> 4) & 1) * 32 + (lane & 3) * 8 + (4 * hi + ((lane & 15) >> 2)) * 64;
#define ATT_KLD(d0) do { kf[2 * (d0)] = *(const __attribute__((address_space(3))) bf16x8*)(kb + (d0) * 2048); kf[2 * (d0) + 1] = *(const __attribute__((address_space(3))) bf16x8*)(kb + (d0) * 2048 + 512); } while (0)
#define ATT_QK(P0, P1) do { const lds_cptr kb = shm3 + LDS_K + slot * 8192 + hi * 1024 + r32 * 16; bf16x8 kf[8]; \
        ATT_KLD(0); ATT_KLD(1); if (DV == 64) { ATT_KLD(2); ATT_KLD(3); } \
        const f32x16 cop = splat(-mref); __builtin_amdgcn_sched_barrier(0);   \
        P0 = __builtin_amdgcn_mfma_f32_32x32x16_bf16(kf[0], qr[0], cop, 0, 0, 0); P1 = __builtin_amdgcn_mfma_f32_32x32x16_bf16(kf[1], qr[0], cop, 0, 0, 0); \
        if (DV == 128) { ATT_KLD(2); ATT_KLD(3); __builtin_amdgcn_sched_barrier(0); } \
        _Pragma("unroll") for (int d0 = 1; d0 < 4; ++d0) { P0 = __builtin_amdgcn_mfma_f32_32x32x16_bf16(kf[2 * d0], qr[d0], P0, 0, 0, 0); P1 = __builtin_amdgcn_mfma_f32_32x32x16_bf16(kf[2 * d0 + 1], qr[d0], P1, 0, 0, 0); } } while (0)
#define ATT_MASK(P0, P1, n) do { if (MODE != 2 && (n) < 4 && (64 * (n) + 63 > wid * 32)) { const int kb0 = 64 * (n) + 4 * hi; \
        _Pragma("unroll") for (int r = 0; r < 16; ++r) { const int kv = kb0 + (r & 3) + 8 * (r >> 2); if (kv > qrel) P0[r] = -INFINITY; if (kv + 32 > qrel) P1[r] = -INFINITY; } } } while (0)
#define ATT_ROWMAX(P0, P1, RM) do { asm volatile("s_nop 15\n\ts_nop 7" : "+v"(P0), "+v"(P1)); \
        float a_ = max3a(P0[0], P0[1], P1[0]), b_ = max3a(P0[2], P0[3], P1[1]); a_ = max3a(a_, P1[2], P1[3]); \
        _Pragma("unroll") for (int r = 4; r < 16; r += 4) { a_ = max3a(a_, P0[r], P0[r + 1]); b_ = max3a(b_, P0[r + 2], P0[r + 3]); a_ = max3a(a_, P1[r], P1[r + 1]); b_ = max3a(b_, P1[r + 2], P1[r + 3]); } \
        RM = swapmax(fmaxf(a_, b_)); } while (0)
#define ATT_VOFF(j) (((j) >> 2) * 4096 + ((j) & 3) * 1024)
        { if (!RES) { if (DV == 128) ATT_WAITBAR(3); else ATT_WAITBAR(2); ATT_DMA(2, 2, 2); }
          f32x16 p0, p1; ATT_QK(p0, p1); ATT_MASK(p0, p1, 0);
          float rm; ATT_ROWMAX(p0, p1, rm); mref = rm;
#pragma unroll
          for (int r = 0; r < 16; ++r) { p0[r] = __builtin_amdgcn_exp2f(p0[r] - rm); p1[r] = __builtin_amdgcn_exp2f(p1[r] - rm); }
#pragma unroll
          for (int k = 0; k < 2; ++k)
#pragma unroll
              for (int j = 0; j < 4; ++j) { pw[k][j] = pg8::cvt_pk_bf16(p0[8 * k + 2 * j], p0[8 * k + 2 * j + 1]); pw[2 + k][j] = pg8::cvt_pk_bf16(p1[8 * k + 2 * j], p1[8 * k + 2 * j + 1]); }
          slot = 1; vslot = 1; }
#pragma unroll 1
        for (int n = 1; n < NT; ++n) {
            if (!RES) { if (n + 1 < NT) { if (DV == 128) ATT_WAITBAR(3); else ATT_WAITBAR(2); } else ATT_WAITBAR(0);
                if (n + 2 < NT) { const int s2 = slot + 2 >= 3 ? slot - 1 : slot + 2; ATT_DMA(n + 2, s2, (vslot + 2) & 3); } }
            f32x16 p0, p1; ATT_QK(p0, p1); ATT_MASK(p0, p1, n);
            float rm; ATT_ROWMAX(p0, p1, rm);
            bool resc = false; float fsc = 1.f;
            if (__any(rm > THR)) {
                const float dl = fmaxf(rm, 0.f); mref += dl; fsc = __builtin_amdgcn_exp2f(-dl); resc = true;
#pragma unroll
                for (int r = 0; r < 16; ++r) { p0[r] -= dl; p1[r] -= dl; } }
            { const lds_cptr vp = shm3 + (RES ? RES_V + ((vslot + 3) & 3) * 8192 : LDS_V + ((vslot + 3) & 3) * 16384) + vlane;
              s16x4 vlo[4], vhi[4]; u32x4a pwn[4];
#pragma unroll
              for (int j = 0; j < 4; ++j) { vlo[j] = vtr(vp + ATT_VOFF(j)); vhi[j] = vtr(vp + ATT_VOFF(j) + 512); }
              __builtin_amdgcn_sched_barrier(0);
#pragma unroll
              for (int g = 0; g < NM; ++g) {
                  if (g < 4) ol = __builtin_amdgcn_mfma_f32_32x32x16_bf16(__builtin_bit_cast(bf16x8, pw[g]), ones, ol, 0, 0, 0);
                  else { const int j = g - 4; const bf16x8 vf = (bf16x8){vlo[j & 3][0], vlo[j & 3][1], vlo[j & 3][2], vlo[j & 3][3], vhi[j & 3][0], vhi[j & 3][1], vhi[j & 3][2], vhi[j & 3][3]};
                      o[j >> 2] = __builtin_amdgcn_mfma_f32_32x32x16_bf16(__builtin_bit_cast(bf16x8, pw[j & 3]), vf, o[j >> 2], 0, 0, 0);
                      if (j + 4 < NPV) { vlo[j & 3] = vtr(vp + ATT_VOFF(j + 4)); vhi[j & 3] = vtr(vp + ATT_VOFF(j + 4) + 512); } }
                  const int npair = (DV == 128) ? (g < 16 ? 1 : 0) : (g < 4 ? 2 : 1);
                  const int pbase = (DV == 128) ? g : (g < 4 ? 2 * g : g + 4);
#pragma unroll
                  for (int q2 = 0; q2 < npair; ++q2) { const int pi = pbase + q2;
                      const float ea = __builtin_amdgcn_exp2f(pi < 8 ? p0[2 * pi] : p1[2 * pi - 16]), eb = __builtin_amdgcn_exp2f(pi < 8 ? p0[2 * pi + 1] : p1[2 * pi - 15]);
                      pwn[pi >> 2][pi & 3] = pg8::cvt_pk_bf16(ea, eb); }
                  __builtin_amdgcn_sched_barrier(0);
              }
#pragma unroll
              for (int k = 0; k < 4; ++k) pw[k] = pwn[k]; }
            if (resc) {
                if (hi == 0) wsf[r32] = fsc;
                asm volatile("s_waitcnt lgkmcnt(0)" ::: "memory");
#pragma unroll
                for (int r = 0; r < 16; ++r) { const float fr = wsf[crow(r, hi)]; ol[r] *= fr;
#pragma unroll
                    for (int d = 0; d < ND; ++d) o[d][r] *= fr; }
            }
            slot = RES ? slot + 1 : (slot == 2 ? 0 : slot + 1); vslot = (vslot + 1) & 3;
        }
        { const lds_cptr vp = shm3 + (RES ? RES_V + ((vslot + 3) & 3) * 8192 : LDS_V + ((vslot + 3) & 3) * 16384) + vlane;
#pragma unroll
          for (int ks = 0; ks < 4; ++ks) ol = __builtin_amdgcn_mfma_f32_32x32x16_bf16(__builtin_bit_cast(bf16x8, pw[ks]), ones, ol, 0, 0, 0);
#pragma unroll
          for (int j = 0; j < NPV; ++j) { const s16x4 vlo = vtr(vp + ATT_VOFF(j)), vhi = vtr(vp + ATT_VOFF(j) + 512);
              const bf16x8 vf = (bf16x8){vlo[0], vlo[1], vlo[2], vlo[3], vhi[0], vhi[1], vhi[2], vhi[3]};
              o[j >> 2] = __builtin_amdgcn_mfma_f32_32x32x16_bf16(__builtin_bit_cast(bf16x8, pw[j & 3]), vf, o[j >> 2], 0, 0, 0);
              if ((j & 7) == 7) __builtin_amdgcn_sched_barrier(0); } }
#undef ATT_QK
#undef ATT_KLD
#undef ATT_MASK
#undef ATT_ROWMAX
#undef ATT_VOFF
        int lane_e = lane, q0_e = q0 + wbase, h_e = h; asm volatile("" : "+v"(lane_e), "+v"(q0_e), "+v"(h_e));
        float rli[16];
#pragma unroll
        for (int r = 0; r < 16; ++r) rli[r] = __builtin_amdgcn_rcpf(ol[r]);
        bf16* stg = (bf16*)(shm + LDS_OST) + wid * 2048;
        if (MOBA) {
#pragma unroll
            for (int r = 0; r < 16; ++r) { const int orow = crow(r, hi);
#pragma unroll
                for (int d = 0; d < 2; ++d) stg[orow * 64 + d * 32 + (lane_e & 31)] = (bf16)f2bf(o[d][r] * rli[r]); }
            if (MODE == 0) {
                asm volatile("s_waitcnt lgkmcnt(0)" ::: "memory");
                bf16* Ow = Op + (rowbase + q0_e) * PITCH + h_e * 64;
#pragma unroll
                for (int i = 0; i < 4; ++i) { const int row = i * 8 + (lane_e >> 3), ch = lane_e & 7; const u32x4a v = *(const u32x4a*)(stg + row * 64 + ch * 8); *(u32x4a*)(Ow + (long)row * PITCH + ch * 8) = v; }
            } else {
                if ((lane_e & 31) == 0) {
#pragma unroll
                    for (int r = 0; r < 16; ++r) wsf[crow(r, hi)] = ol[r]; }
                int* dtab = (int*)wsf + 32;
                float* wt = (float*)(shm + LDS_WT) + wid * 128;
                asm volatile("s_waitcnt lgkmcnt(0)" ::: "memory");
                const size_t bhq = (size_t)(b * 8 + h_e) * S;
                if (MODE == 2) {
                    if (lane_e < 32) { const int slotr = (q0_e - q0) + lane_e; const int qq = (int)ql[slotr < nvalid ? slotr : 0];
                        int d = -1;
                        if (slotr < nvalid) { const unsigned smq = sel[bhq + qq]; d = (int)((bhq + qq) * 3) + __popc(smq & ((1u << qb) - 1u));
                            *(float2*)(mlp + (size_t)d * 2) = make_float2(mref, wsf[lane_e]); }
                        dtab[lane_e] = d; }
                    asm volatile("s_waitcnt lgkmcnt(0)" ::: "memory");
#pragma unroll
                    for (int i = 0; i < 4; ++i) { const int row = i * 8 + (lane_e >> 3), ch = lane_e & 7; const int d = dtab[row];
                        if (d >= 0) { const u32x4a v = *(const u32x4a*)(stg + row * 64 + ch * 8); *(u32x4a*)(opart + (size_t)d * 64 + ch * 8) = v; } }
                } else {
                    u32x4a pv[4][3];
#pragma unroll
                    for (int i = 0; i < 4; ++i) { const int row = i * 8 + (lane_e >> 3), ch = lane_e & 7; const bf16* pp = opart + ((bhq + q0_e + row) * 3) * 64 + ch * 8;
#pragma unroll
                        for (int k = 0; k < 3; ++k) pv[i][k] = *(const u32x4a*)(pp + k * 64); }
                    if (lane_e < 32) { const int ns = __popc(smq3);
                        const float md = mref, ld = wsf[lane_e];
                        float M = md;
#pragma unroll
                        for (int k = 0; k < 3; ++k) if (k < ns) M = fmaxf(M, ml3[k].x);
                        float wd = ld * __builtin_amdgcn_exp2f(md - M), wk[3], tot = wd;
#pragma unroll
                        for (int k = 0; k < 3; ++k) { wk[k] = (k < ns) ? ml3[k].y * __builtin_amdgcn_exp2f(ml3[k].x - M) : 0.f; tot += wk[k]; }
                        const float inv = 1.f / tot;
                        *(f32x4*)(wt + lane_e * 4) = (f32x4){wd * inv, wk[0] * inv, wk[1] * inv, wk[2] * inv}; }
                    asm volatile("s_waitcnt lgkmcnt(0)" ::: "memory");
                    bf16* Ow = Op + (rowbase + q0_e) * PITCH + h_e * 64;
#pragma unroll
                    for (int i = 0; i < 4; ++i) { const int row = i * 8 + (lane_e >> 3), ch = lane_e & 7;
                        const f32x4 a = *(const f32x4*)(wt + row * 4); const u32x4a v = *(const u32x4a*)(stg + row * 64 + ch * 8);
                        f32x4 x0 = pg8::bflo(v.x, v.y) * a[0], x1 = pg8::bflo(v.z, v.w) * a[0];
#pragma unroll
                        for (int k = 0; k < 3; ++k) { const bool on = a[1 + k] != 0.f; const f32x4 y0 = pg8::bflo(pv[i][k].x, pv[i][k].y) * a[1 + k], y1 = pg8::bflo(pv[i][k].z, pv[i][k].w) * a[1 + k];
#pragma unroll
                            for (int e = 0; e < 4; ++e) { x0[e] += on ? y0[e] : 0.f; x1[e] += on ? y1[e] : 0.f; } }
                        *(u32x4a*)(Ow + (long)row * PITCH + ch * 8) = pg8::pack8(x0, x1); }
                }
            }
        } else {
            float* scr = o1scr + (size_t)comp * 32768 + (size_t)wid * 4096 + lane_e;
#pragma unroll
            for (int d = 0; d < ND; ++d) { float* sp = scr + d * 1024; asm volatile("" : "+v"(sp));
#pragma unroll
                for (int r = 0; r < 16; ++r) sp[r * 64] = o[d][r] * rli[r]; }
            if (comp == 1) {
                asm volatile("s_waitcnt vmcnt(0)" ::: "memory");
                const int row = lane_e >> 1, hf = lane_e & 1;
                const int hi_r = (row >> 2) & 1, rr = (row & 3) | ((row >> 3) << 2);
                const float* A0 = o1scr + (size_t)wid * 4096 + rr * 64 + hi_r * 32 + hf * 2048;
                const float* B0 = A0 + 32768;
                f32x4 v[16]; float ssq = 0.f;
#pragma unroll
                for (int d2 = 0; d2 < 2; ++d2)
#pragma unroll
                    for (int c4 = 0; c4 < 8; ++c4) { const f32x4 a = __builtin_nontemporal_load((const f32x4*)(A0 + d2 * 1024 + c4 * 4)), bb = __builtin_nontemporal_load((const f32x4*)(B0 + d2 * 1024 + c4 * 4));
                        const f32x4 w = a - bb * lam; v[d2 * 8 + c4] = w; ssq += (w[0] * w[0] + w[1] * w[1]) + (w[2] * w[2] + w[3] * w[3]); }
                ssq += __shfl_xor(ssq, 1);
                const float rstd = rsqrtf(ssq * (1.f / 128.f) + EPS) * 0.8f;
                bf16* Ow = Op + (rowbase + q0_e + row) * PITCH + h_e * 128 + hf * 64;
#pragma unroll
                for (int k = 0; k < 8; ++k) { const f32x4 g0 = *(const f32x4*)(subg + hf * 64 + k * 8), g1 = *(const f32x4*)(subg + hf * 64 + k * 8 + 4);
                    *(u32x4a*)(Ow + k * 8) = pg8::pack8(v[2 * k] * g0 * rstd, v[2 * k + 1] * g1 * rstd); }
            }
        }
        if (RES) asm volatile("s_waitcnt lgkmcnt(0)" ::: "memory"); else
        asm volatile("s_waitcnt vmcnt(0) lgkmcnt(0)\n\ts_barrier" ::: "memory");
    }
#undef ATT_KR0
#undef ATT_DMA
}
__device__ __forceinline__ void moba_block_issue(const bf16* __restrict__ Kp, const bf16* __restrict__ Vp, const int b, const int h, const int blk, char* shm) {
    const int tid = threadIdx.x, lane = tid & 63; const int wid = __builtin_amdgcn_readfirstlane(tid >> 6);
    const unsigned lds0 = (unsigned)(uintptr_t)shm;
    const bf16* ksrc = Kp + ((long)b * S + 256 * blk + lane) * PITCH + h * 64 + wid * 8;
    const bf16* vsrc = Vp + ((long)b * S + 256 * blk + 16 * (wid & 3) + (lane >> 2)) * PITCH + h * 64 + (wid >> 2) * 32 + (lane & 3) * 8;
    asm volatile("s_waitcnt lgkmcnt(0)\n\ts_barrier" ::: "memory");
#pragma unroll
    for (int n = 0; n < 4; ++n) { glds16(ksrc + (long)(64 * n) * PITCH, (unsigned)__builtin_amdgcn_readfirstlane(lds0 + n * 8192 + wid * 1024));
        glds16(vsrc + (long)(64 * n) * PITCH, (unsigned)__builtin_amdgcn_readfirstlane(lds0 + RES_V + n * 8192 + wid * 1024)); }
}
}

__device__ __forceinline__ float wave_sum(float v) {
#pragma unroll
    for (int o = 1; o < 64; o <<= 1) v += __shfl_xor(v, o);
    return v;
}
__device__ __forceinline__ void gate_wave(int b, int h, int chunk, int lane, const bf16* __restrict__ Qm, const LAS float* ksl, unsigned* __restrict__ sel, unsigned* qcnt, unsigned short* qlist) {
    const int qpos = chunk * 64 + lane, blk = chunk >> 2;
    const size_t t = (size_t)b * S + qpos;
    float q[64];
#pragma unroll
    for (int d8 = 0; d8 < 8; ++d8) { const v4u v = *(const v4u*)(Qm + t * 512 + h * 64 + d8 * 8);
        q[d8 * 8] = __uint_as_float(v.x << 16); q[d8 * 8 + 1] = __uint_as_float(v.x & 0xffff0000u); q[d8 * 8 + 2] = __uint_as_float(v.y << 16); q[d8 * 8 + 3] = __uint_as_float(v.y & 0xffff0000u);
        q[d8 * 8 + 4] = __uint_as_float(v.z << 16); q[d8 * 8 + 5] = __uint_as_float(v.z & 0xffff0000u); q[d8 * 8 + 6] = __uint_as_float(v.w << 16); q[d8 * 8 + 7] = __uint_as_float(v.w & 0xffff0000u); }
    float v0 = -3e38f, v1 = -3e38f, v2 = -3e38f; int i0 = -1, i1 = -1, i2 = -1;
    for (int j = 0; j < blk; ++j) {
        const LAS f32x4* kr = (const LAS f32x4*)(ksl + j * 64);
        float g = 0.f;
#pragma unroll
        for (int d4 = 0; d4 < 16; ++d4) { const f32x4 kv = kr[d4]; g += q[4 * d4] * kv[0] + q[4 * d4 + 1] * kv[1] + q[4 * d4 + 2] * kv[2] + q[4 * d4 + 3] * kv[3]; }
        if (g > v0) { v2 = v1; i2 = i1; v1 = v0; i1 = i0; v0 = g; i0 = j; }
        else if (g > v1) { v2 = v1; i2 = i1; v1 = g; i1 = j; }
        else if (g > v2) { v2 = g; i2 = j; }
    }
    unsigned m = 0u;
    if (i0 >= 0) m |= 1u << i0;
    if (i1 >= 0) m |= 1u << i1;
    if (i2 >= 0) m |= 1u << i2;
    sel[(size_t)(b * 8 + h) * S + qpos] = m;
    if (qcnt) {
        const int bh = b * 8 + h;
        int myc = 0;
        for (int j = 0; j < blk; ++j) { const unsigned long long bal = __ballot((m >> j) & 1u); if (lane == j) myc = (int)__popcll(bal); }
        int mybase = 0; if (lane < blk && myc) mybase = (int)atomicAdd(qcnt + bh * 32 + lane, (unsigned)myc);
        for (int j = 0; j < blk; ++j) { const bool sj = (m >> j) & 1u; const unsigned long long bal = __ballot(sj); const int base = __shfl(mybase, j);
            if (sj) qlist[(size_t)bh * QL_PER_BH + 256 * (31 * j - (j * (j - 1)) / 2) + base + __popcll(bal & ((1ull << lane) - 1ull))] = (unsigned short)qpos; }
    }
}
constexpr int NWAVES = 8;
constexpr int RING_OFF = 0, RING_BYTES = 131072;
constexpr int LDSCTL_OFF = RING_BYTES, MISC_OFF = LDSCTL_OFF + 320;
constexpr int TBL_OFF = LDSCTL_OFF + 512;
constexpr int ROWTAB_OFF = LDSCTL_OFF + 2048;
static_assert(att::LDS_TOTAL <= RING_BYTES && pg8::STAGE_BYTES <= RING_BYTES, "phase scratch fits the ring region");
constexpr int LDS_BYTES = 147456;
constexpr int CW_BAR = 4096;

struct Frame {
    LAS unsigned char* lds;
    volatile LAS unsigned* MISC;
    gu32* ctl;
    int tid, lane, wave, vcu, G;
};
struct Args { const float* in[23]; float* out; unsigned char* ws; int ph_lo, ph_hi, li, pad; };

template <int MODE> __device__ __forceinline__ int wmap(int c) {
    if (MODE == 1) { const int pn = c >> 8; const bool rp = (pn < 4) || (pn >= 6 && pn < 10); if (!rp) return c; const int o = c & 255; return (pn << 8) + (((o >> 5) & 1) << 7) + ((o >> 6) << 5) + (o & 31); }
    if (MODE == 2) return ((c >> 7) << 8) + (c & 127);
    if (MODE == 3) return ((c >> 7) << 8) + 128 + (c & 127);
    return c;
}
struct TrItem { const float* W; bf16* WT; int K, N, mode, item; };
__device__ __forceinline__ void tr_load(const TrItem& it, int lane, f32x4 (&v)[8]) {
    const int nblk = it.N / 32, kb = it.item / nblk, nb = it.item % nblk;
    const float* p = it.W + (size_t)(64 * kb + (lane >> 3)) * it.N + 32 * nb + 4 * (lane & 7);
#pragma unroll
    for (int i = 0; i < 8; ++i) v[i] = *(const GAS f32x4*)(p + (size_t)(8 * i) * it.N);
}
__device__ __forceinline__ void tr_store(const TrItem& it, int lane, const f32x4 (&v)[8], LAS float* scr) {
    const int nblk = it.N / 32, kb = it.item / nblk, nb = it.item % nblk, k0 = 64 * kb, n0 = 32 * nb;
#pragma unroll
    for (int i = 0; i < 8; ++i) { LAS float* d = scr + (8 * i + (lane >> 3)) * 33 + 4 * (lane & 7); d[0] = v[i][0]; d[1] = v[i][1]; d[2] = v[i][2]; d[3] = v[i][3]; }
    LDS_WAIT(); asm volatile("" ::: "memory");
    const int c = lane & 7;
#pragma unroll
    for (int j = 0; j < 4; ++j) { const int n = (lane >> 3) + 8 * j; const LAS float* s = scr + (8 * c) * 33 + n;
        v4u o; o.x = pk2(s[0 * 33], s[1 * 33]); o.y = pk2(s[2 * 33], s[3 * 33]); o.z = pk2(s[4 * 33], s[5 * 33]); o.w = pk2(s[6 * 33], s[7 * 33]);
        const int cc = n0 + n; const int row = it.mode == 1 ? wmap<1>(cc) : (it.mode == 2 ? wmap<2>(cc) : (it.mode == 3 ? wmap<3>(cc) : cc));
        *(GAS v4u*)(it.WT + (size_t)row * it.K + k0 + 8 * c) = o; }
    LDS_WAIT(); asm volatile("" ::: "memory");
}
__device__ __forceinline__ float silu_f(float v) { return v / (1.f + __expf(-v)); }

__device__ __forceinline__ void p0_prologue(Frame& F, const Args& args) {
    unsigned char* ws = args.ws;
    const int gw = F.vcu * NWAVES + F.wave, NGW = F.G * NWAVES, gt = gw * 64 + F.lane, NGT = NGW * 64;
    { const float* c = args.in[1]; const float* w = args.in[2]; float* modp = (float*)(ws + WS_MODP);
      LAS float* act = (LAS float*)(F.lds + RING_OFF + F.wave * 16384);
      for (int task = gw; task < 768; task += NGW) { const int n = (task % 96) * 64 + F.lane, ks = task / 96;
#pragma unroll
          for (int i = 0; i < 8; ++i) { const int idx = F.lane + 64 * i, bb = idx >> 7, kk = idx & 127; act[idx] = silu_f(c[bb * 1024 + ks * 128 + kk]); }
          LDS_WAIT(); asm volatile("" ::: "memory");
          float a0 = 0.f, a1 = 0.f, a2 = 0.f, a3 = 0.f;
#pragma unroll 8
          for (int kk = 0; kk < 128; ++kk) { const float wv = w[(size_t)(ks * 128 + kk) * 6144 + n];
              a0 += act[kk] * wv; a1 += act[128 + kk] * wv; a2 += act[256 + kk] * wv; a3 += act[384 + kk] * wv; }
          modp[(size_t)(ks * 4 + 0) * 6144 + n] = a0; modp[(size_t)(ks * 4 + 1) * 6144 + n] = a1; modp[(size_t)(ks * 4 + 2) * 6144 + n] = a2; modp[(size_t)(ks * 4 + 3) * 6144 + n] = a3;
          LDS_WAIT(); asm volatile("" ::: "memory"); } }
    { float2* tab = (float2*)(ws + WS_ROPE);
      for (int idx = gt; idx < S * 32; idx += NGT) { const int pos = idx >> 5, i = idx & 31;
          const float e = (float)(2 * i) / 64.f; const float inv = 1.0f / powf(10000.f, e); const float ang = (float)pos * inv;
          const double a = (double)ang; const double TWO_PI = 6.283185307179586476925286766559;
          const double n = rint(a / TWO_PI); const double r = a - n * TWO_PI; const double r2 = r * r;
          double sn = 0.0, cs = 0.0, ts = r, tc = 1.0;
          for (int k = 0; k < 16; ++k) { cs += tc; sn += ts; tc *= -r2 / (double)((2 * k + 1) * (2 * k + 2)); ts *= -r2 / (double)((2 * k + 2) * (2 * k + 3)); }
          tab[idx] = make_float2((float)cs, (float)sn); } }
    if (gt == 0) { float s1 = 0.f, s2 = 0.f; for (int i = 0; i < 64; ++i) { s1 += args.in[6][i] * args.in[7][i]; s2 += args.in[8][i] * args.in[9][i]; }
        *(float*)(ws + WS_LAM) = expf(s1) - expf(s2) + 0.2f; }
    { bf16* wr = (bf16*)(ws + WS_WR); const float* wg = args.in[15]; const float* we = args.in[17];
      for (int idx = gt; idx < 32 * 3 * 64 * 8; idx += NGT) { const int s = idx & 7, ln = (idx >> 3) & 63, nt = (idx >> 9) % 3, uu = idx / 1536;
          const int k = 32 * uu + 8 * (ln >> 4) + s, col = 16 * nt + (ln & 15);
          const float w = col < 4 ? wg[k * 4 + col] : (col < 36 ? we[k * 32 + col - 4] : 0.f);
          const unsigned hi = f2bf(w); const float rem = w - __uint_as_float(hi << 16);
          wr[idx] = (bf16)hi; wr[49152 + idx] = (bf16)f2bf(rem); } }
    LAS float* scr = (LAS float*)(F.lds + RING_OFF + F.wave * 16384);
    constexpr int I_IN = 16 * 160, I_PM = 8 * 32, I_PD = 8 * 32, I_OUT = 16 * 32, I_G = 32 * 256, I_U = 32 * 256, I_D = 32 * 256;
    constexpr int NITEMS = I_IN + I_PM + I_PD + I_OUT + I_G + I_U + I_D;
    unsigned char* wsb = ws;
#define TR_DECODE(IT, OUT) do { int r = (IT); \
        if (r < I_IN) { OUT = TrItem{args.in[5], (bf16*)(wsb + WS_WIN), 1024, 5120, 1, r}; break; } r -= I_IN; \
        if (r < I_PM) { OUT = TrItem{args.in[11], (bf16*)(wsb + WS_WPM), 512, 1024, 0, r}; break; } r -= I_PM; \
        if (r < I_PD) { OUT = TrItem{args.in[12], (bf16*)(wsb + WS_WPD), 512, 1024, 0, r}; break; } r -= I_PD; \
        if (r < I_OUT) { OUT = TrItem{args.in[13], (bf16*)(wsb + WS_WOUT), 1024, 1024, 0, r}; break; } r -= I_OUT; \
        if (r < I_G) { const int e = r >> 8; OUT = TrItem{args.in[19] + (size_t)e * 1024 * 512, (bf16*)(wsb + WS_WGU) + (size_t)e * 1024 * 1024, 1024, 512, 2, r & 255}; break; } r -= I_G; \
        if (r < I_U) { const int e = r >> 8; OUT = TrItem{args.in[20] + (size_t)e * 1024 * 512, (bf16*)(wsb + WS_WGU) + (size_t)e * 1024 * 1024, 1024, 512, 3, r & 255}; break; } r -= I_U; \
        { const int e = r >> 8; OUT = TrItem{args.in[21] + (size_t)e * 512 * 1024, (bf16*)(wsb + WS_WD) + (size_t)e * 1024 * 512, 512, 1024, 0, r & 255}; } } while (0)
    if (gw < NITEMS) {
        TrItem cur; TR_DECODE(gw, cur);
        f32x4 va[8], vb[8];
        tr_load(cur, F.lane, va);
        for (int it = gw; it < NITEMS; it += 2 * NGW) {
            TrItem nx1 = cur; const bool h1 = it + NGW < NITEMS; if (h1) { TR_DECODE(it + NGW, nx1); tr_load(nx1, F.lane, vb); }
            tr_store(cur, F.lane, va, scr);
            if (!h1) break;
            TrItem nx2 = nx1; const bool h2 = it + 2 * NGW < NITEMS; if (h2) { TR_DECODE(it + 2 * NGW, nx2); tr_load(nx2, F.lane, va); }
            tr_store(nx1, F.lane, vb, scr);
            if (!h2) break;
            cur = nx2;
        }
    }
#undef TR_DECODE
}
__device__ __forceinline__ void p1_xn(Frame& F, const Args& args) {
    unsigned char* ws = args.ws;
    LAS float* tA = (LAS float*)(F.lds + RING_OFF); LAS float* tS = tA + 1024;
    const int w = blockIdx.x, b = (w * 128) / S;
    const float* modp = (const float*)(ws + WS_MODP); const float* b_ada = args.in[3]; const float* g1n = args.in[4];
    for (int d = F.tid; d < 1024; d += NWAVES * 64) { float sc = b_ada[1024 + d], sh = b_ada[d];
#pragma unroll
        for (int p = 0; p < 8; ++p) { sc += modp[(size_t)(p * 4 + b) * 6144 + 1024 + d]; sh += modp[(size_t)(p * 4 + b) * 6144 + d]; }
        tA[d] = g1n[d] * (1.f + sc); tS[d] = sh; }
    if (F.tid < 96) { const int idx = w * 96 + F.tid, bb = idx / 6144, n = idx % 6144; float v = b_ada[n];
#pragma unroll
        for (int p = 0; p < 8; ++p) v += modp[(size_t)(p * 4 + bb) * 6144 + n];
        ((float*)(ws + WS_MOD))[idx] = v; }
    __syncthreads();
    const float* x = args.in[0]; bf16* XN = (bf16*)(ws + WS_XN);
    for (int i = 0; i < 16; ++i) {
        const int row = w * 128 + F.wave * 16 + i;
        const GAS f32x4* xr = (const GAS f32x4*)(x + (size_t)row * 1024) + F.lane;
        f32x4 v[4]; float ss = 0.f;
#pragma unroll
        for (int j = 0; j < 4; ++j) { v[j] = xr[64 * j]; ss += (v[j].x * v[j].x + v[j].y * v[j].y) + (v[j].z * v[j].z + v[j].w * v[j].w); }
        const float rstd = rsqrtf(wave_sum(ss) * (1.f / 1024.f) + EPS);
        GAS unsigned long long* o8 = (GAS unsigned long long*)(XN + (size_t)row * 1024) + F.lane;
#pragma unroll
        for (int j = 0; j < 4; ++j) { const f32x4 a = ((const LAS f32x4*)tA)[F.lane + 64 * j], s = ((const LAS f32x4*)tS)[F.lane + 64 * j];
            const f32x4 o = v[j] * rstd * a + s;
            o8[64 * j] = (unsigned long long)pg8::cvt_pk_bf16(o.x, o.y) | ((unsigned long long)pg8::cvt_pk_bf16(o.z, o.w) << 32); }
    }
}

__device__ __forceinline__ void moe_tables(Frame& F, const Args& args) {
    LAS int* tbl = (LAS int*)(F.lds + TBL_OFF);
    if (F.tid == 0) { const gu32* gc = F.ctl + CW_CNT; int o = 0;
        for (int e = 0; e < 32; ++e) { const int c = (int)__hip_atomic_load(gc + e, RLX_AGENT); tbl[e] = o; tbl[40 + e] = c; o += (c + 255) >> 8; }
        tbl[32] = o; }
    __syncthreads();
}
__device__ __forceinline__ void p7_router(Frame& F, const Args& args) {
    unsigned char* ws = args.ws;
    typedef float f32x4v __attribute__((ext_vector_type(4)));
    LAS float* tA = (LAS float*)(F.lds + RING_OFF); LAS float* tS = tA + 1024;
    LAS float* lgs = (LAS float*)(F.lds + RING_OFF + 8192) + F.wave * (16 * 48);
    LAS int* cntl = (LAS int*)(F.lds + RING_OFF + 8192 + 8 * 16 * 48 * 4); LAS int* basel = cntl + 32;
    const int w = blockIdx.x, b = (w * 128) / S;
    const float* mod = (const float*)(ws + WS_MOD); const float* g2n = args.in[14];
    for (int d = F.tid; d < 1024; d += NWAVES * 64) { tA[d] = g2n[d] * (1.f + mod[b * 6144 + 4096 + d]); tS[d] = mod[b * 6144 + 3072 + d]; }
    if (F.tid < 32) cntl[F.tid] = 0;
    __syncthreads();
    const int i16 = F.lane & 15, q = F.lane >> 4;
    const int row = w * 128 + F.wave * 16 + i16;
    const float* x1 = args.out; bf16* h2 = (bf16*)(ws + WS_XN); const bf16* wr = (const bf16*)(ws + WS_WR);
    float rstd;
    { const f32x4v* rp = (const f32x4v*)((const float*)(ws + WS_ROWSQ) + (size_t)row * 16); const f32x4v a = rp[0], c = rp[1], d = rp[2], e = rp[3];
      const float ss = ((a[0] + a[1]) + (a[2] + a[3])) + ((c[0] + c[1]) + (c[2] + c[3])) + ((d[0] + d[1]) + (d[2] + d[3])) + ((e[0] + e[1]) + (e[2] + e[3]));
      rstd = rsqrtf(ss * (1.f / 1024.f) + EPS); }
    f32x4v acc[3];
#pragma unroll
    for (int nt = 0; nt < 3; ++nt) acc[nt] = (f32x4v){0.f, 0.f, 0.f, 0.f};
    const float* xr = x1 + (size_t)row * 1024 + 8 * q;
    bf16* hr = h2 + (size_t)row * 1024 + 8 * q;
#pragma unroll 4
    for (int uu = 0; uu < 32; ++uu) {
        const f32x4v xa = *(const f32x4v*)(xr + 32 * uu), xb = *(const f32x4v*)(xr + 32 * uu + 4);
        const f32x4v aa = *(const LAS f32x4v*)(tA + 32 * uu + 8 * q), ab = *(const LAS f32x4v*)(tA + 32 * uu + 8 * q + 4);
        const f32x4v sa = *(const LAS f32x4v*)(tS + 32 * uu + 8 * q), sb = *(const LAS f32x4v*)(tS + 32 * uu + 8 * q + 4);
        const f32x4v ha = xa * rstd * aa + sa, hb = xb * rstd * ab + sb;
        const pg8::u32x4 hh = pg8::pack8(ha, hb);
        *(pg8::u32x4*)(hr + 32 * uu) = hh;
        const pg8::u32x4 hl = pg8::pack8(ha - pg8::bflo(hh.x, hh.y), hb - pg8::bflo(hh.z, hh.w));
        const bf16x8 ahi = __builtin_bit_cast(bf16x8, hh), alo = __builtin_bit_cast(bf16x8, hl);
#pragma unroll
        for (int nt = 0; nt < 3; ++nt) { const size_t bo = ((size_t)(uu * 3 + nt) * 64 + F.lane) * 8;
            const bf16x8 bhi = *(const bf16x8*)(wr + bo), blo = *(const bf16x8*)(wr + 49152 + bo);
            acc[nt] = __builtin_amdgcn_mfma_f32_16x16x32_bf16(ahi, bhi, acc[nt], 0, 0, 0);
            acc[nt] = __builtin_amdgcn_mfma_f32_16x16x32_bf16(alo, bhi, acc[nt], 0, 0, 0);
            acc[nt] = __builtin_amdgcn_mfma_f32_16x16x32_bf16(ahi, blo, acc[nt], 0, 0, 0); }
    }
#pragma unroll
    for (int nt = 0; nt < 3; ++nt)
#pragma unroll
        for (int r = 0; r < 4; ++r) lgs[(4 * q + r) * 48 + 16 * nt + i16] = acc[nt][r];
    LDS_WAIT(); asm volatile("" ::: "memory");
    int e0 = 0, e1 = 0, p0l = 0, p1l = 0; float w0 = 0.f, w1 = 0.f;
    if (F.lane < 16) {
        const LAS float* lr = lgs + F.lane * 48; const float* bg = args.in[16]; const float* be = args.in[18];
        float gl[4]; float gmx = -3e38f; int gi = 0;
#pragma unroll
        for (int i = 0; i < 4; ++i) { gl[i] = lr[i] + bg[i]; if (gl[i] > gmx) { gmx = gl[i]; gi = i; } }
        float gs = 0.f;
#pragma unroll
        for (int i = 0; i < 4; ++i) gs += expf(gl[i] - gmx);
        const float gw = 1.f / gs;
        float el[8]; float emx = -3e38f;
#pragma unroll
        for (int i = 0; i < 8; ++i) { el[i] = lr[4 + gi * 8 + i] + be[gi * 8 + i]; emx = fmaxf(emx, el[i]); }
        float es = 0.f, ep[8];
#pragma unroll
        for (int i = 0; i < 8; ++i) { ep[i] = expf(el[i] - emx); es += ep[i]; }
        int a0 = 0; float pa = -1.f;
#pragma unroll
        for (int i = 0; i < 8; ++i) if (ep[i] > pa) { pa = ep[i]; a0 = i; }
        int a1 = 0; float pb = -1.f;
#pragma unroll
        for (int i = 0; i < 8; ++i) if (i != a0 && ep[i] > pb) { pb = ep[i]; a1 = i; }
        pa /= es; pb /= es; const float sw = pa + pb;
        e0 = gi * 8 + a0; e1 = gi * 8 + a1; w0 = gw * (pa / sw); w1 = gw * (pb / sw);
        p0l = __hip_atomic_fetch_add(cntl + e0, 1, __ATOMIC_RELAXED, __HIP_MEMORY_SCOPE_WORKGROUP);
        p1l = __hip_atomic_fetch_add(cntl + e1, 1, __ATOMIC_RELAXED, __HIP_MEMORY_SCOPE_WORKGROUP);
    }
    __syncthreads();
    if (F.tid < 32) { const int c = cntl[F.tid]; basel[F.tid] = c ? (int)__hip_atomic_fetch_add(F.ctl + CW_CNT + F.tid, (unsigned)c, RLX_AGENT) : 0; }
    __syncthreads();
    if (F.lane < 16) {
        const int t = w * 128 + F.wave * 16 + F.lane;
        int* list = (int*)(ws + WS_LIST); int* toki = (int*)(ws + WS_TOKI); float* tokw = (float*)(ws + WS_TOKW);
        const int q0 = basel[e0] + p0l, q1 = basel[e1] + p1l;
        list[(size_t)e0 * T + q0] = t * 2; list[(size_t)e1 * T + q1] = t * 2 + 1;
        toki[t * 2] = (e0 << 20) | q0; toki[t * 2 + 1] = (e1 << 20) | q1; tokw[t * 2] = w0; tokw[t * 2 + 1] = w1;
    }
}
__device__ __forceinline__ void p10_final(Frame& F, const Args& args) {
    unsigned char* ws = args.ws;
    const LAS int* tbl = (const LAS int*)(F.lds + TBL_OFF);
    const int w = blockIdx.x, b = (w * 128) / S;
    const float* g2 = (const float*)(ws + WS_MOD) + (size_t)b * 6144 + 5120; const float* fg = args.in[22];
    const bf16* Yb = (const bf16*)(ws + WS_YB); const int* toki = (const int*)(ws + WS_TOKI);
    float* out = args.out;
    for (int i = 0; i < 16; ++i) {
        const int t = w * 128 + F.wave * 16 + i;
        const int i0 = toki[t * 2], i1 = toki[t * 2 + 1];
        const size_t ra = (size_t)(tbl[i0 >> 20] * 256 + (i0 & 0xfffff)), rb = (size_t)(tbl[i1 >> 20] * 256 + (i1 & 0xfffff));
        f32x4 v[4]; float ss = 0.f;
#pragma unroll
        for (int j = 0; j < 4; ++j) { const int d0 = (F.lane + 64 * j) * 4; const f32x4 xv = *(const f32x4*)(out + (size_t)t * 1024 + d0);
            const uint2 ya = *(const uint2*)(Yb + ra * 1024 + d0), yb = *(const uint2*)(Yb + rb * 1024 + d0); const f32x4 g = *(const f32x4*)(g2 + d0);
            v[j] = xv + g * (pg8::bflo(ya.x, ya.y) + pg8::bflo(yb.x, yb.y));
            ss += (v[j].x * v[j].x + v[j].y * v[j].y) + (v[j].z * v[j].z + v[j].w * v[j].w); }
        const float rstd = rsqrtf(wave_sum(ss) * (1.f / 1024.f) + EPS);
#pragma unroll
        for (int j = 0; j < 4; ++j) { const int d0 = (F.lane + 64 * j) * 4; const f32x4 g = *(const f32x4*)(fg + d0); *(f32x4*)(out + (size_t)t * 1024 + d0) = v[j] * rstd * g; }
    }
}

__global__ void __launch_bounds__(NWAVES * 64, 2) fwd(Args args) {
    extern __shared__ __attribute__((aligned(16))) unsigned char lds[];
    Frame F;
    F.lds = (LAS unsigned char*)lds;
    F.MISC = (volatile LAS unsigned*)(F.lds + MISC_OFF);
    F.tid = threadIdx.x; F.lane = F.tid & 63; F.wave = __builtin_amdgcn_readfirstlane(F.tid >> 6);
    F.G = gridDim.x; { const int bx = blockIdx.x; F.vcu = (F.G % 8 == 0) ? (bx % 8) * (F.G / 8) + bx / 8 : bx; }
    unsigned char* ws = args.ws;
    F.ctl = (gu32*)(ws + WS_CTL);
    for (int u = F.tid; u < (LDS_BYTES - LDSCTL_OFF) / 4; u += NWAVES * 64) ((LAS unsigned*)(F.lds + LDSCTL_OFF))[u] = 0u;
    __syncthreads();
    XcdBarrier bar = xcd_barrier_post((unsigned*)(F.ctl + CW_BAR) + args.li * XCD_BAR_WORDS, F.MISC + 8);
    const int lo = args.ph_lo, hi = args.ph_hi;
#define IN(k) (lo <= (k) && (k) < hi)
#define BOTH(k) (IN(k) && IN((k) + 1))
#define GRID_BAR() xcd_barrier(bar)

    if (IN(0)) { p0_prologue(F, args); if (BOTH(0)) GRID_BAR(); }
    if (IN(1)) { p1_xn(F, args); if (BOTH(1)) GRID_BAR(); }
    if (IN(2)) {
        __syncthreads();
        pg8::Gemm g{(const bf16*)(ws + WS_XN), (const bf16*)(ws + WS_WIN), 1024}; pg8::StaticOrder So; So.init(T, INW, F.G, (int)blockIdx.x);
        pg8::EpiInProj E{(bf16*)(ws + WS_QM), (bf16*)(ws + WS_GM), (float*)(ws + WS_KSUM), (const float*)(ws + WS_ROPE), T, S, C2};
        pg8::gemm_phase<pg8::EpiInProj, pg8::StaticOrder, true, true>(F.lds + RING_OFF, g, So, E);
        if (BOTH(2)) GRID_BAR();
    }
    if (IN(3)) {
        __syncthreads();
        const int bh = F.vcu >> 3, part = F.vcu & 7;
        LAS float* ksl = (LAS float*)(F.lds + RING_OFF);
        { const float* ks = (const float*)(ws + WS_KSUM);
          for (int i = F.tid; i < 32 * 64; i += NWAVES * 64) { const int j = i >> 6, d = i & 63; const size_t o = ((size_t)((bh >> 3) * 32 + j)) * 512 + (bh & 7) * 64 + d; ksl[i] = ks[o] + ks[128 * 512 + o]; } }
        __syncthreads();
#pragma unroll 1
        for (int hf = 0; hf < 2; ++hf) { const int cc = part * 8 + F.wave, chunk = hf ? 127 - cc : cc;
            gate_wave(bh >> 3, bh & 7, chunk, F.lane, (const bf16*)(ws + WS_QM), ksl, (unsigned*)(ws + WS_SEL), (unsigned*)(F.ctl + CW_QCNT), (unsigned short*)((char*)args.out + DO_QLIST)); }
        if (BOTH(3)) GRID_BAR();
    }
    if (IN(4)) {
        __syncthreads();
        const float lam = *(const float*)(ws + WS_LAM);
        float* o1scr = (float*)(ws + WS_XN) + (size_t)blockIdx.x * 65536;
        bf16* opart = (bf16*)args.out; float* mlp = (float*)((char*)args.out + DO_MLP); const unsigned short* qlist = (const unsigned short*)((char*)args.out + DO_QLIST);
        LAS int* pre = (LAS int*)(F.lds + ROWTAB_OFF); LAS int* tot = pre + 1040;
        if (F.tid < 32) { int run = 0; for (int j = 0; j < 32; ++j) { pre[F.tid * 32 + j] = run; run += ((int)__hip_atomic_load(F.ctl + CW_QCNT + F.tid * 32 + j, RLX_AGENT) + 511) >> 9; } tot[F.tid] = run; }
        __syncthreads();
        if (F.tid == 0) { int run = 0; for (int i = 0; i < 32; ++i) { const int c = tot[i]; tot[i] = run; run += c; } tot[32] = run; }
        __syncthreads();
        for (int e = F.tid; e < 1024; e += NWAVES * 64) pre[e] += tot[e >> 5];
        if (F.tid == 0) pre[1024] = tot[32];
        __syncthreads();
        const int nitems = pre[1024];
#pragma unroll 1
        for (int I = F.vcu; I < nitems; I += F.G) {
            int lo_ = 0, hi_ = 1024;
            while (hi_ - lo_ > 1) { const int mid = (lo_ + hi_) >> 1; if (pre[mid] <= I) lo_ = mid; else hi_ = mid; }
            const int e = lo_, bh = e >> 5, j = e & 31, c = I - pre[e];
            const int cnt = (int)__hip_atomic_load(F.ctl + CW_QCNT + e, RLX_AGENT); int nv = cnt - 512 * c; nv = nv > 512 ? 512 : nv;
            att::moba_block_issue((const bf16*)(ws + WS_KM), (const bf16*)(ws + WS_VM), bh >> 3, bh & 7, j, (char*)lds + RING_OFF);
            const unsigned short* ql = qlist + (size_t)bh * QL_PER_BH + 256 * (31 * j - (j * (j - 1)) / 2) + 512 * c;
            if (F.wave * 32 >= nv) asm volatile("s_waitcnt vmcnt(0)\n\ts_barrier" ::: "memory");
#pragma unroll 1
            for (int g = F.wave; g * 32 < nv; g += NWAVES)
                att::attn_unit<64, 2, true>(bh >> 3, bh & 7, j, (const bf16*)(ws + WS_QM), (const bf16*)(ws + WS_KM), (const bf16*)(ws + WS_VM), nullptr, (const unsigned*)(ws + WS_SEL), nullptr, 0.f, nullptr,
                                            (char*)lds + RING_OFF, ql + g * 32, nv - g * 32 < 32 ? nv - g * 32 : 32, opart, mlp, g == F.wave);
        }
        __syncthreads();
        { const int u = F.vcu, bh = u >> 4, s = u & 15;
#pragma unroll 1
          for (int kk = 0; kk < 2; ++kk) att::attn_unit<128, 1>(bh >> 2, bh & 3, (kk & 1) ? s : 31 - s, (const bf16*)(ws + WS_QD), (const bf16*)(ws + WS_KD), (const bf16*)(ws + WS_VD), (bf16*)(ws + WS_QD),
                                                                   nullptr, o1scr, lam, args.in[10], (char*)lds + RING_OFF); }
        GRID_BAR();
#pragma unroll 1
        for (int k = 0; k < 4; ++k) { const int u = F.vcu * 4 + k, bh = u >> 5, qb = u & 31;
            att::moba_block_issue((const bf16*)(ws + WS_KM), (const bf16*)(ws + WS_VM), bh >> 3, bh & 7, qb, (char*)lds + RING_OFF);
            att::attn_unit<64, 3, true>(bh >> 3, bh & 7, qb, (const bf16*)(ws + WS_QM), (const bf16*)(ws + WS_KM), (const bf16*)(ws + WS_VM), (bf16*)(ws + WS_QM), (const unsigned*)(ws + WS_SEL), nullptr, 0.f, nullptr,
                                        (char*)lds + RING_OFF, nullptr, 0, opart, mlp, true); }
        __syncthreads();
        if (BOTH(4)) GRID_BAR();
    }
    if (IN(5)) {
        __syncthreads();
        pg8::StaticOrder So; So.init(T, 1024, F.G, (int)blockIdx.x);
        { pg8::Gemm g{(const bf16*)(ws + WS_QM), (const bf16*)(ws + WS_WPM), 512}; pg8::EpiGate<0> E{(const bf16*)(ws + WS_GM), (bf16*)(ws + WS_MERGED)};
          pg8::gemm_phase<pg8::EpiGate<0>, pg8::StaticOrder, true, true>(F.lds + RING_OFF, g, So, E); }
        __syncthreads();
        { pg8::Gemm g{(const bf16*)(ws + WS_QD), (const bf16*)(ws + WS_WPD), 512}; pg8::EpiGate<1> E{(const bf16*)(ws + WS_GD), (bf16*)(ws + WS_MERGED)};
          pg8::gemm_phase<pg8::EpiGate<1>, pg8::StaticOrder, true, true>(F.lds + RING_OFF, g, So, E); }
        if (BOTH(5)) GRID_BAR();
    }
    if (IN(6)) {
        __syncthreads();
        pg8::StaticOrder So; So.init(T, 1024, F.G, (int)blockIdx.x);
        pg8::Gemm g{(const bf16*)(ws + WS_MERGED), (const bf16*)(ws + WS_WOUT), 1024};
        pg8::EpiResid E{args.in[0], (const float*)(ws + WS_MOD) + 2048, args.out, (float*)(ws + WS_ROWSQ), S};
        pg8::gemm_phase<pg8::EpiResid, pg8::StaticOrder, true, true>(F.lds + RING_OFF, g, So, E);
        if (BOTH(6)) GRID_BAR();
    }
    if (IN(7)) { __syncthreads(); p7_router(F, args); if (BOTH(7)) GRID_BAR(); }
    if (IN(8)) {
        __syncthreads(); moe_tables(F, args);
        const LAS int* tbl = (const LAS int*)(F.lds + TBL_OFF); LAS int* rowtab = (LAS int*)(F.lds + ROWTAB_OFF);
        pg8::MoeOrder Mo{tbl, rowtab, tbl[32], 4, F.G, (int)blockIdx.x, 1024, true};
        { pg8::Unit u; const int* list = (const int*)(ws + WS_LIST);
          for (int ui = 0; ui < 8 && Mo.next(ui, u); ++ui)
              for (int r = F.tid; r < 256; r += NWAVES * 64) { const int rr = r < u.cnt ? r : u.cnt - 1; rowtab[ui * 256 + r] = list[(size_t)u.e * T + u.lo + rr] >> 1; } }
        __syncthreads();
        pg8::Gemm g{(const bf16*)(ws + WS_XN), (const bf16*)(ws + WS_WGU), 1024};
        pg8::EpiMoeHid E{(bf16*)(ws + WS_HID)};
        pg8::gemm_phase<pg8::EpiMoeHid, pg8::MoeOrder, true, true>(F.lds + RING_OFF, g, Mo, E);
        if (BOTH(8)) GRID_BAR();
    }
    if (IN(9)) {
        __syncthreads(); moe_tables(F, args);
        const LAS int* tbl = (const LAS int*)(F.lds + TBL_OFF);
        pg8::MoeOrder Mo{tbl, nullptr, tbl[32], 4, F.G, (int)blockIdx.x, 1024, false};
        pg8::Gemm g{(const bf16*)(ws + WS_HID), (const bf16*)(ws + WS_WD), 512};
        pg8::EpiMoeDown E{(bf16*)(ws + WS_YB), (const int*)(ws + WS_LIST), (const float*)(ws + WS_TOKW), T};
        pg8::gemm_phase<pg8::EpiMoeDown, pg8::MoeOrder, true, true>(F.lds + RING_OFF, g, Mo, E);
        if (BOTH(9)) GRID_BAR();
    }
    if (IN(10)) { __syncthreads(); moe_tables(F, args); p10_final(F, args); }
#undef IN
#undef BOTH
}
}


extern "C" void kernel_launch(void* const* d_in, const int* in_sizes, int n_in, void* d_out, int out_size, void* d_ws, size_t ws_size, hipStream_t stream) {
    char* ws = (char*)d_ws; float* out = (float*)d_out;
    static int grid = 0;
    if (grid == 0) {
        int dev = 0, cus = 0, per_cu = 0;
        if (hipGetDevice(&dev) != hipSuccess || hipDeviceGetAttribute(&cus, hipDeviceAttributeMultiprocessorCount, dev) != hipSuccess) { fprintf(stderr, "kernel_launch: device query failed\n"); grid = -1; return; }
        if (hipFuncSetAttribute((const void*)fwd, hipFuncAttributeMaxDynamicSharedMemorySize, LDS_BYTES) != hipSuccess) { fprintf(stderr, "kernel_launch: hipFuncSetAttribute failed\n"); grid = -1; return; }
        if (hipOccupancyMaxActiveBlocksPerMultiprocessor(&per_cu, (const void*)fwd, NWAVES * 64, LDS_BYTES) != hipSuccess || per_cu < 1) fprintf(stderr, "kernel_launch: occupancy query reports %d\n", per_cu);
        (void)hipGetLastError();
        grid = cus < 256 ? cus : 256;
        if (ws_size < 512 * MiB || n_in != 23 || out_size != T * D) { fprintf(stderr, "kernel_launch: built for 23 inputs, %d outputs and >= 512 MiB of workspace\n", T * D); grid = -1; return; }
    }
    if (grid < 0) return;
    (void)hipMemsetAsync(ws + WS_CTL, 0, 64 * 1024, stream);
    Args a{};
    for (int i = 0; i < 23; ++i) a.in[i] = (const float*)d_in[i];
    a.out = out; a.ws = (unsigned char*)d_ws;
    a.ph_lo = 0; a.ph_hi = 11; a.li = 0; a.pad = 0;
    hipLaunchKernelGGL(fwd, dim3(grid), dim3(NWAVES * 64), LDS_BYTES, stream, a);
}
```

```cpp
#include <hip/hip_runtime.h>
#include <cstdint>
#include <cstdio>

namespace {

constexpr int NB = 4, S = 8192, D = 1024, T = NB * S;
constexpr int INW = 5120;
constexpr float EPS = 1e-6f;
constexpr float C2 = 0.125f * 1.4426950408889634f;
constexpr size_t MiB = 1ull << 20;
constexpr size_t WS_CTL = 0;
constexpr size_t WS_MOD = 1 * MiB;
constexpr size_t WS_LAM = 1 * MiB + 128 * 1024;
constexpr size_t WS_OFF = 1 * MiB + 132 * 1024;
constexpr size_t WS_KSUM = 1 * MiB + 256 * 1024;
constexpr size_t WS_MODP = 2 * MiB;
constexpr size_t WS_WR = 3 * MiB;
constexpr size_t WS_ROPE = 4 * MiB;
constexpr size_t WS_WIN = 6 * MiB;
constexpr size_t WS_WPM = 16 * MiB, WS_WPD = 17 * MiB, WS_WOUT = 18 * MiB;
constexpr size_t WS_WGU = 20 * MiB;
constexpr size_t WS_WD = 84 * MiB;
constexpr size_t WS_XN = 116 * MiB;
constexpr size_t WS_QM = 180 * MiB, WS_KM = 212 * MiB, WS_VM = 244 * MiB, WS_QD = 276 * MiB, WS_KD = 308 * MiB, WS_VD = 340 * MiB;
constexpr size_t WS_GM = 372 * MiB, WS_GD = 436 * MiB;
constexpr size_t WS_LIST = 500 * MiB;
constexpr size_t WS_TOKI = 504 * MiB;
constexpr size_t WS_TOKW = 504 * MiB + 256 * 1024;
constexpr size_t WS_SEL = 505 * MiB;
constexpr size_t WS_ROWSQ = 506 * MiB;
constexpr size_t WS_MERGED = 212 * MiB;
constexpr size_t WS_HID = 372 * MiB;
constexpr size_t WS_YB = 180 * MiB;
constexpr int CW_QCNT = 8192;
constexpr size_t DO_MLP = 96 * MiB, DO_QLIST = 104 * MiB;
constexpr int QL_PER_BH = 126976;
constexpr int CW_CNT = 1024;


#define GAS __attribute__((address_space(1)))
#define LAS __attribute__((address_space(3)))
typedef unsigned short bf16;
typedef unsigned v4u __attribute__((ext_vector_type(4)));
typedef float f32x4 __attribute__((ext_vector_type(4)));
typedef short bf16x8 __attribute__((ext_vector_type(8)));
typedef GAS unsigned gu32;
typedef GAS unsigned long long gu64;
#define RLX_AGENT __ATOMIC_RELAXED, __HIP_MEMORY_SCOPE_AGENT
#define LDS_WAIT() asm volatile("s_waitcnt lgkmcnt(0)" ::: "memory")
#define VM_WAIT() asm volatile("s_waitcnt vmcnt(0)" ::: "memory")
__device__ __forceinline__ unsigned f2bf(float f) { unsigned u = __builtin_bit_cast(unsigned, f); return (u + 0x7fffu + ((u >> 16) & 1u)) >> 16; }
__device__ __forceinline__ unsigned pk2(float lo, float hi) { return f2bf(lo) | (f2bf(hi) << 16); }
__device__ __forceinline__ float bf2f(bf16 v) { return __uint_as_float((unsigned)v << 16); }
#define XB_TMO      128
#define XB_XCNT(j)  (256  + 64 * (j))
#define XB_XSUB(j)  (1280 + 64 * (j))
#define XB_XGEN(j)  (2304 + 64 * (j))
#define XB_TOP      3328
#define XB_TOPGEN   3392
#define XCD_BAR_WORDS 3456
#define XB_SPIN_CAP (1u << 18)

__device__ __forceinline__ unsigned xb_ld(unsigned* p)              { return __hip_atomic_load(p, __ATOMIC_RELAXED, __HIP_MEMORY_SCOPE_AGENT); }
__device__ __forceinline__ unsigned xb_add(unsigned* p, unsigned v) { return __hip_atomic_fetch_add(p, v, __ATOMIC_RELAXED, __HIP_MEMORY_SCOPE_AGENT); }
__device__ __forceinline__ unsigned xb_xcc_id() { return (unsigned)__builtin_amdgcn_s_getreg((3 << 11) | 20) & 0xFu; }
#define XB_SPIN(cond, bar) do { unsigned _sp = 0; while (cond) { __builtin_amdgcn_s_sleep(1); \
    if ((++_sp & 255u) == 0u) { if (xb_ld(&(bar)[XB_TMO])) break; if (_sp > XB_SPIN_CAP) { atomicAdd(&(bar)[XB_TMO], 1u); break; } } } } while (0)

struct XcdBarrier {
    unsigned* bar; unsigned x;
    volatile LAS unsigned* st;
};

__device__ __forceinline__ XcdBarrier xcd_barrier_post(unsigned* bar, volatile LAS unsigned* st) {
    XcdBarrier b; b.bar = bar; b.x = xb_xcc_id(); b.st = st;
    if (threadIdx.x == 0) (void)xb_add(&bar[XB_XCNT(b.x)], 1u);
    return b;
}
__device__ __forceinline__ void xcd_barrier_complete(unsigned* bar, unsigned x, unsigned& nloc, unsigned& nx) {
    const unsigned G = gridDim.x * gridDim.y * gridDim.z;
    unsigned sum, cnt, mine, sp = 0u;
    for (;;) {
        sum = 0u; cnt = 0u; mine = 0u;
#pragma unroll
        for (unsigned j = 0; j < 16; ++j) { const unsigned c = xb_ld(&bar[XB_XCNT(j)]); sum += c; cnt += (c > 0u) ? 1u : 0u; mine = (j == x) ? c : mine; }
        if (sum == G) break;
        __builtin_amdgcn_s_sleep(1);
        if ((++sp & 255u) == 0u) { if (xb_ld(&bar[XB_TMO])) break; if (sp > XB_SPIN_CAP) { atomicAdd(&bar[XB_TMO], 1u); break; } }
    }
    nloc = mine > 0u ? mine : 1u; nx = cnt > 0u ? cnt : 1u;
}

__device__ __forceinline__ void xcd_barrier(const XcdBarrier& b) {
    asm volatile("s_waitcnt vmcnt(0)" ::: "memory");
    __syncthreads();
    if (threadIdx.x == 0) {
        unsigned* bar = b.bar;
        __builtin_amdgcn_s_waitcnt(0);
        unsigned nloc = b.st[0], nx = b.st[1];
        if (nloc == 0u) { xcd_barrier_complete(bar, b.x, nloc, nx); b.st[0] = nloc; b.st[1] = nx; }
        const unsigned old = xb_add(&bar[XB_XSUB(b.x)], 1u);
        const unsigned gen = old / nloc;
        if (old + 1u == (gen + 1u) * nloc) {
            __builtin_amdgcn_fence(__ATOMIC_RELEASE, "agent");
            asm volatile("s_waitcnt vmcnt(0)" ::: "memory");
            const unsigned og = xb_add(&bar[XB_TOP], 1u);
            const unsigned tg = og / nx;
            if (og + 1u == (tg + 1u) * nx) xb_add(&bar[XB_TOPGEN], 1u);
            else XB_SPIN(xb_ld(&bar[XB_TOPGEN]) == tg, bar);
            __builtin_amdgcn_fence(__ATOMIC_ACQUIRE, "agent");
            xb_add(&bar[XB_XGEN(b.x)], 1u);
            asm volatile("s_waitcnt vmcnt(0)" ::: "memory");
        } else {
            XB_SPIN(xb_ld(&bar[XB_XGEN(b.x)]) == gen, bar);
            __builtin_amdgcn_fence(__ATOMIC_ACQUIRE, "agent");
            asm volatile("s_waitcnt vmcnt(0)" ::: "memory");
        }
    }
    __syncthreads();
}


namespace pg8 {
#define PG8_LAS __attribute__((address_space(3)))
typedef unsigned short bf16_t;
typedef short bf16x8 __attribute__((ext_vector_type(8)));
typedef float f32x4 __attribute__((ext_vector_type(4)));
typedef unsigned u32x4 __attribute__((ext_vector_type(4)));
constexpr int BM = 256, BK = 64, HALF = 128, HTB = HALF * BK * 2  , STAGE_BYTES = 8 * HTB, NXCD = 8, WGM = 8;

__host__ __device__ __forceinline__ int lds_byte(int r, int c) { const int st = (r >> 4) * 2 + (c >> 5), rr = r & 15, cc = c & 31, ob = rr * 64 + cc * 2; return st * 1024 + (ob ^ (((ob >> 9) & 1) << 5)); }
__host__ __device__ __forceinline__ void stage_rc(int b, int& R, int& C) { const int st = b / 1024, sb = b % 1024, swz = sb ^ (((sb >> 9) & 1) << 5); R = (st >> 1) * 16 + swz / 64; C = (st & 1) * 32 + (swz % 64) / 2; }
__host__ __device__ __forceinline__ int perm32(int rho) { const int n = rho >> 4, i = rho & 15; return 8 * (i >> 2) + 4 * n + (i & 3); }

struct Unit { int pm, pn, e, lo, cnt; };
struct Gemm { const bf16_t* A; const bf16_t* Bt; int K; };

struct StaticOrder {
    int nM, nN, nwg, G, c;
    __host__ __device__ void init(int M, int N, int G_, int c_) { nM = M / BM; nN = N / BM; nwg = nM * nN; G = G_; c = c_; }
    __host__ __device__ bool next(int i, Unit& u) const {
        const long L = (long)i * G + c; if (L >= nwg) return false;
        int wgid = (int)L; { const int q = nwg / NXCD, r = nwg % NXCD, xcd = wgid % NXCD, off = wgid / NXCD; wgid = (xcd < r ? xcd * (q + 1) : r * (q + 1) + (xcd - r) * q) + off; }
        const int nig = WGM * nN, gid = wgid / nig, fm = gid * WGM, gsz = (nM - fm) < WGM ? (nM - fm) : WGM;
        u.pm = fm + ((wgid % nig) % gsz); u.pn = (wgid % nig) / gsz; u.e = 0; u.lo = 0; u.cnt = BM; return true;
    }
    __device__ __forceinline__ int arow(int, const Unit& u, int r) const { return u.pm * BM + r; }
    __device__ __forceinline__ int brow(const Unit& u) const { return u.pn * BM; }
    __device__ __forceinline__ void a_ready(const Unit&) const {}
    __device__ __forceinline__ void done(const Unit&) const {}
};
typedef float f32x2_t __attribute__((ext_vector_type(2))); typedef __bf16 bf16x2_t __attribute__((ext_vector_type(2)));
__device__ __forceinline__ unsigned cvt_pk_bf16(float lo, float hi) { f32x2_t v = {lo, hi}; bf16x2_t b = __builtin_convertvector(v, bf16x2_t); return __builtin_bit_cast(unsigned, b); }
struct MoeOrder {
    const PG8_LAS int* tbl; const PG8_LAS int* rowtab; int ntile, nN, G, c, Nexp; bool gather;
    __device__ __forceinline__ bool next(int i, Unit& u) const {
        const int L = i * G + c; if (L >= ntile * nN) return false;
        const int mt = L / nN; int e = 0;
        while (tbl[e + 1] <= mt) ++e;
        u.pm = mt; u.pn = L - mt * nN; u.e = e; u.lo = (mt - tbl[e]) * BM; u.cnt = tbl[40 + e] - u.lo; return true;
    }
    __device__ __forceinline__ int arow(int ui, const Unit& u, int r) const { return gather ? rowtab[ui * BM + r] : u.pm * BM + r; }
    __device__ __forceinline__ int brow(const Unit& u) const { return u.e * Nexp + u.pn * BM; }
    __device__ __forceinline__ void a_ready(const Unit&) const {}
    __device__ __forceinline__ void done(const Unit&) const {}
};
__device__ __forceinline__ float fast_sigmoid(float v) { return __builtin_amdgcn_rcpf(1.f + __builtin_amdgcn_exp2f(-1.4426950408889634f * v)); }
__device__ __forceinline__ u32x4 pack8(const f32x4& a, const f32x4& b) { u32x4 w; w.x = cvt_pk_bf16(a[0], a[1]); w.y = cvt_pk_bf16(a[2], a[3]); w.z = cvt_pk_bf16(b[0], b[1]); w.w = cvt_pk_bf16(b[2], b[3]); return w; }
__device__ __forceinline__ f32x4 bflo(unsigned a, unsigned b) { return (f32x4){__uint_as_float(a << 16), __uint_as_float(a & 0xffff0000u), __uint_as_float(b << 16), __uint_as_float(b & 0xffff0000u)}; }

struct EpiInProj {
    static constexpr bool PERM = true, AFTER_DRAIN = false;
    bf16_t* qkv;
    bf16_t* gates;
    float* ksum;
    const float* tab;
    int Trows, Srows; float c2;
    __device__ __forceinline__ void operator()(const f32x4 (&acc)[2][2][4][2], const Unit& u, int wr, int wc, int fr, int fq) const {
        const int pn = u.pn; const int rw = u.pm * BM + wr * 64 + fr;
        if (pn >= 12) {
            bf16_t* base = gates + (size_t)((pn - 12) >> 2) * ((size_t)Trows * 1024) + ((pn - 12) & 3) * 256 + wc * 32 + 8 * fq;
#pragma unroll
            for (int ai = 0; ai < 2; ++ai)
#pragma unroll
                for (int m = 0; m < 4; ++m) { bf16_t* rowp = base + (size_t)(rw + ai * HALF + m * 16) * 1024;
#pragma unroll
                    for (int bj = 0; bj < 2; ++bj) { f32x4 v0 = acc[ai][bj][m][0], v1 = acc[ai][bj][m][1];
#pragma unroll
                        for (int j = 0; j < 4; ++j) { v0[j] = fast_sigmoid(v0[j]); v1[j] = fast_sigmoid(v1[j]); }
                        *(u32x4*)(rowp + bj * HALF) = pack8(v0, v1); } }
            return;
        }
        const int seg = pn >> 1, ts = pn & 1;
        bf16_t* base = qkv + (size_t)seg * ((size_t)Trows * 512);
        if (seg == 2 || seg == 5) {
            bf16_t* b2 = base + ts * 256 + wc * 32 + 8 * fq;
#pragma unroll
            for (int ai = 0; ai < 2; ++ai)
#pragma unroll
                for (int m = 0; m < 4; ++m) { bf16_t* rowp = b2 + (size_t)(rw + ai * HALF + m * 16) * 512;
#pragma unroll
                    for (int bj = 0; bj < 2; ++bj) *(u32x4*)(rowp + bj * HALF) = pack8(acc[ai][bj][m][0], acc[ai][bj][m][1]); }
            return;
        }
        const float sc = (seg == 0 || seg == 3) ? c2 : 1.f;
        const int colh = (ts * 4 + wc) * 64 + 8 * fq;
        f32x4 ks[2][2];
#pragma unroll
        for (int a = 0; a < 2; ++a)
#pragma unroll
            for (int n = 0; n < 2; ++n) ks[a][n] = (f32x4){0.f, 0.f, 0.f, 0.f};
#pragma unroll
        for (int ai = 0; ai < 2; ++ai)
#pragma unroll
            for (int m = 0; m < 4; ++m) {
                const int r = rw + ai * HALF + m * 16, pos = r & (Srows - 1);
                const f32x4* tp = (const f32x4*)(tab + (size_t)pos * 64 + 16 * fq);
                const f32x4 t0 = tp[0], t1 = tp[1], t2 = tp[2], t3 = tp[3];
                f32x4 olo[2], ohi[2];
#pragma unroll
                for (int n = 0; n < 2; ++n) {
                    const f32x4 ta = n ? t2 : t0, tb = n ? t3 : t1;
                    const f32x4 cs = (f32x4){ta[0], ta[2], tb[0], tb[2]}, sn = (f32x4){ta[1], ta[3], tb[1], tb[3]};
                    const f32x4 lo = acc[ai][0][m][n], hi = acc[ai][1][m][n];
                    olo[n] = lo * cs - hi * sn; ohi[n] = hi * cs + lo * sn;
                }
                if (seg == 1) { ks[0][0] += olo[0]; ks[0][1] += olo[1]; ks[1][0] += ohi[0]; ks[1][1] += ohi[1]; }
                bf16_t* rowp = base + (size_t)r * 512 + colh;
                *(u32x4*)(rowp) = pack8(olo[0] * sc, olo[1] * sc); *(u32x4*)(rowp + 32) = pack8(ohi[0] * sc, ohi[1] * sc);
            }
        if (seg == 1) {
#pragma unroll
            for (int a = 0; a < 2; ++a)
#pragma unroll
                for (int n = 0; n < 2; ++n)
#pragma unroll
                    for (int j = 0; j < 4; ++j) { float v = ks[a][n][j]; v += __shfl_xor(v, 1); v += __shfl_xor(v, 2); v += __shfl_xor(v, 4); v += __shfl_xor(v, 8); ks[a][n][j] = v; }
            if (fr == 0) { float* kp = ksum + ((size_t)(wr * 128 + u.pm)) * 512 + colh; *(f32x4*)(kp) = ks[0][0]; *(f32x4*)(kp + 4) = ks[0][1]; *(f32x4*)(kp + 32) = ks[1][0]; *(f32x4*)(kp + 36) = ks[1][1]; }
        }
    }
};
template <int PASS> struct EpiGate {
    static constexpr bool PERM = true, AFTER_DRAIN = false;
    const bf16_t* G; bf16_t* out;
    __device__ __forceinline__ void operator()(const f32x4 (&acc)[2][2][4][2], const Unit& u, int wr, int wc, int fr, int fq) const {
        const int rw = u.pm * BM + wr * 64 + fr, col0 = u.pn * BM + wc * 32 + 8 * fq;
#pragma unroll
        for (int ai = 0; ai < 2; ++ai) {
            u32x4 g[4][2], p[4][2];
#pragma unroll
            for (int m = 0; m < 4; ++m)
#pragma unroll
                for (int bj = 0; bj < 2; ++bj) { const size_t off = (size_t)(rw + ai * HALF + m * 16) * 1024 + col0 + bj * HALF;
                    g[m][bj] = *(const u32x4*)(G + off); if (PASS == 1) p[m][bj] = __builtin_nontemporal_load((const u32x4*)(out + off)); }
#pragma unroll
            for (int m = 0; m < 4; ++m)
#pragma unroll
                for (int bj = 0; bj < 2; ++bj) { const size_t off = (size_t)(rw + ai * HALF + m * 16) * 1024 + col0 + bj * HALF;
                    f32x4 v0 = acc[ai][bj][m][0] * bflo(g[m][bj].x, g[m][bj].y), v1 = acc[ai][bj][m][1] * bflo(g[m][bj].z, g[m][bj].w);
                    if (PASS == 1) { v0 += bflo(p[m][bj].x, p[m][bj].y); v1 += bflo(p[m][bj].z, p[m][bj].w); }
                    *(u32x4*)(out + off) = pack8(v0, v1); }
        }
    }
};
struct EpiResid {
    static constexpr bool PERM = true, AFTER_DRAIN = false;
    const float* x; const float* g1; float* x1; float* rowsq; int Srows;
    __device__ __forceinline__ void operator()(const f32x4 (&acc)[2][2][4][2], const Unit& u, int wr, int wc, int fr, int fq) const {
        const int rw = u.pm * BM + wr * 64 + fr, col0 = u.pn * BM + wc * 32 + 8 * fq, b = (u.pm * BM) / Srows;
        f32x4 gv[2][2];
#pragma unroll
        for (int bj = 0; bj < 2; ++bj)
#pragma unroll
            for (int n = 0; n < 2; ++n) gv[bj][n] = *(const f32x4*)(g1 + (size_t)b * 6144 + col0 + bj * HALF + n * 4);
#pragma unroll
        for (int ai = 0; ai < 2; ++ai) {
            f32x4 xv[4][2][2];
#pragma unroll
            for (int m = 0; m < 4; ++m) { const size_t off = (size_t)(rw + ai * HALF + m * 16) * 1024 + col0;
#pragma unroll
                for (int bj = 0; bj < 2; ++bj)
#pragma unroll
                    for (int n = 0; n < 2; ++n) xv[m][bj][n] = *(const f32x4*)(x + off + bj * HALF + n * 4); }
#pragma unroll
            for (int m = 0; m < 4; ++m) { const int r = rw + ai * HALF + m * 16; const size_t off = (size_t)r * 1024 + col0; float s = 0.f;
#pragma unroll
                for (int bj = 0; bj < 2; ++bj)
#pragma unroll
                    for (int n = 0; n < 2; ++n) { const f32x4 o = xv[m][bj][n] + gv[bj][n] * acc[ai][bj][m][n];
                        *(f32x4*)(x1 + off + bj * HALF + n * 4) = o; s += (o[0] * o[0] + o[1] * o[1]) + (o[2] * o[2] + o[3] * o[3]); }
                s += __shfl_xor(s, 16); s += __shfl_xor(s, 32);
                if (fq == 0) rowsq[(size_t)r * 16 + u.pn * 4 + wc] = s; }
        }
    }
};
struct EpiMoeHid {
    static constexpr bool PERM = true, AFTER_DRAIN = false;
    bf16_t* hid;
    __device__ __forceinline__ void operator()(const f32x4 (&acc)[2][2][4][2], const Unit& u, int wr, int wc, int fr, int fq) const {
        const int rw = u.pm * BM + wr * 64 + fr, col0 = u.pn * 128 + wc * 32 + 8 * fq;
#pragma unroll
        for (int ai = 0; ai < 2; ++ai)
#pragma unroll
            for (int m = 0; m < 4; ++m) { f32x4 h[2];
#pragma unroll
                for (int n = 0; n < 2; ++n) { const f32x4 g = acc[ai][0][m][n], up = acc[ai][1][m][n];
#pragma unroll
                    for (int j = 0; j < 4; ++j) h[n][j] = g[j] * fast_sigmoid(g[j]) * up[j]; }
                *(u32x4*)(hid + (size_t)(rw + ai * HALF + m * 16) * 512 + col0) = pack8(h[0], h[1]); }
    }
};
struct EpiMoeDown {
    static constexpr bool PERM = true, AFTER_DRAIN = false;
    bf16_t* Yb; const int* list; const float* tokw; int Trows;
    __device__ __forceinline__ void operator()(const f32x4 (&acc)[2][2][4][2], const Unit& u, int wr, int wc, int fr, int fq) const {
        const int rl = wr * 64 + fr, col0 = u.pn * BM + wc * 32 + 8 * fq;
        int le[2][4]; float w[2][4];
#pragma unroll
        for (int ai = 0; ai < 2; ++ai)
#pragma unroll
            for (int m = 0; m < 4; ++m) { const int rr = rl + ai * HALF + m * 16; le[ai][m] = list[(size_t)u.e * Trows + u.lo + (rr < u.cnt ? rr : 0)]; }
#pragma unroll
        for (int ai = 0; ai < 2; ++ai)
#pragma unroll
            for (int m = 0; m < 4; ++m) { const int rr = rl + ai * HALF + m * 16; const float tw = tokw[le[ai][m]]; w[ai][m] = rr < u.cnt ? tw : 0.f; }
#pragma unroll
        for (int ai = 0; ai < 2; ++ai)
#pragma unroll
            for (int m = 0; m < 4; ++m) { const int rr = rl + ai * HALF + m * 16;
                bf16_t* rowp = Yb + (size_t)(u.pm * BM + rr) * 1024 + col0;
#pragma unroll
                for (int bj = 0; bj < 2; ++bj) *(u32x4*)(rowp + bj * HALF) = pack8(acc[ai][bj][m][0] * w[ai][m], acc[ai][bj][m][1] * w[ai][m]); }
    }
};

template <class Epi, class Sched, bool ALIGN_EPI = false, bool SP2 = false>
__device__ __forceinline__ void gemm_phase(PG8_LAS unsigned char* lds, const Gemm g, const Sched& S, const Epi& E) {
    const int tid = threadIdx.x, wid = __builtin_amdgcn_readfirstlane(tid >> 6), lane = tid & 63, wr = wid >> 2, wc = wid & 3, fr = lane & 15, fq = lane >> 4;
    const int K = g.K, nt = K / BK;
    unsigned voffB[2], CA2[2]; int RA[2];
#pragma unroll
    for (int i = 0; i < 2; ++i) { int R, C; stage_rc(tid * 16 + i * 8192, R, C); const int Rb = Epi::PERM ? ((R & ~31) + perm32(R & 31)) : R;
        RA[i] = R; CA2[i] = (unsigned)C * 2u; voffB[i] = (unsigned)(Rb * K + C) * 2u; }
    const unsigned K2 = (unsigned)K * 2u;
    const size_t kstep = (size_t)(BK * 2);
    const size_t hstep = (size_t)HALF * K * 2;
    const unsigned ldsw = (unsigned)wid * 1024u;
    const int aoff = lds_byte(wr * 64 + fr, fq * 8), boff = lds_byte(wc * 32 + fr, fq * 8);
#define PG8_SA(b, h) (((b) * 2 + (h)) * HTB)
#define PG8_SB(b, h) ((4 + (b) * 2 + (h)) * HTB)
#define PG8_STAGE(bufoff, gbase, voff) do { _Pragma("unroll") for (int _i = 0; _i < 2; ++_i) \
        __builtin_amdgcn_global_load_lds((const unsigned*)((const char*)(gbase) + (voff)[_i]), (PG8_LAS unsigned*)(lds + (bufoff) + ldsw + _i * 8192), 16, 0, 0); } while (0)
#define PG8_LDA(dst, b, h) do { _Pragma("unroll") for (int m = 0; m < 4; ++m) _Pragma("unroll") for (int k = 0; k < 2; ++k) dst[m][k] = *(const PG8_LAS bf16x8*)(lds + PG8_SA(b, h) + aoff + m * 2048 + k * 1024); } while (0)
#define PG8_LDB(dst, b, h) do { _Pragma("unroll") for (int n = 0; n < 2; ++n) _Pragma("unroll") for (int k = 0; k < 2; ++k) dst[n][k] = *(const PG8_LAS bf16x8*)(lds + PG8_SB(b, h) + boff + n * 2048 + k * 1024); } while (0)
#define PG8_MMA(ai, bj, At, Bt) do { __builtin_amdgcn_s_setprio(1); _Pragma("unroll") for (int m = 0; m < 4; ++m) _Pragma("unroll") for (int n = 0; n < 2; ++n) _Pragma("unroll") for (int k = 0; k < 2; ++k) \
        acc[ai][bj][m][n] = __builtin_amdgcn_mfma_f32_16x16x32_bf16(Bt[n][k], At[m][k], acc[ai][bj][m][n], 0, 0, 0); __builtin_amdgcn_s_setprio(0); } while (0)
#define PG8_WAIT_V(n) asm volatile("s_waitcnt vmcnt(" #n ")" ::: "memory")
#define PG8_WAIT_L(n) asm volatile("s_waitcnt lgkmcnt(" #n ")" ::: "memory")
#define PG8_BAR __builtin_amdgcn_s_barrier()
#define PG8_SCHED __builtin_amdgcn_sched_barrier(0)
    Unit cur, nxt; int ui = 0;
    if (!S.next(0, cur)) return;
    f32x4 acc[2][2][4][2];
#pragma unroll
    for (int a = 0; a < 2; ++a)
#pragma unroll
        for (int b = 0; b < 2; ++b)
#pragma unroll
            for (int m = 0; m < 4; ++m)
#pragma unroll
                for (int n = 0; n < 2; ++n) acc[a][b][m][n] = (f32x4){0.f, 0.f, 0.f, 0.f};
    bf16x8 At[4][2], B0[2][2], B1[2][2];
    unsigned vA0[2], vA1[2], nA0[2], nA1[2];
#pragma unroll
    for (int i = 0; i < 2; ++i) { vA0[i] = (unsigned)S.arow(0, cur, RA[i]) * K2 + CA2[i]; vA1[i] = (unsigned)S.arow(0, cur, HALF + RA[i]) * K2 + CA2[i]; }
    const char* const gA = (const char*)g.A; const char* cB = (const char*)g.Bt + (size_t)S.brow(cur) * K2;
    S.a_ready(cur);
    if constexpr (SP2) {
        PG8_STAGE(PG8_SB(0, 0), cB, voffB); PG8_STAGE(PG8_SB(0, 1), cB + hstep, voffB); PG8_STAGE(PG8_SA(0, 0), gA, vA0); PG8_STAGE(PG8_SA(0, 1), gA, vA1);
        if (wr == 1) PG8_BAR;
        PG8_WAIT_V(2); PG8_BAR;
        PG8_STAGE(PG8_SB(1, 0), cB + kstep, voffB); PG8_STAGE(PG8_SA(1, 0), gA + kstep, vA0); PG8_STAGE(PG8_SB(1, 1), cB + hstep + kstep, voffB);
        PG8_WAIT_V(6); PG8_BAR;
    } else {
        PG8_STAGE(PG8_SB(0, 0), cB, voffB); PG8_STAGE(PG8_SA(0, 0), gA, vA0); PG8_STAGE(PG8_SB(0, 1), cB + hstep, voffB); PG8_STAGE(PG8_SA(0, 1), gA, vA1);
        if (wr == 1) PG8_BAR;
        PG8_WAIT_V(4); PG8_BAR;
        PG8_STAGE(PG8_SB(1, 0), cB + kstep, voffB); PG8_STAGE(PG8_SA(1, 0), gA + kstep, vA0); PG8_STAGE(PG8_SB(1, 1), cB + hstep + kstep, voffB);
        PG8_WAIT_V(6); PG8_BAR;
    }
    for (;;) {
        const bool has_next = S.next(ui + 1, nxt);
#pragma unroll
        for (int i = 0; i < 2; ++i) { nA0[i] = has_next ? (unsigned)S.arow(ui + 1, nxt, RA[i]) * K2 + CA2[i] : vA0[i]; nA1[i] = has_next ? (unsigned)S.arow(ui + 1, nxt, HALF + RA[i]) * K2 + CA2[i] : vA1[i]; }
        const char* nB = has_next ? (const char*)g.Bt + (size_t)S.brow(nxt) * K2 : cB;
        for (int t = 0; t < nt; t += 2) {
            const bool last = (t == nt - 2);
            const char* a1 = gA + (size_t)(t + 1) * kstep;
            const char* a2 = last ? gA : gA + (size_t)(t + 2) * kstep; const unsigned x0[2] = {last ? nA0[0] : vA0[0], last ? nA0[1] : vA0[1]}, x1[2] = {last ? nA1[0] : vA1[0], last ? nA1[1] : vA1[1]}; const char* b2 = last ? nB : cB + (size_t)(t + 2) * kstep;
            const char* a3 = a2 + kstep; const char* b3 = b2 + kstep;
            if (last && has_next) S.a_ready(nxt);
            if constexpr (SP2) {
            PG8_LDB(B0, 0, 0); PG8_LDB(B1, 0, 1); PG8_SCHED; PG8_LDA(At, 0, 0); PG8_STAGE(PG8_SA(1, 1), a1, vA1);
            PG8_WAIT_V(8); PG8_WAIT_L(0); PG8_BAR; PG8_MMA(0, 0, At, B0); PG8_MMA(0, 1, At, B1); PG8_BAR; PG8_SCHED;
            PG8_LDA(At, 0, 1); PG8_STAGE(PG8_SB(0, 0), b2, voffB); PG8_STAGE(PG8_SB(0, 1), b2 + hstep, voffB); PG8_STAGE(PG8_SA(0, 0), a2, x0);
            PG8_WAIT_V(8); PG8_WAIT_L(0); PG8_BAR; PG8_MMA(1, 0, At, B0); PG8_MMA(1, 1, At, B1); PG8_BAR; PG8_SCHED;
            PG8_LDB(B0, 1, 0); PG8_LDB(B1, 1, 1); PG8_SCHED; PG8_LDA(At, 1, 0); PG8_STAGE(PG8_SA(0, 1), a2, x1);
            PG8_WAIT_V(8); PG8_WAIT_L(0); PG8_BAR; PG8_MMA(0, 0, At, B0); PG8_MMA(0, 1, At, B1); PG8_BAR; PG8_SCHED;
            PG8_LDA(At, 1, 1); PG8_STAGE(PG8_SB(1, 0), b3, voffB); PG8_STAGE(PG8_SB(1, 1), b3 + hstep, voffB); PG8_STAGE(PG8_SA(1, 0), a3, x0);
            PG8_WAIT_V(8); PG8_WAIT_L(0); PG8_BAR; PG8_MMA(1, 0, At, B0); PG8_MMA(1, 1, At, B1); PG8_BAR; PG8_SCHED;
            } else {
            PG8_LDB(B0, 0, 0); PG8_SCHED; PG8_LDA(At, 0, 0); PG8_STAGE(PG8_SA(1, 1), a1, vA1);
            PG8_WAIT_L(8); PG8_BAR; PG8_WAIT_L(0); PG8_MMA(0, 0, At, B0); PG8_BAR; PG8_SCHED;
            PG8_LDB(B1, 0, 1); PG8_STAGE(PG8_SB(0, 0), b2, voffB);
            PG8_BAR; PG8_WAIT_L(0); PG8_MMA(0, 1, At, B1); PG8_BAR;
            PG8_LDA(At, 0, 1); PG8_STAGE(PG8_SA(0, 0), a2, x0);
            PG8_BAR; PG8_WAIT_L(0); PG8_MMA(1, 0, At, B0); PG8_BAR; PG8_SCHED;
            PG8_STAGE(PG8_SB(0, 1), b2 + hstep, voffB);
            PG8_WAIT_V(6); PG8_BAR; PG8_MMA(1, 1, At, B1); PG8_BAR;
            PG8_LDB(B0, 1, 0); PG8_SCHED; PG8_LDA(At, 1, 0); PG8_STAGE(PG8_SA(0, 1), a2, x1);
            PG8_WAIT_L(8); PG8_BAR; PG8_WAIT_L(0); PG8_MMA(0, 0, At, B0); PG8_BAR; PG8_SCHED;
            PG8_LDB(B1, 1, 1); PG8_STAGE(PG8_SB(1, 0), b3, voffB);
            PG8_BAR; PG8_WAIT_L(0); PG8_MMA(0, 1, At, B1); PG8_BAR;
            PG8_LDA(At, 1, 1); PG8_STAGE(PG8_SA(1, 0), a3, x0);
            PG8_BAR; PG8_WAIT_L(0); PG8_MMA(1, 0, At, B0); PG8_BAR; PG8_SCHED;
            PG8_STAGE(PG8_SB(1, 1), b3 + hstep, voffB);
            PG8_WAIT_V(6); PG8_BAR; PG8_MMA(1, 1, At, B1); PG8_BAR;
            }
        }
        if constexpr (ALIGN_EPI) { if (wr == 0) PG8_BAR; }
        if constexpr (!Epi::AFTER_DRAIN) { E(acc, cur, wr, wc, fr, fq); S.done(cur); }
        if (!has_next) break;
#pragma unroll
        for (int a = 0; a < 2; ++a)
#pragma unroll
            for (int b = 0; b < 2; ++b)
#pragma unroll
                for (int m = 0; m < 4; ++m)
#pragma unroll
                    for (int n = 0; n < 2; ++n) acc[a][b][m][n] = (f32x4){0.f, 0.f, 0.f, 0.f};
        cur = nxt; cB = nB; ++ui;
#pragma unroll
        for (int i = 0; i < 2; ++i) { vA0[i] = nA0[i]; vA1[i] = nA1[i]; }
        if constexpr (ALIGN_EPI) { if (wr == 1) PG8_BAR; }
    }
    PG8_WAIT_V(0);
    if constexpr (!ALIGN_EPI) { if (wr == 0) PG8_BAR; }
    PG8_BAR;
    if constexpr (Epi::AFTER_DRAIN) { E.fused(acc, cur, wr, wc, fr, fq, lds, wid, lane); S.done(cur); }
#undef PG8_SA
#undef PG8_SB
#undef PG8_STAGE
#undef PG8_LDA
#undef PG8_LDB
#undef PG8_MMA
#undef PG8_WAIT_V
#undef PG8_WAIT_L
#undef PG8_BAR
#undef PG8_SCHED
}


}
namespace att {
typedef float f32x16 __attribute__((ext_vector_type(16)));
typedef short s16x4 __attribute__((ext_vector_type(4)));
typedef short v4i16_t __attribute__((ext_vector_type(4)));
typedef unsigned u32x4a __attribute__((ext_vector_type(4)));
constexpr int PITCH = 512;
constexpr int LDS_K = 0, LDS_V = 24576, LDS_WS = LDS_V + 4 * 16384, LDS_OST = LDS_WS + 2048, LDS_WT = LDS_OST + 8 * 4096, LDS_TOTAL = LDS_WT + 8 * 512, RES_V = 32768;
constexpr float THR = 5.0f;
__device__ __forceinline__ int crow(int r, int hi) { return (r & 3) + 8 * (r >> 2) + 4 * hi; }
__device__ __forceinline__ void glds16(const void* gsrc, unsigned lds_dst) { unsigned keep;
    asm volatile("s_mov_b32 %0, m0\n\ts_mov_b32 m0, %2\n\ts_nop 0\n\tglobal_load_lds_dwordx4 %1, off\n\ts_mov_b32 m0, %0" : "=&s"(keep) : "v"(gsrc), "s"(lds_dst) : "memory"); }
__device__ __forceinline__ f32x16 splat(float x) { f32x16 v;
#pragma unroll
    for (int r = 0; r < 16; ++r) v[r] = x;
    return v; }
typedef __attribute__((address_space(3))) const char* lds_cptr;
__device__ __forceinline__ s16x4 vtr(lds_cptr p) { return __builtin_bit_cast(s16x4, __builtin_amdgcn_ds_read_tr16_b64_v4i16((__attribute__((address_space(3))) v4i16_t*)p)); }
__device__ __forceinline__ float swapmax(float m) { auto rr = __builtin_amdgcn_permlane32_swap(__float_as_uint(m), __float_as_uint(m), false, false); return fmaxf(__uint_as_float(rr[0]), __uint_as_float(rr[1])); }
__device__ __forceinline__ float swapsum(float m) { auto rr = __builtin_amdgcn_permlane32_swap(__float_as_uint(m), __float_as_uint(m), false, false); return __uint_as_float(rr[0]) + __uint_as_float(rr[1]); }
__device__ __forceinline__ float max3a(float a, float b, float c) { float r; asm("v_max3_f32 %0, %1, %2, %3" : "=v"(r) : "v"(a), "v"(b), "v"(c)); return r; }
#define ATT_WAITBAR(N) asm volatile("s_waitcnt vmcnt(" #N ") lgkmcnt(0)\n\ts_barrier" ::: "memory")

template <int DV, int MODE, bool RES = false>
__device__ __forceinline__ void attn_unit(const int b, const int h, const int qb, const bf16* Qp, const bf16* __restrict__ Kp, const bf16* __restrict__ Vp, bf16* Op,
                                          const unsigned* __restrict__ sel, float* o1scr, const float lam, const float* __restrict__ subg, char* shm,
                                          const unsigned short* __restrict__ ql = nullptr, const int nvalid = 0, bf16* opart = nullptr, float* mlp = nullptr, const bool blk_sync = false) {
    constexpr bool MOBA = (MODE != 1);
    constexpr int ND = DV / 32;
    const int tid = threadIdx.x, lane = tid & 63, r32 = lane & 31, hi = lane >> 5;
    const int wid = __builtin_amdgcn_readfirstlane(tid >> 6);
    const long rowbase = (long)b * S; const int q0 = qb * 256;
    const unsigned lds0 = (unsigned)(uintptr_t)shm;
    float* wsf = (float*)(shm + LDS_WS) + wid * 64;
    const lds_cptr shm3 = (lds_cptr)shm;
    const int NT = (MODE == 3 && RES) ? (wid >> 1) + 1 : ((MODE >= 2) ? 4 : 4 * (qb + 1));
    const int wbase = (RES && MODE == 2) ? 0 : wid * 32;
    const int qrel = wbase + r32;
#pragma unroll 1
    for (int comp = 0; comp < (MOBA ? 1 : 2); ++comp) {
        const int qkcol = MOBA ? h * 64 : (2 * h + comp) * 64, vcol = MOBA ? h * 64 : h * 128;
        const bf16* Kh = Kp + rowbase * PITCH + qkcol; const bf16* Vh = Vp + rowbase * PITCH + vcol;
        const bf16* ksrc = Kh + (long)lane * PITCH + wid * 8;
        const bf16* vsrc = Vh + (long)(16 * (wid & 3) + (lane >> 2)) * PITCH + (wid >> 2) * 32 + (lane & 3) * 8;
        const unsigned kdst = lds0 + LDS_K + wid * 1024, vdst = lds0 + LDS_V + wid * 1024;
#define ATT_KR0(n) (MODE == 2 ? q0 + 64 * (n) : ((n) < 4 ? q0 + 64 * (n) : 64 * ((n) - 4)))
#define ATT_DMA(n, ks_, vs_) do { const long kr_ = ATT_KR0(n); glds16(ksrc + kr_ * PITCH, (unsigned)__builtin_amdgcn_readfirstlane(kdst + (ks_) * 8192)); \
        glds16(vsrc + kr_ * PITCH, (unsigned)__builtin_amdgcn_readfirstlane(vdst + (vs_) * 16384)); \
        if (DV == 128) glds16(vsrc + kr_ * PITCH + 64, (unsigned)__builtin_amdgcn_readfirstlane(vdst + (vs_) * 16384 + 8192)); } while (0)
        if (!RES) { ATT_DMA(0, 0, 0); ATT_DMA(1, 1, 1); }
        int qi = q0 + qrel;
        if (MODE == 2) qi = (int)ql[qrel < nvalid ? qrel : 0];
        const bf16* Qw = Qp + (rowbase + qi) * PITCH + qkcol;
        bf16x8 qr[4];
#pragma unroll
        for (int d0 = 0; d0 < 4; ++d0) qr[d0] = *reinterpret_cast<const bf16x8*>(&Qw[d0 * 16 + hi * 8]);
        unsigned smq3 = 0u; float2 ml3[3] = {make_float2(-INFINITY, 0.f), make_float2(-INFINITY, 0.f), make_float2(-INFINITY, 0.f)};
        if (MODE == 3 && lane < 32) { const size_t qx = (size_t)(b * 8 + h) * S + q0 + wid * 32 + lane; smq3 = sel[qx]; const int ns = __popc(smq3);
#pragma unroll
            for (int k = 0; k < 3; ++k) if (k < ns) ml3[k] = *(const float2*)(mlp + (qx * 3 + k) * 2); }
        if (RES && blk_sync) asm volatile("s_waitcnt vmcnt(0)\n\ts_barrier" ::: "memory");
        float mref = 0.f;
        f32x16 ol = splat(0.f);
        const bf16x8 ones = (bf16x8){0x3F80, 0x3F80, 0x3F80, 0x3F80, 0x3F80, 0x3F80, 0x3F80, 0x3F80};
        f32x16 o[ND];
#pragma unroll
        for (int d = 0; d < ND; ++d) o[d] = splat(0.f);
        int slot = 0, vslot = 0;
        u32x4a pw[4];
        constexpr int NPV = 4 * ND, NM = 4 + NPV;
        const int vlane = ((lane >> 4) & 1) * 32 + (lane & 3) * 8 + (4 * hi + ((lane & 15) >> 2)) * 64;
#define ATT_KLD(d0) do { kf[2 * (d0)] = *(const __attribute__((address_space(3))) bf16x8*)(kb + (d0) * 2048); kf[2 * (d0) + 1] = *(const __attribute__((address_space(3))) bf16x8*)(kb + (d0) * 2048 + 512); } while (0)
#define ATT_QK(P0, P1) do { const lds_cptr kb = shm3 + LDS_K + slot * 8192 + hi * 1024 + r32 * 16; bf16x8 kf[8]; \
        ATT_KLD(0); ATT_KLD(1); if (DV == 64) { ATT_KLD(2); ATT_KLD(3); } \
        const f32x16 cop = splat(-mref); __builtin_amdgcn_sched_barrier(0);   \
        P0 = __builtin_amdgcn_mfma_f32_32x32x16_bf16(kf[0], qr[0], cop, 0, 0, 0); P1 = __builtin_amdgcn_mfma_f32_32x32x16_bf16(kf[1], qr[0], cop, 0, 0, 0); \
        if (DV == 128) { ATT_KLD(2); ATT_KLD(3); __builtin_amdgcn_sched_barrier(0); } \
        _Pragma("unroll") for (int d0 = 1; d0 < 4; ++d0) { P0 = __builtin_amdgcn_mfma_f32_32x32x16_bf16(kf[2 * d0], qr[d0], P0, 0, 0, 0); P1 = __builtin_amdgcn_mfma_f32_32x32x16_bf16(kf[2 * d0 + 1], qr[d0], P1, 0, 0, 0); } } while (0)
#define ATT_MASK(P0, P1, n) do { if (MODE != 2 && (n) < 4 && (64 * (n) + 63 > wid * 32)) { const int kb0 = 64 * (n) + 4 * hi; \
        _Pragma("unroll") for (int r = 0; r < 16; ++r) { const int kv = kb0 + (r & 3) + 8 * (r >> 2); if (kv > qrel) P0[r] = -INFINITY; if (kv + 32 > qrel) P1[r] = -INFINITY; } } } while (0)
#define ATT_ROWMAX(P0, P1, RM) do { asm volatile("s_nop 15\n\ts_nop 7" : "+v"(P0), "+v"(P1)); \
        float a_ = max3a(P0[0], P0[1], P1[0]), b_ = max3a(P0[2], P0[3], P1[1]); a_ = max3a(a_, P1[2], P1[3]); \
        _Pragma("unroll") for (int r = 4; r < 16; r += 4) { a_ = max3a(a_, P0[r], P0[r + 1]); b_ = max3a(b_, P0[r + 2], P0[r + 3]); a_ = max3a(a_, P1[r], P1[r + 1]); b_ = max3a(b_, P1[r + 2], P1[r + 3]); } \
        RM = swapmax(fmaxf(a_, b_)); } while (0)
#define ATT_VOFF(j) (((j) >> 2) * 4096 + ((j) & 3) * 1024)
        { if (!RES) { if (DV == 128) ATT_WAITBAR(3); else ATT_WAITBAR(2); ATT_DMA(2, 2, 2); }
          f32x16 p0, p1; ATT_QK(p0, p1); ATT_MASK(p0, p1, 0);
          float rm; ATT_ROWMAX(p0, p1, rm); mref = rm;
#pragma unroll
          for (int r = 0; r < 16; ++r) { p0[r] = __builtin_amdgcn_exp2f(p0[r] - rm); p1[r] = __builtin_amdgcn_exp2f(p1[r] - rm); }
#pragma unroll
          for (int k = 0; k < 2; ++k)
#pragma unroll
              for (int j = 0; j < 4; ++j) { pw[k][j] = pg8::cvt_pk_bf16(p0[8 * k + 2 * j], p0[8 * k + 2 * j + 1]); pw[2 + k][j] = pg8::cvt_pk_bf16(p1[8 * k + 2 * j], p1[8 * k + 2 * j + 1]); }
          slot = 1; vslot = 1; }
#pragma unroll 1
        for (int n = 1; n < NT; ++n) {
            if (!RES) { if (n + 1 < NT) { if (DV == 128) ATT_WAITBAR(3); else ATT_WAITBAR(2); } else ATT_WAITBAR(0);
                if (n + 2 < NT) { const int s2 = slot + 2 >= 3 ? slot - 1 : slot + 2; ATT_DMA(n + 2, s2, (vslot + 2) & 3); } }
            f32x16 p0, p1; ATT_QK(p0, p1); ATT_MASK(p0, p1, n);
            float rm; ATT_ROWMAX(p0, p1, rm);
            bool resc = false; float fsc = 1.f;
            if (__any(rm > THR)) {
                const float dl = fmaxf(rm, 0.f); mref += dl; fsc = __builtin_amdgcn_exp2f(-dl); resc = true;
#pragma unroll
                for (int r = 0; r < 16; ++r) { p0[r] -= dl; p1[r] -= dl; } }
            { const lds_cptr vp = shm3 + (RES ? RES_V + ((vslot + 3) & 3) * 8192 : LDS_V + ((vslot + 3) & 3) * 16384) + vlane;
              s16x4 vlo[4], vhi[4]; u32x4a pwn[4];
#pragma unroll
              for (int j = 0; j < 4; ++j) { vlo[j] = vtr(vp + ATT_VOFF(j)); vhi[j] = vtr(vp + ATT_VOFF(j) + 512); }
              __builtin_amdgcn_sched_barrier(0);
#pragma unroll
              for (int g = 0; g < NM; ++g) {
                  if (g < 4) ol = __builtin_amdgcn_mfma_f32_32x32x16_bf16(__builtin_bit_cast(bf16x8, pw[g]), ones, ol, 0, 0, 0);
                  else { const int j = g - 4; const bf16x8 vf = (bf16x8){vlo[j & 3][0], vlo[j & 3][1], vlo[j & 3][2], vlo[j & 3][3], vhi[j & 3][0], vhi[j & 3][1], vhi[j & 3][2], vhi[j & 3][3]};
                      o[j >> 2] = __builtin_amdgcn_mfma_f32_32x32x16_bf16(__builtin_bit_cast(bf16x8, pw[j & 3]), vf, o[j >> 2], 0, 0, 0);
                      if (j + 4 < NPV) { vlo[j & 3] = vtr(vp + ATT_VOFF(j + 4)); vhi[j & 3] = vtr(vp + ATT_VOFF(j + 4) + 512); } }
                  const int npair = (DV == 128) ? (g < 16 ? 1 : 0) : (g < 4 ? 2 : 1);
                  const int pbase = (DV == 128) ? g : (g < 4 ? 2 * g : g + 4);
#pragma unroll
                  for (int q2 = 0; q2 < npair; ++q2) { const int pi = pbase + q2;
                      const float ea = __builtin_amdgcn_exp2f(pi < 8 ? p0[2 * pi] : p1[2 * pi - 16]), eb = __builtin_amdgcn_exp2f(pi < 8 ? p0[2 * pi + 1] : p1[2 * pi - 15]);
                      pwn[pi >> 2][pi & 3] = pg8::cvt_pk_bf16(ea, eb); }
                  __builtin_amdgcn_sched_barrier(0);
              }
#pragma unroll
              for (int k = 0; k < 4; ++k) pw[k] = pwn[k]; }
            if (resc) {
                if (hi == 0) wsf[r32] = fsc;
                asm volatile("s_waitcnt lgkmcnt(0)" ::: "memory");
#pragma unroll
                for (int r = 0; r < 16; ++r) { const float fr = wsf[crow(r, hi)]; ol[r] *= fr;
#pragma unroll
                    for (int d = 0; d < ND; ++d) o[d][r] *= fr; }
            }
            slot = RES ? slot + 1 : (slot == 2 ? 0 : slot + 1); vslot = (vslot + 1) & 3;
        }
        { const lds_cptr vp = shm3 + (RES ? RES_V + ((vslot + 3) & 3) * 8192 : LDS_V + ((vslot + 3) & 3) * 16384) + vlane;
#pragma unroll
          for (int ks = 0; ks < 4; ++ks) ol = __builtin_amdgcn_mfma_f32_32x32x16_bf16(__builtin_bit_cast(bf16x8, pw[ks]), ones, ol, 0, 0, 0);
#pragma unroll
          for (int j = 0; j < NPV; ++j) { const s16x4 vlo = vtr(vp + ATT_VOFF(j)), vhi = vtr(vp + ATT_VOFF(j) + 512);
              const bf16x8 vf = (bf16x8){vlo[0], vlo[1], vlo[2], vlo[3], vhi[0], vhi[1], vhi[2], vhi[3]};
              o[j >> 2] = __builtin_amdgcn_mfma_f32_32x32x16_bf16(__builtin_bit_cast(bf16x8, pw[j & 3]), vf, o[j >> 2], 0, 0, 0);
              if ((j & 7) == 7) __builtin_amdgcn_sched_barrier(0); } }
#undef ATT_QK
#undef ATT_KLD
#undef ATT_MASK
#undef ATT_ROWMAX
#undef ATT_VOFF
        int lane_e = lane, q0_e = q0 + wbase, h_e = h; asm volatile("" : "+v"(lane_e), "+v"(q0_e), "+v"(h_e));
        float rli[16];
#pragma unroll
        for (int r = 0; r < 16; ++r) rli[r] = __builtin_amdgcn_rcpf(ol[r]);
        bf16* stg = (bf16*)(shm + LDS_OST) + wid * 2048;
        if (MOBA) {
#pragma unroll
            for (int r = 0; r < 16; ++r) { const int orow = crow(r, hi);
#pragma unroll
                for (int d = 0; d < 2; ++d) stg[orow * 64 + d * 32 + (lane_e & 31)] = (bf16)f2bf(o[d][r] * rli[r]); }
            if (MODE == 0) {
                asm volatile("s_waitcnt lgkmcnt(0)" ::: "memory");
                bf16* Ow = Op + (rowbase + q0_e) * PITCH + h_e * 64;
#pragma unroll
                for (int i = 0; i < 4; ++i) { const int row = i * 8 + (lane_e >> 3), ch = lane_e & 7; const u32x4a v = *(const u32x4a*)(stg + row * 64 + ch * 8); *(u32x4a*)(Ow + (long)row * PITCH + ch * 8) = v; }
            } else {
                if ((lane_e & 31) == 0) {
#pragma unroll
                    for (int r = 0; r < 16; ++r) wsf[crow(r, hi)] = ol[r]; }
                int* dtab = (int*)wsf + 32;
                float* wt = (float*)(shm + LDS_WT) + wid * 128;
                asm volatile("s_waitcnt lgkmcnt(0)" ::: "memory");
                const size_t bhq = (size_t)(b * 8 + h_e) * S;
                if (MODE == 2) {
                    if (lane_e < 32) { const int slotr = (q0_e - q0) + lane_e; const int qq = (int)ql[slotr < nvalid ? slotr : 0];
                        int d = -1;
                        if (slotr < nvalid) { const unsigned smq = sel[bhq + qq]; d = (int)((bhq + qq) * 3) + __popc(smq & ((1u << qb) - 1u));
                            *(float2*)(mlp + (size_t)d * 2) = make_float2(mref, wsf[lane_e]); }
                        dtab[lane_e] = d; }
                    asm volatile("s_waitcnt lgkmcnt(0)" ::: "memory");
#pragma unroll
                    for (int i = 0; i < 4; ++i) { const int row = i * 8 + (lane_e >> 3), ch = lane_e & 7; const int d = dtab[row];
                        if (d >= 0) { const u32x4a v = *(const u32x4a*)(stg + row * 64 + ch * 8); *(u32x4a*)(opart + (size_t)d * 64 + ch * 8) = v; } }
                } else {
                    u32x4a pv[4][3];
#pragma unroll
                    for (int i = 0; i < 4; ++i) { const int row = i * 8 + (lane_e >> 3), ch = lane_e & 7; const bf16* pp = opart + ((bhq + q0_e + row) * 3) * 64 + ch * 8;
#pragma unroll
                        for (int k = 0; k < 3; ++k) pv[i][k] = *(const u32x4a*)(pp + k * 64); }
                    if (lane_e < 32) { const int ns = __popc(smq3);
                        const float md = mref, ld = wsf[lane_e];
                        float M = md;
#pragma unroll
                        for (int k = 0; k < 3; ++k) if (k < ns) M = fmaxf(M, ml3[k].x);
                        float wd = ld * __builtin_amdgcn_exp2f(md - M), wk[3], tot = wd;
#pragma unroll
                        for (int k = 0; k < 3; ++k) { wk[k] = (k < ns) ? ml3[k].y * __builtin_amdgcn_exp2f(ml3[k].x - M) : 0.f; tot += wk[k]; }
                        const float inv = 1.f / tot;
                        *(f32x4*)(wt + lane_e * 4) = (f32x4){wd * inv, wk[0] * inv, wk[1] * inv, wk[2] * inv}; }
                    asm volatile("s_waitcnt lgkmcnt(0)" ::: "memory");
                    bf16* Ow = Op + (rowbase + q0_e) * PITCH + h_e * 64;
#pragma unroll
                    for (int i = 0; i < 4; ++i) { const int row = i * 8 + (lane_e >> 3), ch = lane_e & 7;
                        const f32x4 a = *(const f32x4*)(wt + row * 4); const u32x4a v = *(const u32x4a*)(stg + row * 64 + ch * 8);
                        f32x4 x0 = pg8::bflo(v.x, v.y) * a[0], x1 = pg8::bflo(v.z, v.w) * a[0];
#pragma unroll
                        for (int k = 0; k < 3; ++k) { const bool on = a[1 + k] != 0.f; const f32x4 y0 = pg8::bflo(pv[i][k].x, pv[i][k].y) * a[1 + k], y1 = pg8::bflo(pv[i][k].z, pv[i][k].w) * a[1 + k];
#pragma unroll
                            for (int e = 0; e < 4; ++e) { x0[e] += on ? y0[e] : 0.f; x1[e] += on ? y1[e] : 0.f; } }
                        *(u32x4a*)(Ow + (long)row * PITCH + ch * 8) = pg8::pack8(x0, x1); }
                }
            }
        } else {
            float* scr = o1scr + (size_t)comp * 32768 + (size_t)wid * 4096 + lane_e;
#pragma unroll
            for (int d = 0; d < ND; ++d) { float* sp = scr + d * 1024; asm volatile("" : "+v"(sp));
#pragma unroll
                for (int r = 0; r < 16; ++r) sp[r * 64] = o[d][r] * rli[r]; }
            if (comp == 1) {
                asm volatile("s_waitcnt vmcnt(0)" ::: "memory");
                const int row = lane_e >> 1, hf = lane_e & 1;
                const int hi_r = (row >> 2) & 1, rr = (row & 3) | ((row >> 3) << 2);
                const float* A0 = o1scr + (size_t)wid * 4096 + rr * 64 + hi_r * 32 + hf * 2048;
                const float* B0 = A0 + 32768;
                f32x4 v[16]; float ssq = 0.f;
#pragma unroll
                for (int d2 = 0; d2 < 2; ++d2)
#pragma unroll
                    for (int c4 = 0; c4 < 8; ++c4) { const f32x4 a = __builtin_nontemporal_load((const f32x4*)(A0 + d2 * 1024 + c4 * 4)), bb = __builtin_nontemporal_load((const f32x4*)(B0 + d2 * 1024 + c4 * 4));
                        const f32x4 w = a - bb * lam; v[d2 * 8 + c4] = w; ssq += (w[0] * w[0] + w[1] * w[1]) + (w[2] * w[2] + w[3] * w[3]); }
                ssq += __shfl_xor(ssq, 1);
                const float rstd = rsqrtf(ssq * (1.f / 128.f) + EPS) * 0.8f;
                bf16* Ow = Op + (rowbase + q0_e + row) * PITCH + h_e * 128 + hf * 64;
#pragma unroll
                for (int k = 0; k < 8; ++k) { const f32x4 g0 = *(const f32x4*)(subg + hf * 64 + k * 8), g1 = *(const f32x4*)(subg + hf * 64 + k * 8 + 4);
                    *(u32x4a*)(Ow + k * 8) = pg8::pack8(v[2 * k] * g0 * rstd, v[2 * k + 1] * g1 * rstd); }
            }
        }
        if (RES) asm volatile("s_waitcnt lgkmcnt(0)" ::: "memory"); else
        asm volatile("s_waitcnt vmcnt(0) lgkmcnt(0)\n\ts_barrier" ::: "memory");
    }
#undef ATT_KR0
#undef ATT_DMA
}
__device__ __forceinline__ void moba_block_issue(const bf16* __restrict__ Kp, const bf16* __restrict__ Vp, const int b, const int h, const int blk, char* shm) {
    const int tid = threadIdx.x, lane = tid & 63; const int wid = __builtin_amdgcn_readfirstlane(tid >> 6);
    const unsigned lds0 = (unsigned)(uintptr_t)shm;
    const bf16* ksrc = Kp + ((long)b * S + 256 * blk + lane) * PITCH + h * 64 + wid * 8;
    const bf16* vsrc = Vp + ((long)b * S + 256 * blk + 16 * (wid & 3) + (lane >> 2)) * PITCH + h * 64 + (wid >> 2) * 32 + (lane & 3) * 8;
    asm volatile("s_waitcnt lgkmcnt(0)\n\ts_barrier" ::: "memory");
#pragma unroll
    for (int n = 0; n < 4; ++n) { glds16(ksrc + (long)(64 * n) * PITCH, (unsigned)__builtin_amdgcn_readfirstlane(lds0 + n * 8192 + wid * 1024));
        glds16(vsrc + (long)(64 * n) * PITCH, (unsigned)__builtin_amdgcn_readfirstlane(lds0 + RES_V + n * 8192 + wid * 1024)); }
}
}

__device__ __forceinline__ float wave_sum(float v) {
#pragma unroll
    for (int o = 1; o < 64; o <<= 1) v += __shfl_xor(v, o);
    return v;
}
__device__ __forceinline__ void gate_wave(int b, int h, int chunk, int lane, const bf16* __restrict__ Qm, const LAS float* ksl, unsigned* __restrict__ sel, unsigned* qcnt, unsigned short* qlist) {
    const int qpos = chunk * 64 + lane, blk = chunk >> 2;
    const size_t t = (size_t)b * S + qpos;
    float q[64];
#pragma unroll
    for (int d8 = 0; d8 < 8; ++d8) { const v4u v = *(const v4u*)(Qm + t * 512 + h * 64 + d8 * 8);
        q[d8 * 8] = __uint_as_float(v.x << 16); q[d8 * 8 + 1] = __uint_as_float(v.x & 0xffff0000u); q[d8 * 8 + 2] = __uint_as_float(v.y << 16); q[d8 * 8 + 3] = __uint_as_float(v.y & 0xffff0000u);
        q[d8 * 8 + 4] = __uint_as_float(v.z << 16); q[d8 * 8 + 5] = __uint_as_float(v.z & 0xffff0000u); q[d8 * 8 + 6] = __uint_as_float(v.w << 16); q[d8 * 8 + 7] = __uint_as_float(v.w & 0xffff0000u); }
    float v0 = -3e38f, v1 = -3e38f, v2 = -3e38f; int i0 = -1, i1 = -1, i2 = -1;
    for (int j = 0; j < blk; ++j) {
        const LAS f32x4* kr = (const LAS f32x4*)(ksl + j * 64);
        float g = 0.f;
#pragma unroll
        for (int d4 = 0; d4 < 16; ++d4) { const f32x4 kv = kr[d4]; g += q[4 * d4] * kv[0] + q[4 * d4 + 1] * kv[1] + q[4 * d4 + 2] * kv[2] + q[4 * d4 + 3] * kv[3]; }
        if (g > v0) { v2 = v1; i2 = i1; v1 = v0; i1 = i0; v0 = g; i0 = j; }
        else if (g > v1) { v2 = v1; i2 = i1; v1 = g; i1 = j; }
        else if (g > v2) { v2 = g; i2 = j; }
    }
    unsigned m = 0u;
    if (i0 >= 0) m |= 1u << i0;
    if (i1 >= 0) m |= 1u << i1;
    if (i2 >= 0) m |= 1u << i2;
    sel[(size_t)(b * 8 + h) * S + qpos] = m;
    if (qcnt) {
        const int bh = b * 8 + h;
        int myc = 0;
        for (int j = 0; j < blk; ++j) { const unsigned long long bal = __ballot((m >> j) & 1u); if (lane == j) myc = (int)__popcll(bal); }
        int mybase = 0; if (lane < blk && myc) mybase = (int)atomicAdd(qcnt + bh * 32 + lane, (unsigned)myc);
        for (int j = 0; j < blk; ++j) { const bool sj = (m >> j) & 1u; const unsigned long long bal = __ballot(sj); const int base = __shfl(mybase, j);
            if (sj) qlist[(size_t)bh * QL_PER_BH + 256 * (31 * j - (j * (j - 1)) / 2) + base + __popcll(bal & ((1ull << lane) - 1ull))] = (unsigned short)qpos; }
    }
}
constexpr int NWAVES = 8;
constexpr int RING_OFF = 0, RING_BYTES = 131072;
constexpr int LDSCTL_OFF = RING_BYTES, MISC_OFF = LDSCTL_OFF + 320;
constexpr int TBL_OFF = LDSCTL_OFF + 512;
constexpr int ROWTAB_OFF = LDSCTL_OFF + 2048;
static_assert(att::LDS_TOTAL <= RING_BYTES && pg8::STAGE_BYTES <= RING_BYTES, "phase scratch fits the ring region");
constexpr int LDS_BYTES = 147456;
constexpr int CW_BAR = 4096;

struct Frame {
    LAS unsigned char* lds;
    volatile LAS unsigned* MISC;
    gu32* ctl;
    int tid, lane, wave, vcu, G;
};
struct Args { const float* in[23]; float* out; unsigned char* ws; int ph_lo, ph_hi, li, pad; };

template <int MODE> __device__ __forceinline__ int wmap(int c) {
    if (MODE == 1) { const int pn = c >> 8; const bool rp = (pn < 4) || (pn >= 6 && pn < 10); if (!rp) return c; const int o = c & 255; return (pn << 8) + (((o >> 5) & 1) << 7) + ((o >> 6) << 5) + (o & 31); }
    if (MODE == 2) return ((c >> 7) << 8) + (c & 127);
    if (MODE == 3) return ((c >> 7) << 8) + 128 + (c & 127);
    return c;
}
struct TrItem { const float* W; bf16* WT; int K, N, mode, item; };
__device__ __forceinline__ void tr_load(const TrItem& it, int lane, f32x4 (&v)[8]) {
    const int nblk = it.N / 32, kb = it.item / nblk, nb = it.item % nblk;
    const float* p = it.W + (size_t)(64 * kb + (lane >> 3)) * it.N + 32 * nb + 4 * (lane & 7);
#pragma unroll
    for (int i = 0; i < 8; ++i) v[i] = *(const GAS f32x4*)(p + (size_t)(8 * i) * it.N);
}
__device__ __forceinline__ void tr_store(const TrItem& it, int lane, const f32x4 (&v)[8], LAS float* scr) {
    const int nblk = it.N / 32, kb = it.item / nblk, nb = it.item % nblk, k0 = 64 * kb, n0 = 32 * nb;
#pragma unroll
    for (int i = 0; i < 8; ++i) { LAS float* d = scr + (8 * i + (lane >> 3)) * 33 + 4 * (lane & 7); d[0] = v[i][0]; d[1] = v[i][1]; d[2] = v[i][2]; d[3] = v[i][3]; }
    LDS_WAIT(); asm volatile("" ::: "memory");
    const int c = lane & 7;
#pragma unroll
    for (int j = 0; j < 4; ++j) { const int n = (lane >> 3) + 8 * j; const LAS float* s = scr + (8 * c) * 33 + n;
        v4u o; o.x = pk2(s[0 * 33], s[1 * 33]); o.y = pk2(s[2 * 33], s[3 * 33]); o.z = pk2(s[4 * 33], s[5 * 33]); o.w = pk2(s[6 * 33], s[7 * 33]);
        const int cc = n0 + n; const int row = it.mode == 1 ? wmap<1>(cc) : (it.mode == 2 ? wmap<2>(cc) : (it.mode == 3 ? wmap<3>(cc) : cc));
        *(GAS v4u*)(it.WT + (size_t)row * it.K + k0 + 8 * c) = o; }
    LDS_WAIT(); asm volatile("" ::: "memory");
}
__device__ __forceinline__ float silu_f(float v) { return v / (1.f + __expf(-v)); }

__device__ __forceinline__ void p0_prologue(Frame& F, const Args& args) {
    unsigned char* ws = args.ws;
    const int gw = F.vcu * NWAVES + F.wave, NGW = F.G * NWAVES, gt = gw * 64 + F.lane, NGT = NGW * 64;
    { const float* c = args.in[1]; const float* w = args.in[2]; float* modp = (float*)(ws + WS_MODP);
      LAS float* act = (LAS float*)(F.lds + RING_OFF + F.wave * 16384);
      for (int task = gw; task < 768; task += NGW) { const int n = (task % 96) * 64 + F.lane, ks = task / 96;
#pragma unroll
          for (int i = 0; i < 8; ++i) { const int idx = F.lane + 64 * i, bb = idx >> 7, kk = idx & 127; act[idx] = silu_f(c[bb * 1024 + ks * 128 + kk]); }
          LDS_WAIT(); asm volatile("" ::: "memory");
          float a0 = 0.f, a1 = 0.f, a2 = 0.f, a3 = 0.f;
#pragma unroll 8
          for (int kk = 0; kk < 128; ++kk) { const float wv = w[(size_t)(ks * 128 + kk) * 6144 + n];
              a0 += act[kk] * wv; a1 += act[128 + kk] * wv; a2 += act[256 + kk] * wv; a3 += act[384 + kk] * wv; }
          modp[(size_t)(ks * 4 + 0) * 6144 + n] = a0; modp[(size_t)(ks * 4 + 1) * 6144 + n] = a1; modp[(size_t)(ks * 4 + 2) * 6144 + n] = a2; modp[(size_t)(ks * 4 + 3) * 6144 + n] = a3;
          LDS_WAIT(); asm volatile("" ::: "memory"); } }
    { float2* tab = (float2*)(ws + WS_ROPE);
      for (int idx = gt; idx < S * 32; idx += NGT) { const int pos = idx >> 5, i = idx & 31;
          const float e = (float)(2 * i) / 64.f; const float inv = 1.0f / powf(10000.f, e); const float ang = (float)pos * inv;
          const double a = (double)ang; const double TWO_PI = 6.283185307179586476925286766559;
          const double n = rint(a / TWO_PI); const double r = a - n * TWO_PI; const double r2 = r * r;
          double sn = 0.0, cs = 0.0, ts = r, tc = 1.0;
          for (int k = 0; k < 16; ++k) { cs += tc; sn += ts; tc *= -r2 / (double)((2 * k + 1) * (2 * k + 2)); ts *= -r2 / (double)((2 * k + 2) * (2 * k + 3)); }
          tab[idx] = make_float2((float)cs, (float)sn); } }
    if (gt == 0) { float s1 = 0.f, s2 = 0.f; for (int i = 0; i < 64; ++i) { s1 += args.in[6][i] * args.in[7][i]; s2 += args.in[8][i] * args.in[9][i]; }
        *(float*)(ws + WS_LAM) = expf(s1) - expf(s2) + 0.2f; }
    { bf16* wr = (bf16*)(ws + WS_WR); const float* wg = args.in[15]; const float* we = args.in[17];
      for (int idx = gt; idx < 32 * 3 * 64 * 8; idx += NGT) { const int s = idx & 7, ln = (idx >> 3) & 63, nt = (idx >> 9) % 3, uu = idx / 1536;
          const int k = 32 * uu + 8 * (ln >> 4) + s, col = 16 * nt + (ln & 15);
          const float w = col < 4 ? wg[k * 4 + col] : (col < 36 ? we[k * 32 + col - 4] : 0.f);
          const unsigned hi = f2bf(w); const float rem = w - __uint_as_float(hi << 16);
          wr[idx] = (bf16)hi; wr[49152 + idx] = (bf16)f2bf(rem); } }
    LAS float* scr = (LAS float*)(F.lds + RING_OFF + F.wave * 16384);
    constexpr int I_IN = 16 * 160, I_PM = 8 * 32, I_PD = 8 * 32, I_OUT = 16 * 32, I_G = 32 * 256, I_U = 32 * 256, I_D = 32 * 256;
    constexpr int NITEMS = I_IN + I_PM + I_PD + I_OUT + I_G + I_U + I_D;
    unsigned char* wsb = ws;
#define TR_DECODE(IT, OUT) do { int r = (IT); \
        if (r < I_IN) { OUT = TrItem{args.in[5], (bf16*)(wsb + WS_WIN), 1024, 5120, 1, r}; break; } r -= I_IN; \
        if (r < I_PM) { OUT = TrItem{args.in[11], (bf16*)(wsb + WS_WPM), 512, 1024, 0, r}; break; } r -= I_PM; \
        if (r < I_PD) { OUT = TrItem{args.in[12], (bf16*)(wsb + WS_WPD), 512, 1024, 0, r}; break; } r -= I_PD; \
        if (r < I_OUT) { OUT = TrItem{args.in[13], (bf16*)(wsb + WS_WOUT), 1024, 1024, 0, r}; break; } r -= I_OUT; \
        if (r < I_G) { const int e = r >> 8; OUT = TrItem{args.in[19] + (size_t)e * 1024 * 512, (bf16*)(wsb + WS_WGU) + (size_t)e * 1024 * 1024, 1024, 512, 2, r & 255}; break; } r -= I_G; \
        if (r < I_U) { const int e = r >> 8; OUT = TrItem{args.in[20] + (size_t)e * 1024 * 512, (bf16*)(wsb + WS_WGU) + (size_t)e * 1024 * 1024, 1024, 512, 3, r & 255}; break; } r -= I_U; \
        { const int e = r >> 8; OUT = TrItem{args.in[21] + (size_t)e * 512 * 1024, (bf16*)(wsb + WS_WD) + (size_t)e * 1024 * 512, 512, 1024, 0, r & 255}; } } while (0)
    if (gw < NITEMS) {
        TrItem cur; TR_DECODE(gw, cur);
        f32x4 va[8], vb[8];
        tr_load(cur, F.lane, va);
        for (int it = gw; it < NITEMS; it += 2 * NGW) {
            TrItem nx1 = cur; const bool h1 = it + NGW < NITEMS; if (h1) { TR_DECODE(it + NGW, nx1); tr_load(nx1, F.lane, vb); }
            tr_store(cur, F.lane, va, scr);
            if (!h1) break;
            TrItem nx2 = nx1; const bool h2 = it + 2 * NGW < NITEMS; if (h2) { TR_DECODE(it + 2 * NGW, nx2); tr_load(nx2, F.lane, va); }
            tr_store(nx1, F.lane, vb, scr);
            if (!h2) break;
            cur = nx2;
        }
    }
#undef TR_DECODE
}
__device__ __forceinline__ void p1_xn(Frame& F, const Args& args) {
    unsigned char* ws = args.ws;
    LAS float* tA = (LAS float*)(F.lds + RING_OFF); LAS float* tS = tA + 1024;
    const int w = blockIdx.x, b = (w * 128) / S;
    const float* modp = (const float*)(ws + WS_MODP); const float* b_ada = args.in[3]; const float* g1n = args.in[4];
    for (int d = F.tid; d < 1024; d += NWAVES * 64) { float sc = b_ada[1024 + d], sh = b_ada[d];
#pragma unroll
        for (int p = 0; p < 8; ++p) { sc += modp[(size_t)(p * 4 + b) * 6144 + 1024 + d]; sh += modp[(size_t)(p * 4 + b) * 6144 + d]; }
        tA[d] = g1n[d] * (1.f + sc); tS[d] = sh; }
    if (F.tid < 96) { const int idx = w * 96 + F.tid, bb = idx / 6144, n = idx % 6144; float v = b_ada[n];
#pragma unroll
        for (int p = 0; p < 8; ++p) v += modp[(size_t)(p * 4 + bb) * 6144 + n];
        ((float*)(ws + WS_MOD))[idx] = v; }
    __syncthreads();
    const float* x = args.in[0]; bf16* XN = (bf16*)(ws + WS_XN);
    for (int i = 0; i < 16; ++i) {
        const int row = w * 128 + F.wave * 16 + i;
        const GAS f32x4* xr = (const GAS f32x4*)(x + (size_t)row * 1024) + F.lane;
        f32x4 v[4]; float ss = 0.f;
#pragma unroll
        for (int j = 0; j < 4; ++j) { v[j] = xr[64 * j]; ss += (v[j].x * v[j].x + v[j].y * v[j].y) + (v[j].z * v[j].z + v[j].w * v[j].w); }
        const float rstd = rsqrtf(wave_sum(ss) * (1.f / 1024.f) + EPS);
        GAS unsigned long long* o8 = (GAS unsigned long long*)(XN + (size_t)row * 1024) + F.lane;
#pragma unroll
        for (int j = 0; j < 4; ++j) { const f32x4 a = ((const LAS f32x4*)tA)[F.lane + 64 * j], s = ((const LAS f32x4*)tS)[F.lane + 64 * j];
            const f32x4 o = v[j] * rstd * a + s;
            o8[64 * j] = (unsigned long long)pg8::cvt_pk_bf16(o.x, o.y) | ((unsigned long long)pg8::cvt_pk_bf16(o.z, o.w) << 32); }
    }
}

__device__ __forceinline__ void moe_tables(Frame& F, const Args& args) {
    LAS int* tbl = (LAS int*)(F.lds + TBL_OFF);
    if (F.tid == 0) { const gu32* gc = F.ctl + CW_CNT; int o = 0;
        for (int e = 0; e < 32; ++e) { const int c = (int)__hip_atomic_load(gc + e, RLX_AGENT); tbl[e] = o; tbl[40 + e] = c; o += (c + 255) >> 8; }
        tbl[32] = o; }
    __syncthreads();
}
__device__ __forceinline__ void p7_router(Frame& F, const Args& args) {
    unsigned char* ws = args.ws;
    typedef float f32x4v __attribute__((ext_vector_type(4)));
    LAS float* tA = (LAS float*)(F.lds + RING_OFF); LAS float* tS = tA + 1024;
    LAS float* lgs = (LAS float*)(F.lds + RING_OFF + 8192) + F.wave * (16 * 48);
    LAS int* cntl = (LAS int*)(F.lds + RING_OFF + 8192 + 8 * 16 * 48 * 4); LAS int* basel = cntl + 32;
    const int w = blockIdx.x, b = (w * 128) / S;
    const float* mod = (const float*)(ws + WS_MOD); const float* g2n = args.in[14];
    for (int d = F.tid; d < 1024; d += NWAVES * 64) { tA[d] = g2n[d] * (1.f + mod[b * 6144 + 4096 + d]); tS[d] = mod[b * 6144 + 3072 + d]; }
    if (F.tid < 32) cntl[F.tid] = 0;
    __syncthreads();
    const int i16 = F.lane & 15, q = F.lane >> 4;
    const int row = w * 128 + F.wave * 16 + i16;
    const float* x1 = args.out; bf16* h2 = (bf16*)(ws + WS_XN); const bf16* wr = (const bf16*)(ws + WS_WR);
    float rstd;
    { const f32x4v* rp = (const f32x4v*)((const float*)(ws + WS_ROWSQ) + (size_t)row * 16); const f32x4v a = rp[0], c = rp[1], d = rp[2], e = rp[3];
      const float ss = ((a[0] + a[1]) + (a[2] + a[3])) + ((c[0] + c[1]) + (c[2] + c[3])) + ((d[0] + d[1]) + (d[2] + d[3])) + ((e[0] + e[1]) + (e[2] + e[3]));
      rstd = rsqrtf(ss * (1.f / 1024.f) + EPS); }
    f32x4v acc[3];
#pragma unroll
    for (int nt = 0; nt < 3; ++nt) acc[nt] = (f32x4v){0.f, 0.f, 0.f, 0.f};
    const float* xr = x1 + (size_t)row * 1024 + 8 * q;
    bf16* hr = h2 + (size_t)row * 1024 + 8 * q;
#pragma unroll 4
    for (int uu = 0; uu < 32; ++uu) {
        const f32x4v xa = *(const f32x4v*)(xr + 32 * uu), xb = *(const f32x4v*)(xr + 32 * uu + 4);
        const f32x4v aa = *(const LAS f32x4v*)(tA + 32 * uu + 8 * q), ab = *(const LAS f32x4v*)(tA + 32 * uu + 8 * q + 4);
        const f32x4v sa = *(const LAS f32x4v*)(tS + 32 * uu + 8 * q), sb = *(const LAS f32x4v*)(tS + 32 * uu + 8 * q + 4);
        const f32x4v ha = xa * rstd * aa + sa, hb = xb * rstd * ab + sb;
        const pg8::u32x4 hh = pg8::pack8(ha, hb);
        *(pg8::u32x4*)(hr + 32 * uu) = hh;
        const pg8::u32x4 hl = pg8::pack8(ha - pg8::bflo(hh.x, hh.y), hb - pg8::bflo(hh.z, hh.w));
        const bf16x8 ahi = __builtin_bit_cast(bf16x8, hh), alo = __builtin_bit_cast(bf16x8, hl);
#pragma unroll
        for (int nt = 0; nt < 3; ++nt) { const size_t bo = ((size_t)(uu * 3 + nt) * 64 + F.lane) * 8;
            const bf16x8 bhi = *(const bf16x8*)(wr + bo), blo = *(const bf16x8*)(wr + 49152 + bo);
            acc[nt] = __builtin_amdgcn_mfma_f32_16x16x32_bf16(ahi, bhi, acc[nt], 0, 0, 0);
            acc[nt] = __builtin_amdgcn_mfma_f32_16x16x32_bf16(alo, bhi, acc[nt], 0, 0, 0);
            acc[nt] = __builtin_amdgcn_mfma_f32_16x16x32_bf16(ahi, blo, acc[nt], 0, 0, 0); }
    }
#pragma unroll
    for (int nt = 0; nt < 3; ++nt)
#pragma unroll
        for (int r = 0; r < 4; ++r) lgs[(4 * q + r) * 48 + 16 * nt + i16] = acc[nt][r];
    LDS_WAIT(); asm volatile("" ::: "memory");
    int e0 = 0, e1 = 0, p0l = 0, p1l = 0; float w0 = 0.f, w1 = 0.f;
    if (F.lane < 16) {
        const LAS float* lr = lgs + F.lane * 48; const float* bg = args.in[16]; const float* be = args.in[18];
        float gl[4]; float gmx = -3e38f; int gi = 0;
#pragma unroll
        for (int i = 0; i < 4; ++i) { gl[i] = lr[i] + bg[i]; if (gl[i] > gmx) { gmx = gl[i]; gi = i; } }
        float gs = 0.f;
#pragma unroll
        for (int i = 0; i < 4; ++i) gs += expf(gl[i] - gmx);
        const float gw = 1.f / gs;
        float el[8]; float emx = -3e38f;
#pragma unroll
        for (int i = 0; i < 8; ++i) { el[i] = lr[4 + gi * 8 + i] + be[gi * 8 + i]; emx = fmaxf(emx, el[i]); }
        float es = 0.f, ep[8];
#pragma unroll
        for (int i = 0; i < 8; ++i) { ep[i] = expf(el[i] - emx); es += ep[i]; }
        int a0 = 0; float pa = -1.f;
#pragma unroll
        for (int i = 0; i < 8; ++i) if (ep[i] > pa) { pa = ep[i]; a0 = i; }
        int a1 = 0; float pb = -1.f;
#pragma unroll
        for (int i = 0; i < 8; ++i) if (i != a0 && ep[i] > pb) { pb = ep[i]; a1 = i; }
        pa /= es; pb /= es; const float sw = pa + pb;
        e0 = gi * 8 + a0; e1 = gi * 8 + a1; w0 = gw * (pa / sw); w1 = gw * (pb / sw);
        p0l = __hip_atomic_fetch_add(cntl + e0, 1, __ATOMIC_RELAXED, __HIP_MEMORY_SCOPE_WORKGROUP);
        p1l = __hip_atomic_fetch_add(cntl + e1, 1, __ATOMIC_RELAXED, __HIP_MEMORY_SCOPE_WORKGROUP);
    }
    __syncthreads();
    if (F.tid < 32) { const int c = cntl[F.tid]; basel[F.tid] = c ? (int)__hip_atomic_fetch_add(F.ctl + CW_CNT + F.tid, (unsigned)c, RLX_AGENT) : 0; }
    __syncthreads();
    if (F.lane < 16) {
        const int t = w * 128 + F.wave * 16 + F.lane;
        int* list = (int*)(ws + WS_LIST); int* toki = (int*)(ws + WS_TOKI); float* tokw = (float*)(ws + WS_TOKW);
        const int q0 = basel[e0] + p0l, q1 = basel[e1] + p1l;
        list[(size_t)e0 * T + q0] = t * 2; list[(size_t)e1 * T + q1] = t * 2 + 1;
        toki[t * 2] = (e0 << 20) | q0; toki[t * 2 + 1] = (e1 << 20) | q1; tokw[t * 2] = w0; tokw[t * 2 + 1] = w1;
    }
}
__device__ __forceinline__ void p10_final(Frame& F, const Args& args) {
    unsigned char* ws = args.ws;
    const LAS int* tbl = (const LAS int*)(F.lds + TBL_OFF);
    const int w = blockIdx.x, b = (w * 128) / S;
    const float* g2 = (const float*)(ws + WS_MOD) + (size_t)b * 6144 + 5120; const float* fg = args.in[22];
    const bf16* Yb = (const bf16*)(ws + WS_YB); const int* toki = (const int*)(ws + WS_TOKI);
    float* out = args.out;
    const int trow0 = w * 128 + F.wave * 16;
    size_t rall_a = 0, rall_b = 0;
    if (F.lane < 16) { const int i0 = toki[(trow0 + F.lane) * 2], i1 = toki[(trow0 + F.lane) * 2 + 1];
        rall_a = (size_t)(tbl[i0 >> 20] * 256 + (i0 & 0xfffff)); rall_b = (size_t)(tbl[i1 >> 20] * 256 + (i1 & 0xfffff)); }
    f32x4 xn[4]; uint2 yan[4], ybn[4];
#define P10_LOAD(i) do { const int t_ = trow0 + (i); const size_t ra_ = (size_t)__shfl((unsigned long long)rall_a, (i)), rb_ = (size_t)__shfl((unsigned long long)rall_b, (i)); \
        _Pragma("unroll") for (int j = 0; j < 4; ++j) { const int d0 = (F.lane + 64 * j) * 4; xn[j] = *(const f32x4*)(out + (size_t)t_ * 1024 + d0); yan[j] = *(const uint2*)(Yb + ra_ * 1024 + d0); ybn[j] = *(const uint2*)(Yb + rb_ * 1024 + d0); } } while (0)
    P10_LOAD(0);
    for (int i = 0; i < 16; ++i) {
        const int t = trow0 + i;
        f32x4 v[4]; float ss = 0.f;
#pragma unroll
        for (int j = 0; j < 4; ++j) { const int d0 = (F.lane + 64 * j) * 4; const f32x4 g = *(const f32x4*)(g2 + d0);
            v[j] = xn[j] + g * (pg8::bflo(yan[j].x, yan[j].y) + pg8::bflo(ybn[j].x, ybn[j].y));
            ss += (v[j].x * v[j].x + v[j].y * v[j].y) + (v[j].z * v[j].z + v[j].w * v[j].w); }
        if (i + 1 < 16) P10_LOAD(i + 1);
        const float rstd = rsqrtf(wave_sum(ss) * (1.f / 1024.f) + EPS);
#pragma unroll
        for (int j = 0; j < 4; ++j) { const int d0 = (F.lane + 64 * j) * 4; const f32x4 g = *(const f32x4*)(fg + d0); *(f32x4*)(out + (size_t)t * 1024 + d0) = v[j] * rstd * g; }
    }
#undef P10_LOAD
}

__global__ void __launch_bounds__(NWAVES * 64, 2) fwd(Args args) {
    extern __shared__ __attribute__((aligned(16))) unsigned char lds[];
    Frame F;
    F.lds = (LAS unsigned char*)lds;
    F.MISC = (volatile LAS unsigned*)(F.lds + MISC_OFF);
    F.tid = threadIdx.x; F.lane = F.tid & 63; F.wave = __builtin_amdgcn_readfirstlane(F.tid >> 6);
    F.G = gridDim.x; { const int bx = blockIdx.x; F.vcu = (F.G % 8 == 0) ? (bx % 8) * (F.G / 8) + bx / 8 : bx; }
    unsigned char* ws = args.ws;
    F.ctl = (gu32*)(ws + WS_CTL);
    for (int u = F.tid; u < (LDS_BYTES - LDSCTL_OFF) / 4; u += NWAVES * 64) ((LAS unsigned*)(F.lds + LDSCTL_OFF))[u] = 0u;
    __syncthreads();
    XcdBarrier bar = xcd_barrier_post((unsigned*)(F.ctl + CW_BAR) + args.li * XCD_BAR_WORDS, F.MISC + 8);
    const int lo = args.ph_lo, hi = args.ph_hi;
#define IN(k) (lo <= (k) && (k) < hi)
#define BOTH(k) (IN(k) && IN((k) + 1))
#define GRID_BAR() xcd_barrier(bar)

    if (IN(0)) { p0_prologue(F, args); if (BOTH(0)) GRID_BAR(); }
    if (IN(1)) { p1_xn(F, args); if (BOTH(1)) GRID_BAR(); }
    if (IN(2)) {
        __syncthreads();
        pg8::Gemm g{(const bf16*)(ws + WS_XN), (const bf16*)(ws + WS_WIN), 1024}; pg8::StaticOrder So; So.init(T, INW, F.G, (int)blockIdx.x);
        pg8::EpiInProj E{(bf16*)(ws + WS_QM), (bf16*)(ws + WS_GM), (float*)(ws + WS_KSUM), (const float*)(ws + WS_ROPE), T, S, C2};
        pg8::gemm_phase<pg8::EpiInProj, pg8::StaticOrder, true, true>(F.lds + RING_OFF, g, So, E);
        if (BOTH(2)) GRID_BAR();
    }
    if (IN(3)) {
        __syncthreads();
        const int bh = F.vcu >> 3, part = F.vcu & 7;
        LAS float* ksl = (LAS float*)(F.lds + RING_OFF);
        { const float* ks = (const float*)(ws + WS_KSUM);
          for (int i = F.tid; i < 32 * 64; i += NWAVES * 64) { const int j = i >> 6, d = i & 63; const size_t o = ((size_t)((bh >> 3) * 32 + j)) * 512 + (bh & 7) * 64 + d; ksl[i] = ks[o] + ks[128 * 512 + o]; } }
        __syncthreads();
#pragma unroll 1
        for (int hf = 0; hf < 2; ++hf) { const int cc = part * 8 + F.wave, chunk = hf ? 127 - cc : cc;
            gate_wave(bh >> 3, bh & 7, chunk, F.lane, (const bf16*)(ws + WS_QM), ksl, (unsigned*)(ws + WS_SEL), (unsigned*)(F.ctl + CW_QCNT), (unsigned short*)((char*)args.out + DO_QLIST)); }
        if (BOTH(3)) GRID_BAR();
    }
    if (IN(4)) {
        __syncthreads();
        const float lam = *(const float*)(ws + WS_LAM);
        float* o1scr = (float*)(ws + WS_XN) + (size_t)blockIdx.x * 65536;
        bf16* opart = (bf16*)args.out; float* mlp = (float*)((char*)args.out + DO_MLP); const unsigned short* qlist = (const unsigned short*)((char*)args.out + DO_QLIST);
        LAS int* pre = (LAS int*)(F.lds + ROWTAB_OFF); LAS int* tot = pre + 1040;
        if (F.tid < 32) { int run = 0; for (int j = 0; j < 32; ++j) { pre[F.tid * 32 + j] = run; run += ((int)__hip_atomic_load(F.ctl + CW_QCNT + F.tid * 32 + j, RLX_AGENT) + 511) >> 9; } tot[F.tid] = run; }
        __syncthreads();
        if (F.tid == 0) { int run = 0; for (int i = 0; i < 32; ++i) { const int c = tot[i]; tot[i] = run; run += c; } tot[32] = run; }
        __syncthreads();
        for (int e = F.tid; e < 1024; e += NWAVES * 64) pre[e] += tot[e >> 5];
        if (F.tid == 0) pre[1024] = tot[32];
        __syncthreads();
        const int nitems = pre[1024];
#pragma unroll 1
        for (int I = F.vcu; I < nitems; I += F.G) {
            int lo_ = 0, hi_ = 1024;
            while (hi_ - lo_ > 1) { const int mid = (lo_ + hi_) >> 1; if (pre[mid] <= I) lo_ = mid; else hi_ = mid; }
            const int e = lo_, bh = e >> 5, j = e & 31, c = I - pre[e];
            const int cnt = (int)__hip_atomic_load(F.ctl + CW_QCNT + e, RLX_AGENT); int nv = cnt - 512 * c; nv = nv > 512 ? 512 : nv;
            att::moba_block_issue((const bf16*)(ws + WS_KM), (const bf16*)(ws + WS_VM), bh >> 3, bh & 7, j, (char*)lds + RING_OFF);
            const unsigned short* ql = qlist + (size_t)bh * QL_PER_BH + 256 * (31 * j - (j * (j - 1)) / 2) + 512 * c;
            if (F.wave * 32 >= nv) asm volatile("s_waitcnt vmcnt(0)\n\ts_barrier" ::: "memory");
#pragma unroll 1
            for (int g = F.wave; g * 32 < nv; g += NWAVES)
                att::attn_unit<64, 2, true>(bh >> 3, bh & 7, j, (const bf16*)(ws + WS_QM), (const bf16*)(ws + WS_KM), (const bf16*)(ws + WS_VM), nullptr, (const unsigned*)(ws + WS_SEL), nullptr, 0.f, nullptr,
                                            (char*)lds + RING_OFF, ql + g * 32, nv - g * 32 < 32 ? nv - g * 32 : 32, opart, mlp, g == F.wave);
        }
        __syncthreads();
        { const int u = F.vcu, bh = u >> 4, s = u & 15;
#pragma unroll 1
          for (int kk = 0; kk < 2; ++kk) att::attn_unit<128, 1>(bh >> 2, bh & 3, (kk & 1) ? s : 31 - s, (const bf16*)(ws + WS_QD), (const bf16*)(ws + WS_KD), (const bf16*)(ws + WS_VD), (bf16*)(ws + WS_QD),
                                                                   nullptr, o1scr, lam, args.in[10], (char*)lds + RING_OFF); }
        GRID_BAR();
#pragma unroll 1
        for (int k = 0; k < 4; ++k) { const int u = F.vcu * 4 + k, bh = u >> 5, qb = u & 31;
            att::moba_block_issue((const bf16*)(ws + WS_KM), (const bf16*)(ws + WS_VM), bh >> 3, bh & 7, qb, (char*)lds + RING_OFF);
            att::attn_unit<64, 3, true>(bh >> 3, bh & 7, qb, (const bf16*)(ws + WS_QM), (const bf16*)(ws + WS_KM), (const bf16*)(ws + WS_VM), (bf16*)(ws + WS_QM), (const unsigned*)(ws + WS_SEL), nullptr, 0.f, nullptr,
                                        (char*)lds + RING_OFF, nullptr, 0, opart, mlp, true); }
        __syncthreads();
        if (BOTH(4)) GRID_BAR();
    }
    if (IN(5)) {
        __syncthreads();
        pg8::StaticOrder So; So.init(T, 1024, F.G, (int)blockIdx.x);
        { pg8::Gemm g{(const bf16*)(ws + WS_QM), (const bf16*)(ws + WS_WPM), 512}; pg8::EpiGate<0> E{(const bf16*)(ws + WS_GM), (bf16*)(ws + WS_MERGED)};
          pg8::gemm_phase<pg8::EpiGate<0>, pg8::StaticOrder, true, true>(F.lds + RING_OFF, g, So, E); }
        __syncthreads();
        { pg8::Gemm g{(const bf16*)(ws + WS_QD), (const bf16*)(ws + WS_WPD), 512}; pg8::EpiGate<1> E{(const bf16*)(ws + WS_GD), (bf16*)(ws + WS_MERGED)};
          pg8::gemm_phase<pg8::EpiGate<1>, pg8::StaticOrder, true, true>(F.lds + RING_OFF, g, So, E); }
        if (BOTH(5)) GRID_BAR();
    }
    if (IN(6)) {
        __syncthreads();
        pg8::StaticOrder So; So.init(T, 1024, F.G, (int)blockIdx.x);
        pg8::Gemm g{(const bf16*)(ws + WS_MERGED), (const bf16*)(ws + WS_WOUT), 1024};
        pg8::EpiResid E{args.in[0], (const float*)(ws + WS_MOD) + 2048, args.out, (float*)(ws + WS_ROWSQ), S};
        pg8::gemm_phase<pg8::EpiResid, pg8::StaticOrder, true, true>(F.lds + RING_OFF, g, So, E);
        if (BOTH(6)) GRID_BAR();
    }
    if (IN(7)) { __syncthreads(); p7_router(F, args); if (BOTH(7)) GRID_BAR(); }
    if (IN(8)) {
        __syncthreads(); moe_tables(F, args);
        const LAS int* tbl = (const LAS int*)(F.lds + TBL_OFF); LAS int* rowtab = (LAS int*)(F.lds + ROWTAB_OFF);
        pg8::MoeOrder Mo{tbl, rowtab, tbl[32], 4, F.G, (int)blockIdx.x, 1024, true};
        { pg8::Unit u; const int* list = (const int*)(ws + WS_LIST);
          for (int ui = 0; ui < 8 && Mo.next(ui, u); ++ui)
              for (int r = F.tid; r < 256; r += NWAVES * 64) { const int rr = r < u.cnt ? r : u.cnt - 1; rowtab[ui * 256 + r] = list[(size_t)u.e * T + u.lo + rr] >> 1; } }
        __syncthreads();
        pg8::Gemm g{(const bf16*)(ws + WS_XN), (const bf16*)(ws + WS_WGU), 1024};
        pg8::EpiMoeHid E{(bf16*)(ws + WS_HID)};
        pg8::gemm_phase<pg8::EpiMoeHid, pg8::MoeOrder, true, true>(F.lds + RING_OFF, g, Mo, E);
        if (BOTH(8)) GRID_BAR();
    }
    if (IN(9)) {
        __syncthreads(); moe_tables(F, args);
        const LAS int* tbl = (const LAS int*)(F.lds + TBL_OFF);
        pg8::MoeOrder Mo{tbl, nullptr, tbl[32], 4, F.G, (int)blockIdx.x, 1024, false};
        pg8::Gemm g{(const bf16*)(ws + WS_HID), (const bf16*)(ws + WS_WD), 512};
        pg8::EpiMoeDown E{(bf16*)(ws + WS_YB), (const int*)(ws + WS_LIST), (const float*)(ws + WS_TOKW), T};
        pg8::gemm_phase<pg8::EpiMoeDown, pg8::MoeOrder, true, true>(F.lds + RING_OFF, g, Mo, E);
        if (BOTH(9)) GRID_BAR();
    }
    if (IN(10)) { __syncthreads(); moe_tables(F, args); p10_final(F, args); }
#undef IN
#undef BOTH
}
}


extern "C" void kernel_launch(void* const* d_in, const int* in_sizes, int n_in, void* d_out, int out_size, void* d_ws, size_t ws_size, hipStream_t stream) {
    char* ws = (char*)d_ws; float* out = (float*)d_out;
    static int grid = 0;
    if (grid == 0) {
        int dev = 0, cus = 0, per_cu = 0;
        if (hipGetDevice(&dev) != hipSuccess || hipDeviceGetAttribute(&cus, hipDeviceAttributeMultiprocessorCount, dev) != hipSuccess) { fprintf(stderr, "kernel_launch: device query failed\n"); grid = -1; return; }
        if (hipFuncSetAttribute((const void*)fwd, hipFuncAttributeMaxDynamicSharedMemorySize, LDS_BYTES) != hipSuccess) { fprintf(stderr, "kernel_launch: hipFuncSetAttribute failed\n"); grid = -1; return; }
        if (hipOccupancyMaxActiveBlocksPerMultiprocessor(&per_cu, (const void*)fwd, NWAVES * 64, LDS_BYTES) != hipSuccess || per_cu < 1) fprintf(stderr, "kernel_launch: occupancy query reports %d\n", per_cu);
        (void)hipGetLastError();
        grid = cus < 256 ? cus : 256;
        if (ws_size < 512 * MiB || n_in != 23 || out_size != T * D) { fprintf(stderr, "kernel_launch: built for 23 inputs, %d outputs and >= 512 MiB of workspace\n", T * D); grid = -1; return; }
    }
    if (grid < 0) return;
    (void)hipMemsetAsync(ws + WS_CTL, 0, 64 * 1024, stream);
    Args a{};
    for (int i = 0; i < 23; ++i) a.in[i] = (const float*)d_in[i];
    a.out = out; a.ws = (unsigned char*)d_ws;
    a.ph_lo = 0; a.ph_hi = 11; a.li = 0; a.pad = 0;
    hipLaunchKernelGGL(fwd, dim3(grid), dim3(NWAVES * 64), LDS_BYTES, stream, a);
}
```

```cpp
#include <hip/hip_runtime.h>
#include <cstdint>
#include <cstdio>

namespace {

constexpr int NB = 4, S = 8192, D = 1024, T = NB * S;
constexpr int INW = 5120;
constexpr float EPS = 1e-6f;
constexpr float C2 = 0.125f * 1.4426950408889634f;
constexpr size_t MiB = 1ull << 20;
constexpr size_t WS_CTL = 0;
constexpr size_t WS_MOD = 1 * MiB;
constexpr size_t WS_LAM = 1 * MiB + 128 * 1024;
constexpr size_t WS_OFF = 1 * MiB + 132 * 1024;
constexpr size_t WS_KSUM = 1 * MiB + 256 * 1024;
constexpr size_t WS_MODP = 2 * MiB;
constexpr size_t WS_WR = 3 * MiB;
constexpr size_t WS_ROPE = 4 * MiB;
constexpr size_t WS_WIN = 6 * MiB;
constexpr size_t WS_WPM = 16 * MiB, WS_WPD = 17 * MiB, WS_WOUT = 18 * MiB;
constexpr size_t WS_WGU = 20 * MiB;
constexpr size_t WS_WD = 84 * MiB;
constexpr size_t WS_XN = 116 * MiB;
constexpr size_t WS_QM = 180 * MiB, WS_KM = 212 * MiB, WS_VM = 244 * MiB, WS_QD = 276 * MiB, WS_KD = 308 * MiB, WS_VD = 340 * MiB;
constexpr size_t WS_GM = 372 * MiB, WS_GD = 436 * MiB;
constexpr size_t WS_LIST = 500 * MiB;
constexpr size_t WS_TOKI = 504 * MiB;
constexpr size_t WS_TOKW = 504 * MiB + 256 * 1024;
constexpr size_t WS_SEL = 505 * MiB;
constexpr size_t WS_ROWSQ = 506 * MiB;
constexpr size_t WS_MERGED = 212 * MiB;
constexpr size_t WS_HID = 372 * MiB;
constexpr size_t WS_YB = 180 * MiB;
constexpr int CW_QCNT = 8192;
constexpr size_t DO_MLP = 96 * MiB, DO_QLIST = 104 * MiB;
constexpr int QL_PER_BH = 126976;
constexpr int CW_ITEM = 2048;
constexpr int CW_CNT = 1024;


#define GAS __attribute__((address_space(1)))
#define LAS __attribute__((address_space(3)))
typedef unsigned short bf16;
typedef unsigned v4u __attribute__((ext_vector_type(4)));
typedef float f32x4 __attribute__((ext_vector_type(4)));
typedef short bf16x8 __attribute__((ext_vector_type(8)));
typedef GAS unsigned gu32;
typedef GAS unsigned long long gu64;
#define RLX_AGENT __ATOMIC_RELAXED, __HIP_MEMORY_SCOPE_AGENT
#define LDS_WAIT() asm volatile("s_waitcnt lgkmcnt(0)" ::: "memory")
#define VM_WAIT() asm volatile("s_waitcnt vmcnt(0)" ::: "memory")
__device__ __forceinline__ unsigned f2bf(float f) { unsigned u = __builtin_bit_cast(unsigned, f); return (u + 0x7fffu + ((u >> 16) & 1u)) >> 16; }
__device__ __forceinline__ unsigned pk2(float lo, float hi) { return f2bf(lo) | (f2bf(hi) << 16); }
__device__ __forceinline__ float bf2f(bf16 v) { return __uint_as_float((unsigned)v << 16); }
#define XB_TMO      128
#define XB_XCNT(j)  (256  + 64 * (j))
#define XB_XSUB(j)  (1280 + 64 * (j))
#define XB_XGEN(j)  (2304 + 64 * (j))
#define XB_TOP      3328
#define XB_TOPGEN   3392
#define XCD_BAR_WORDS 3456
#define XB_SPIN_CAP (1u << 18)

__device__ __forceinline__ unsigned xb_ld(unsigned* p)              { return __hip_atomic_load(p, __ATOMIC_RELAXED, __HIP_MEMORY_SCOPE_AGENT); }
__device__ __forceinline__ unsigned xb_add(unsigned* p, unsigned v) { return __hip_atomic_fetch_add(p, v, __ATOMIC_RELAXED, __HIP_MEMORY_SCOPE_AGENT); }
__device__ __forceinline__ unsigned xb_xcc_id() { return (unsigned)__builtin_amdgcn_s_getreg((3 << 11) | 20) & 0xFu; }
#define XB_SPIN(cond, bar) do { unsigned _sp = 0; while (cond) { __builtin_amdgcn_s_sleep(1); \
    if ((++_sp & 255u) == 0u) { if (xb_ld(&(bar)[XB_TMO])) break; if (_sp > XB_SPIN_CAP) { atomicAdd(&(bar)[XB_TMO], 1u); break; } } } } while (0)

struct XcdBarrier {
    unsigned* bar; unsigned x;
    volatile LAS unsigned* st;
};

__device__ __forceinline__ XcdBarrier xcd_barrier_post(unsigned* bar, volatile LAS unsigned* st) {
    XcdBarrier b; b.bar = bar; b.x = xb_xcc_id(); b.st = st;
    if (threadIdx.x == 0) (void)xb_add(&bar[XB_XCNT(b.x)], 1u);
    return b;
}
__device__ __forceinline__ void xcd_barrier_complete(unsigned* bar, unsigned x, unsigned& nloc, unsigned& nx) {
    const unsigned G = gridDim.x * gridDim.y * gridDim.z;
    unsigned sum, cnt, mine, sp = 0u;
    for (;;) {
        sum = 0u; cnt = 0u; mine = 0u;
#pragma unroll
        for (unsigned j = 0; j < 16; ++j) { const unsigned c = xb_ld(&bar[XB_XCNT(j)]); sum += c; cnt += (c > 0u) ? 1u : 0u; mine = (j == x) ? c : mine; }
        if (sum == G) break;
        __builtin_amdgcn_s_sleep(1);
        if ((++sp & 255u) == 0u) { if (xb_ld(&bar[XB_TMO])) break; if (sp > XB_SPIN_CAP) { atomicAdd(&bar[XB_TMO], 1u); break; } }
    }
    nloc = mine > 0u ? mine : 1u; nx = cnt > 0u ? cnt : 1u;
}

__device__ __forceinline__ void xcd_barrier(const XcdBarrier& b) {
    asm volatile("s_waitcnt vmcnt(0)" ::: "memory");
    __syncthreads();
    if (threadIdx.x == 0) {
        unsigned* bar = b.bar;
        __builtin_amdgcn_s_waitcnt(0);
        unsigned nloc = b.st[0], nx = b.st[1];
        if (nloc == 0u) { xcd_barrier_complete(bar, b.x, nloc, nx); b.st[0] = nloc; b.st[1] = nx; }
        const unsigned old = xb_add(&bar[XB_XSUB(b.x)], 1u);
        const unsigned gen = old / nloc;
        if (old + 1u == (gen + 1u) * nloc) {
            __builtin_amdgcn_fence(__ATOMIC_RELEASE, "agent");
            asm volatile("s_waitcnt vmcnt(0)" ::: "memory");
            const unsigned og = xb_add(&bar[XB_TOP], 1u);
            const unsigned tg = og / nx;
            if (og + 1u == (tg + 1u) * nx) xb_add(&bar[XB_TOPGEN], 1u);
            else XB_SPIN(xb_ld(&bar[XB_TOPGEN]) == tg, bar);
            __builtin_amdgcn_fence(__ATOMIC_ACQUIRE, "agent");
            xb_add(&bar[XB_XGEN(b.x)], 1u);
            asm volatile("s_waitcnt vmcnt(0)" ::: "memory");
        } else {
            XB_SPIN(xb_ld(&bar[XB_XGEN(b.x)]) == gen, bar);
            __builtin_amdgcn_fence(__ATOMIC_ACQUIRE, "agent");
            asm volatile("s_waitcnt vmcnt(0)" ::: "memory");
        }
    }
    __syncthreads();
}


namespace pg8 {
#define PG8_LAS __attribute__((address_space(3)))
typedef unsigned short bf16_t;
typedef short bf16x8 __attribute__((ext_vector_type(8)));
typedef float f32x4 __attribute__((ext_vector_type(4)));
typedef unsigned u32x4 __attribute__((ext_vector_type(4)));
constexpr int BM = 256, BK = 64, HALF = 128, HTB = HALF * BK * 2  , STAGE_BYTES = 8 * HTB, NXCD = 8, WGM = 8;

__host__ __device__ __forceinline__ int lds_byte(int r, int c) { const int st = (r >> 4) * 2 + (c >> 5), rr = r & 15, cc = c & 31, ob = rr * 64 + cc * 2; return st * 1024 + (ob ^ (((ob >> 9) & 1) << 5)); }
__host__ __device__ __forceinline__ void stage_rc(int b, int& R, int& C) { const int st = b / 1024, sb = b % 1024, swz = sb ^ (((sb >> 9) & 1) << 5); R = (st >> 1) * 16 + swz / 64; C = (st & 1) * 32 + (swz % 64) / 2; }
__host__ __device__ __forceinline__ int perm32(int rho) { const int n = rho >> 4, i = rho & 15; return 8 * (i >> 2) + 4 * n + (i & 3); }

struct Unit { int pm, pn, e, lo, cnt; };
struct Gemm { const bf16_t* A; const bf16_t* Bt; int K; };

struct StaticOrder {
    int nM, nN, nwg, G, c;
    __host__ __device__ void init(int M, int N, int G_, int c_) { nM = M / BM; nN = N / BM; nwg = nM * nN; G = G_; c = c_; }
    __host__ __device__ bool next(int i, Unit& u) const {
        const long L = (long)i * G + c; if (L >= nwg) return false;
        int wgid = (int)L; { const int q = nwg / NXCD, r = nwg % NXCD, xcd = wgid % NXCD, off = wgid / NXCD; wgid = (xcd < r ? xcd * (q + 1) : r * (q + 1) + (xcd - r) * q) + off; }
        const int nig = WGM * nN, gid = wgid / nig, fm = gid * WGM, gsz = (nM - fm) < WGM ? (nM - fm) : WGM;
        u.pm = fm + ((wgid % nig) % gsz); u.pn = (wgid % nig) / gsz; u.e = 0; u.lo = 0; u.cnt = BM; return true;
    }
    __device__ __forceinline__ int arow(int, const Unit& u, int r) const { return u.pm * BM + r; }
    __device__ __forceinline__ int brow(const Unit& u) const { return u.pn * BM; }
    __device__ __forceinline__ void a_ready(const Unit&) const {}
    __device__ __forceinline__ void done(const Unit&) const {}
};
typedef float f32x2_t __attribute__((ext_vector_type(2))); typedef __bf16 bf16x2_t __attribute__((ext_vector_type(2)));
__device__ __forceinline__ unsigned cvt_pk_bf16(float lo, float hi) { f32x2_t v = {lo, hi}; bf16x2_t b = __builtin_convertvector(v, bf16x2_t); return __builtin_bit_cast(unsigned, b); }
struct MoeOrder {
    const PG8_LAS int* tbl; const PG8_LAS int* rowtab; int ntile, nN, G, c, Nexp; bool gather;
    __device__ __forceinline__ bool next(int i, Unit& u) const {
        const int L = i * G + c; if (L >= ntile * nN) return false;
        const int mt = L / nN; int e = 0;
        while (tbl[e + 1] <= mt) ++e;
        u.pm = mt; u.pn = L - mt * nN; u.e = e; u.lo = (mt - tbl[e]) * BM; u.cnt = tbl[40 + e] - u.lo; return true;
    }
    __device__ __forceinline__ int arow(int ui, const Unit& u, int r) const { return gather ? rowtab[ui * BM + r] : u.pm * BM + r; }
    __device__ __forceinline__ int brow(const Unit& u) const { return u.e * Nexp + u.pn * BM; }
    __device__ __forceinline__ void a_ready(const Unit&) const {}
    __device__ __forceinline__ void done(const Unit&) const {}
};
__device__ __forceinline__ float fast_sigmoid(float v) { return __builtin_amdgcn_rcpf(1.f + __builtin_amdgcn_exp2f(-1.4426950408889634f * v)); }
__device__ __forceinline__ u32x4 pack8(const f32x4& a, const f32x4& b) { u32x4 w; w.x = cvt_pk_bf16(a[0], a[1]); w.y = cvt_pk_bf16(a[2], a[3]); w.z = cvt_pk_bf16(b[0], b[1]); w.w = cvt_pk_bf16(b[2], b[3]); return w; }
__device__ __forceinline__ f32x4 bflo(unsigned a, unsigned b) { return (f32x4){__uint_as_float(a << 16), __uint_as_float(a & 0xffff0000u), __uint_as_float(b << 16), __uint_as_float(b & 0xffff0000u)}; }

struct EpiInProj {
    static constexpr bool PERM = true, AFTER_DRAIN = false;
    bf16_t* qkv;
    bf16_t* gates;
    float* ksum;
    const float* tab;
    int Trows, Srows; float c2;
    __device__ __forceinline__ void operator()(const f32x4 (&acc)[2][2][4][2], const Unit& u, int wr, int wc, int fr, int fq) const {
        const int pn = u.pn; const int rw = u.pm * BM + wr * 64 + fr;
        if (pn >= 12) {
            bf16_t* base = gates + (size_t)((pn - 12) >> 2) * ((size_t)Trows * 1024) + ((pn - 12) & 3) * 256 + wc * 32 + 8 * fq;
#pragma unroll
            for (int ai = 0; ai < 2; ++ai)
#pragma unroll
                for (int m = 0; m < 4; ++m) { bf16_t* rowp = base + (size_t)(rw + ai * HALF + m * 16) * 1024;
#pragma unroll
                    for (int bj = 0; bj < 2; ++bj) { f32x4 v0 = acc[ai][bj][m][0], v1 = acc[ai][bj][m][1];
#pragma unroll
                        for (int j = 0; j < 4; ++j) { v0[j] = fast_sigmoid(v0[j]); v1[j] = fast_sigmoid(v1[j]); }
                        *(u32x4*)(rowp + bj * HALF) = pack8(v0, v1); } }
            return;
        }
        const int seg = pn >> 1, ts = pn & 1;
        bf16_t* base = qkv + (size_t)seg * ((size_t)Trows * 512);
        if (seg == 2 || seg == 5) {
            bf16_t* b2 = base + ts * 256 + wc * 32 + 8 * fq;
#pragma unroll
            for (int ai = 0; ai < 2; ++ai)
#pragma unroll
                for (int m = 0; m < 4; ++m) { bf16_t* rowp = b2 + (size_t)(rw + ai * HALF + m * 16) * 512;
#pragma unroll
                    for (int bj = 0; bj < 2; ++bj) *(u32x4*)(rowp + bj * HALF) = pack8(acc[ai][bj][m][0], acc[ai][bj][m][1]); }
            return;
        }
        const float sc = (seg == 0 || seg == 3) ? c2 : 1.f;
        const int colh = (ts * 4 + wc) * 64 + 8 * fq;
        f32x4 ks[2][2];
#pragma unroll
        for (int a = 0; a < 2; ++a)
#pragma unroll
            for (int n = 0; n < 2; ++n) ks[a][n] = (f32x4){0.f, 0.f, 0.f, 0.f};
#pragma unroll
        for (int ai = 0; ai < 2; ++ai)
#pragma unroll
            for (int m = 0; m < 4; ++m) {
                const int r = rw + ai * HALF + m * 16, pos = r & (Srows - 1);
                const f32x4* tp = (const f32x4*)(tab + (size_t)pos * 64 + 16 * fq);
                const f32x4 t0 = tp[0], t1 = tp[1], t2 = tp[2], t3 = tp[3];
                f32x4 olo[2], ohi[2];
#pragma unroll
                for (int n = 0; n < 2; ++n) {
                    const f32x4 ta = n ? t2 : t0, tb = n ? t3 : t1;
                    const f32x4 cs = (f32x4){ta[0], ta[2], tb[0], tb[2]}, sn = (f32x4){ta[1], ta[3], tb[1], tb[3]};
                    const f32x4 lo = acc[ai][0][m][n], hi = acc[ai][1][m][n];
                    olo[n] = lo * cs - hi * sn; ohi[n] = hi * cs + lo * sn;
                }
                if (seg == 1) { ks[0][0] += olo[0]; ks[0][1] += olo[1]; ks[1][0] += ohi[0]; ks[1][1] += ohi[1]; }
                bf16_t* rowp = base + (size_t)r * 512 + colh;
                *(u32x4*)(rowp) = pack8(olo[0] * sc, olo[1] * sc); *(u32x4*)(rowp + 32) = pack8(ohi[0] * sc, ohi[1] * sc);
            }
        if (seg == 1) {
#pragma unroll
            for (int a = 0; a < 2; ++a)
#pragma unroll
                for (int n = 0; n < 2; ++n)
#pragma unroll
                    for (int j = 0; j < 4; ++j) { float v = ks[a][n][j]; v += __shfl_xor(v, 1); v += __shfl_xor(v, 2); v += __shfl_xor(v, 4); v += __shfl_xor(v, 8); ks[a][n][j] = v; }
            if (fr == 0) { float* kp = ksum + ((size_t)(wr * 128 + u.pm)) * 512 + colh; *(f32x4*)(kp) = ks[0][0]; *(f32x4*)(kp + 4) = ks[0][1]; *(f32x4*)(kp + 32) = ks[1][0]; *(f32x4*)(kp + 36) = ks[1][1]; }
        }
    }
};
template <int PASS> struct EpiGate {
    static constexpr bool PERM = true, AFTER_DRAIN = false;
    const bf16_t* G; bf16_t* out;
    __device__ __forceinline__ void operator()(const f32x4 (&acc)[2][2][4][2], const Unit& u, int wr, int wc, int fr, int fq) const {
        const int rw = u.pm * BM + wr * 64 + fr, col0 = u.pn * BM + wc * 32 + 8 * fq;
#pragma unroll
        for (int ai = 0; ai < 2; ++ai) {
            u32x4 g[4][2], p[4][2];
#pragma unroll
            for (int m = 0; m < 4; ++m)
#pragma unroll
                for (int bj = 0; bj < 2; ++bj) { const size_t off = (size_t)(rw + ai * HALF + m * 16) * 1024 + col0 + bj * HALF;
                    g[m][bj] = *(const u32x4*)(G + off); if (PASS == 1) p[m][bj] = __builtin_nontemporal_load((const u32x4*)(out + off)); }
#pragma unroll
            for (int m = 0; m < 4; ++m)
#pragma unroll
                for (int bj = 0; bj < 2; ++bj) { const size_t off = (size_t)(rw + ai * HALF + m * 16) * 1024 + col0 + bj * HALF;
                    f32x4 v0 = acc[ai][bj][m][0] * bflo(g[m][bj].x, g[m][bj].y), v1 = acc[ai][bj][m][1] * bflo(g[m][bj].z, g[m][bj].w);
                    if (PASS == 1) { v0 += bflo(p[m][bj].x, p[m][bj].y); v1 += bflo(p[m][bj].z, p[m][bj].w); }
                    *(u32x4*)(out + off) = pack8(v0, v1); }
        }
    }
};
struct EpiResid {
    static constexpr bool PERM = true, AFTER_DRAIN = false;
    const float* x; const float* g1; float* x1; float* rowsq; int Srows;
    __device__ __forceinline__ void operator()(const f32x4 (&acc)[2][2][4][2], const Unit& u, int wr, int wc, int fr, int fq) const {
        const int rw = u.pm * BM + wr * 64 + fr, col0 = u.pn * BM + wc * 32 + 8 * fq, b = (u.pm * BM) / Srows;
        f32x4 gv[2][2];
#pragma unroll
        for (int bj = 0; bj < 2; ++bj)
#pragma unroll
            for (int n = 0; n < 2; ++n) gv[bj][n] = *(const f32x4*)(g1 + (size_t)b * 6144 + col0 + bj * HALF + n * 4);
#pragma unroll
        for (int ai = 0; ai < 2; ++ai) {
            f32x4 xv[4][2][2];
#pragma unroll
            for (int m = 0; m < 4; ++m) { const size_t off = (size_t)(rw + ai * HALF + m * 16) * 1024 + col0;
#pragma unroll
                for (int bj = 0; bj < 2; ++bj)
#pragma unroll
                    for (int n = 0; n < 2; ++n) xv[m][bj][n] = *(const f32x4*)(x + off + bj * HALF + n * 4); }
#pragma unroll
            for (int m = 0; m < 4; ++m) { const int r = rw + ai * HALF + m * 16; const size_t off = (size_t)r * 1024 + col0; float s = 0.f;
#pragma unroll
                for (int bj = 0; bj < 2; ++bj)
#pragma unroll
                    for (int n = 0; n < 2; ++n) { const f32x4 o = xv[m][bj][n] + gv[bj][n] * acc[ai][bj][m][n];
                        *(f32x4*)(x1 + off + bj * HALF + n * 4) = o; s += (o[0] * o[0] + o[1] * o[1]) + (o[2] * o[2] + o[3] * o[3]); }
                s += __shfl_xor(s, 16); s += __shfl_xor(s, 32);
                if (fq == 0) rowsq[(size_t)r * 16 + u.pn * 4 + wc] = s; }
        }
    }
};
struct EpiMoeHid {
    static constexpr bool PERM = true, AFTER_DRAIN = false;
    bf16_t* hid;
    __device__ __forceinline__ void operator()(const f32x4 (&acc)[2][2][4][2], const Unit& u, int wr, int wc, int fr, int fq) const {
        const int rw = u.pm * BM + wr * 64 + fr, col0 = u.pn * 128 + wc * 32 + 8 * fq;
#pragma unroll
        for (int ai = 0; ai < 2; ++ai)
#pragma unroll
            for (int m = 0; m < 4; ++m) { f32x4 h[2];
#pragma unroll
                for (int n = 0; n < 2; ++n) { const f32x4 g = acc[ai][0][m][n], up = acc[ai][1][m][n];
#pragma unroll
                    for (int j = 0; j < 4; ++j) h[n][j] = g[j] * fast_sigmoid(g[j]) * up[j]; }
                *(u32x4*)(hid + (size_t)(rw + ai * HALF + m * 16) * 512 + col0) = pack8(h[0], h[1]); }
    }
};
struct EpiMoeDown {
    static constexpr bool PERM = true, AFTER_DRAIN = false;
    bf16_t* Yb; const int* list; const float* tokw; int Trows;
    __device__ __forceinline__ void operator()(const f32x4 (&acc)[2][2][4][2], const Unit& u, int wr, int wc, int fr, int fq) const {
        const int rl = wr * 64 + fr, col0 = u.pn * BM + wc * 32 + 8 * fq;
        int le[2][4]; float w[2][4];
#pragma unroll
        for (int ai = 0; ai < 2; ++ai)
#pragma unroll
            for (int m = 0; m < 4; ++m) { const int rr = rl + ai * HALF + m * 16; le[ai][m] = list[(size_t)u.e * Trows + u.lo + (rr < u.cnt ? rr : 0)]; }
#pragma unroll
        for (int ai = 0; ai < 2; ++ai)
#pragma unroll
            for (int m = 0; m < 4; ++m) { const int rr = rl + ai * HALF + m * 16; const float tw = tokw[le[ai][m]]; w[ai][m] = rr < u.cnt ? tw : 0.f; }
#pragma unroll
        for (int ai = 0; ai < 2; ++ai)
#pragma unroll
            for (int m = 0; m < 4; ++m) { const int rr = rl + ai * HALF + m * 16;
                bf16_t* rowp = Yb + (size_t)(u.pm * BM + rr) * 1024 + col0;
#pragma unroll
                for (int bj = 0; bj < 2; ++bj) *(u32x4*)(rowp + bj * HALF) = pack8(acc[ai][bj][m][0] * w[ai][m], acc[ai][bj][m][1] * w[ai][m]); }
    }
};

template <class Epi, class Sched, bool ALIGN_EPI = false, bool SP2 = false>
__device__ __forceinline__ void gemm_phase(PG8_LAS unsigned char* lds, const Gemm g, const Sched& S, const Epi& E) {
    const int tid = threadIdx.x, wid = __builtin_amdgcn_readfirstlane(tid >> 6), lane = tid & 63, wr = wid >> 2, wc = wid & 3, fr = lane & 15, fq = lane >> 4;
    const int K = g.K, nt = K / BK;
    unsigned voffB[2], CA2[2]; int RA[2];
#pragma unroll
    for (int i = 0; i < 2; ++i) { int R, C; stage_rc(tid * 16 + i * 8192, R, C); const int Rb = Epi::PERM ? ((R & ~31) + perm32(R & 31)) : R;
        RA[i] = R; CA2[i] = (unsigned)C * 2u; voffB[i] = (unsigned)(Rb * K + C) * 2u; }
    const unsigned K2 = (unsigned)K * 2u;
    const size_t kstep = (size_t)(BK * 2);
    const size_t hstep = (size_t)HALF * K * 2;
    const unsigned ldsw = (unsigned)wid * 1024u;
    const int aoff = lds_byte(wr * 64 + fr, fq * 8), boff = lds_byte(wc * 32 + fr, fq * 8);
#define PG8_SA(b, h) (((b) * 2 + (h)) * HTB)
#define PG8_SB(b, h) ((4 + (b) * 2 + (h)) * HTB)
#define PG8_STAGE(bufoff, gbase, voff) do { _Pragma("unroll") for (int _i = 0; _i < 2; ++_i) \
        __builtin_amdgcn_global_load_lds((const unsigned*)((const char*)(gbase) + (voff)[_i]), (PG8_LAS unsigned*)(lds + (bufoff) + ldsw + _i * 8192), 16, 0, 0); } while (0)
#define PG8_LDA(dst, b, h) do { _Pragma("unroll") for (int m = 0; m < 4; ++m) _Pragma("unroll") for (int k = 0; k < 2; ++k) dst[m][k] = *(const PG8_LAS bf16x8*)(lds + PG8_SA(b, h) + aoff + m * 2048 + k * 1024); } while (0)
#define PG8_LDB(dst, b, h) do { _Pragma("unroll") for (int n = 0; n < 2; ++n) _Pragma("unroll") for (int k = 0; k < 2; ++k) dst[n][k] = *(const PG8_LAS bf16x8*)(lds + PG8_SB(b, h) + boff + n * 2048 + k * 1024); } while (0)
#define PG8_MMA(ai, bj, At, Bt) do { __builtin_amdgcn_s_setprio(1); _Pragma("unroll") for (int m = 0; m < 4; ++m) _Pragma("unroll") for (int n = 0; n < 2; ++n) _Pragma("unroll") for (int k = 0; k < 2; ++k) \
        acc[ai][bj][m][n] = __builtin_amdgcn_mfma_f32_16x16x32_bf16(Bt[n][k], At[m][k], acc[ai][bj][m][n], 0, 0, 0); __builtin_amdgcn_s_setprio(0); } while (0)
#define PG8_WAIT_V(n) asm volatile("s_waitcnt vmcnt(" #n ")" ::: "memory")
#define PG8_WAIT_L(n) asm volatile("s_waitcnt lgkmcnt(" #n ")" ::: "memory")
#define PG8_BAR __builtin_amdgcn_s_barrier()
#define PG8_SCHED __builtin_amdgcn_sched_barrier(0)
    Unit cur, nxt; int ui = 0;
    if (!S.next(0, cur)) return;
    f32x4 acc[2][2][4][2];
#pragma unroll
    for (int a = 0; a < 2; ++a)
#pragma unroll
        for (int b = 0; b < 2; ++b)
#pragma unroll
            for (int m = 0; m < 4; ++m)
#pragma unroll
                for (int n = 0; n < 2; ++n) acc[a][b][m][n] = (f32x4){0.f, 0.f, 0.f, 0.f};
    bf16x8 At[4][2], B0[2][2], B1[2][2];
    unsigned vA0[2], vA1[2], nA0[2], nA1[2];
#pragma unroll
    for (int i = 0; i < 2; ++i) { vA0[i] = (unsigned)S.arow(0, cur, RA[i]) * K2 + CA2[i]; vA1[i] = (unsigned)S.arow(0, cur, HALF + RA[i]) * K2 + CA2[i]; }
    const char* const gA = (const char*)g.A; const char* cB = (const char*)g.Bt + (size_t)S.brow(cur) * K2;
    S.a_ready(cur);
    if constexpr (SP2) {
        PG8_STAGE(PG8_SB(0, 0), cB, voffB); PG8_STAGE(PG8_SB(0, 1), cB + hstep, voffB); PG8_STAGE(PG8_SA(0, 0), gA, vA0); PG8_STAGE(PG8_SA(0, 1), gA, vA1);
        if (wr == 1) PG8_BAR;
        PG8_WAIT_V(2); PG8_BAR;
        PG8_STAGE(PG8_SB(1, 0), cB + kstep, voffB); PG8_STAGE(PG8_SA(1, 0), gA + kstep, vA0); PG8_STAGE(PG8_SB(1, 1), cB + hstep + kstep, voffB);
        PG8_WAIT_V(6); PG8_BAR;
    } else {
        PG8_STAGE(PG8_SB(0, 0), cB, voffB); PG8_STAGE(PG8_SA(0, 0), gA, vA0); PG8_STAGE(PG8_SB(0, 1), cB + hstep, voffB); PG8_STAGE(PG8_SA(0, 1), gA, vA1);
        if (wr == 1) PG8_BAR;
        PG8_WAIT_V(4); PG8_BAR;
        PG8_STAGE(PG8_SB(1, 0), cB + kstep, voffB); PG8_STAGE(PG8_SA(1, 0), gA + kstep, vA0); PG8_STAGE(PG8_SB(1, 1), cB + hstep + kstep, voffB);
        PG8_WAIT_V(6); PG8_BAR;
    }
    for (;;) {
        const bool has_next = S.next(ui + 1, nxt);
#pragma unroll
        for (int i = 0; i < 2; ++i) { nA0[i] = has_next ? (unsigned)S.arow(ui + 1, nxt, RA[i]) * K2 + CA2[i] : vA0[i]; nA1[i] = has_next ? (unsigned)S.arow(ui + 1, nxt, HALF + RA[i]) * K2 + CA2[i] : vA1[i]; }
        const char* nB = has_next ? (const char*)g.Bt + (size_t)S.brow(nxt) * K2 : cB;
        for (int t = 0; t < nt; t += 2) {
            const bool last = (t == nt - 2);
            const char* a1 = gA + (size_t)(t + 1) * kstep;
            const char* a2 = last ? gA : gA + (size_t)(t + 2) * kstep; const unsigned x0[2] = {last ? nA0[0] : vA0[0], last ? nA0[1] : vA0[1]}, x1[2] = {last ? nA1[0] : vA1[0], last ? nA1[1] : vA1[1]}; const char* b2 = last ? nB : cB + (size_t)(t + 2) * kstep;
            const char* a3 = a2 + kstep; const char* b3 = b2 + kstep;
            if (last && has_next) S.a_ready(nxt);
            if constexpr (SP2) {
            PG8_LDB(B0, 0, 0); PG8_LDB(B1, 0, 1); PG8_SCHED; PG8_LDA(At, 0, 0); PG8_STAGE(PG8_SA(1, 1), a1, vA1);
            PG8_WAIT_V(8); PG8_WAIT_L(0); PG8_BAR; PG8_MMA(0, 0, At, B0); PG8_MMA(0, 1, At, B1); PG8_BAR; PG8_SCHED;
            PG8_LDA(At, 0, 1); PG8_STAGE(PG8_SB(0, 0), b2, voffB); PG8_STAGE(PG8_SB(0, 1), b2 + hstep, voffB); PG8_STAGE(PG8_SA(0, 0), a2, x0);
            PG8_WAIT_V(8); PG8_WAIT_L(0); PG8_BAR; PG8_MMA(1, 0, At, B0); PG8_MMA(1, 1, At, B1); PG8_BAR; PG8_SCHED;
            PG8_LDB(B0, 1, 0); PG8_LDB(B1, 1, 1); PG8_SCHED; PG8_LDA(At, 1, 0); PG8_STAGE(PG8_SA(0, 1), a2, x1);
            PG8_WAIT_V(8); PG8_WAIT_L(0); PG8_BAR; PG8_MMA(0, 0, At, B0); PG8_MMA(0, 1, At, B1); PG8_BAR; PG8_SCHED;
            PG8_LDA(At, 1, 1); PG8_STAGE(PG8_SB(1, 0), b3, voffB); PG8_STAGE(PG8_SB(1, 1), b3 + hstep, voffB); PG8_STAGE(PG8_SA(1, 0), a3, x0);
            PG8_WAIT_V(8); PG8_WAIT_L(0); PG8_BAR; PG8_MMA(1, 0, At, B0); PG8_MMA(1, 1, At, B1); PG8_BAR; PG8_SCHED;
            } else {
            PG8_LDB(B0, 0, 0); PG8_SCHED; PG8_LDA(At, 0, 0); PG8_STAGE(PG8_SA(1, 1), a1, vA1);
            PG8_WAIT_L(8); PG8_BAR; PG8_WAIT_L(0); PG8_MMA(0, 0, At, B0); PG8_BAR; PG8_SCHED;
            PG8_LDB(B1, 0, 1); PG8_STAGE(PG8_SB(0, 0), b2, voffB);
            PG8_BAR; PG8_WAIT_L(0); PG8_MMA(0, 1, At, B1); PG8_BAR;
            PG8_LDA(At, 0, 1); PG8_STAGE(PG8_SA(0, 0), a2, x0);
            PG8_BAR; PG8_WAIT_L(0); PG8_MMA(1, 0, At, B0); PG8_BAR; PG8_SCHED;
            PG8_STAGE(PG8_SB(0, 1), b2 + hstep, voffB);
            PG8_WAIT_V(6); PG8_BAR; PG8_MMA(1, 1, At, B1); PG8_BAR;
            PG8_LDB(B0, 1, 0); PG8_SCHED; PG8_LDA(At, 1, 0); PG8_STAGE(PG8_SA(0, 1), a2, x1);
            PG8_WAIT_L(8); PG8_BAR; PG8_WAIT_L(0); PG8_MMA(0, 0, At, B0); PG8_BAR; PG8_SCHED;
            PG8_LDB(B1, 1, 1); PG8_STAGE(PG8_SB(1, 0), b3, voffB);
            PG8_BAR; PG8_WAIT_L(0); PG8_MMA(0, 1, At, B1); PG8_BAR;
            PG8_LDA(At, 1, 1); PG8_STAGE(PG8_SA(1, 0), a3, x0);
            PG8_BAR; PG8_WAIT_L(0); PG8_MMA(1, 0, At, B0); PG8_BAR; PG8_SCHED;
            PG8_STAGE(PG8_SB(1, 1), b3 + hstep, voffB);
            PG8_WAIT_V(6); PG8_BAR; PG8_MMA(1, 1, At, B1); PG8_BAR;
            }
        }
        if constexpr (ALIGN_EPI) { if (wr == 0) PG8_BAR; }
        if constexpr (!Epi::AFTER_DRAIN) { E(acc, cur, wr, wc, fr, fq); S.done(cur); }
        if (!has_next) break;
#pragma unroll
        for (int a = 0; a < 2; ++a)
#pragma unroll
            for (int b = 0; b < 2; ++b)
#pragma unroll
                for (int m = 0; m < 4; ++m)
#pragma unroll
                    for (int n = 0; n < 2; ++n) acc[a][b][m][n] = (f32x4){0.f, 0.f, 0.f, 0.f};
        cur = nxt; cB = nB; ++ui;
#pragma unroll
        for (int i = 0; i < 2; ++i) { vA0[i] = nA0[i]; vA1[i] = nA1[i]; }
        if constexpr (ALIGN_EPI) { if (wr == 1) PG8_BAR; }
    }
    PG8_WAIT_V(0);
    if constexpr (!ALIGN_EPI) { if (wr == 0) PG8_BAR; }
    PG8_BAR;
    if constexpr (Epi::AFTER_DRAIN) { E.fused(acc, cur, wr, wc, fr, fq, lds, wid, lane); S.done(cur); }
#undef PG8_SA
#undef PG8_SB
#undef PG8_STAGE
#undef PG8_LDA
#undef PG8_LDB
#undef PG8_MMA
#undef PG8_WAIT_V
#undef PG8_WAIT_L
#undef PG8_BAR
#undef PG8_SCHED
}


}
namespace att {
typedef float f32x16 __attribute__((ext_vector_type(16)));
typedef short s16x4 __attribute__((ext_vector_type(4)));
typedef short v4i16_t __attribute__((ext_vector_type(4)));
typedef unsigned u32x4a __attribute__((ext_vector_type(4)));
constexpr int PITCH = 512;
constexpr int LDS_K = 0, LDS_V = 24576, LDS_WS = LDS_V + 4 * 16384, LDS_OST = LDS_WS + 2048, LDS_WT = LDS_OST + 8 * 4096, LDS_TOTAL = LDS_WT + 8 * 512, RES_V = 32768;
constexpr float THR = 5.0f;
__device__ __forceinline__ int crow(int r, int hi) { return (r & 3) + 8 * (r >> 2) + 4 * hi; }
__device__ __forceinline__ void glds16(const void* gsrc, unsigned lds_dst) { unsigned keep;
    asm volatile("s_mov_b32 %0, m0\n\ts_mov_b32 m0, %2\n\ts_nop 0\n\tglobal_load_lds_dwordx4 %1, off\n\ts_mov_b32 m0, %0" : "=&s"(keep) : "v"(gsrc), "s"(lds_dst) : "memory"); }
__device__ __forceinline__ f32x16 splat(float x) { f32x16 v;
#pragma unroll
    for (int r = 0; r < 16; ++r) v[r] = x;
    return v; }
typedef __attribute__((address_space(3))) const char* lds_cptr;
__device__ __forceinline__ s16x4 vtr(lds_cptr p) { return __builtin_bit_cast(s16x4, __builtin_amdgcn_ds_read_tr16_b64_v4i16((__attribute__((address_space(3))) v4i16_t*)p)); }
__device__ __forceinline__ float swapmax(float m) { auto rr = __builtin_amdgcn_permlane32_swap(__float_as_uint(m), __float_as_uint(m), false, false); return fmaxf(__uint_as_float(rr[0]), __uint_as_float(rr[1])); }
__device__ __forceinline__ float swapsum(float m) { auto rr = __builtin_amdgcn_permlane32_swap(__float_as_uint(m), __float_as_uint(m), false, false); return __uint_as_float(rr[0]) + __uint_as_float(rr[1]); }
__device__ __forceinline__ float max3a(float a, float b, float c) { float r; asm("v_max3_f32 %0, %1, %2, %3" : "=v"(r) : "v"(a), "v"(b), "v"(c)); return r; }
#define ATT_WAITBAR(N) asm volatile("s_waitcnt vmcnt(" #N ") lgkmcnt(0)\n\ts_barrier" ::: "memory")

template <int DV, int MODE, bool RES = false>
__device__ __forceinline__ void attn_unit(const int b, const int h, const int qb, const bf16* Qp, const bf16* __restrict__ Kp, const bf16* __restrict__ Vp, bf16* Op,
                                          const unsigned* __restrict__ sel, float* o1scr, const float lam, const float* __restrict__ subg, char* shm,
                                          const unsigned short* __restrict__ ql = nullptr, const int nvalid = 0, bf16* opart = nullptr, float* mlp = nullptr, const bool blk_sync = false) {
    constexpr bool MOBA = (MODE != 1);
    constexpr int ND = DV / 32;
    const int tid = threadIdx.x, lane = tid & 63, r32 = lane & 31, hi = lane >> 5;
    const int wid = __builtin_amdgcn_readfirstlane(tid >> 6);
    const long rowbase = (long)b * S; const int q0 = qb * 256;
    const unsigned lds0 = (unsigned)(uintptr_t)shm;
    float* wsf = (float*)(shm + LDS_WS) + wid * 64;
    const lds_cptr shm3 = (lds_cptr)shm;
    const int NT = (MODE == 3 && RES) ? (wid >> 1) + 1 : ((MODE >= 2) ? 4 : 4 * (qb + 1));
    const int wbase = (RES && MODE == 2) ? 0 : wid * 32;
    const int qrel = wbase + r32;
#pragma unroll 1
    for (int comp = 0; comp < (MOBA ? 1 : 2); ++comp) {
        const int qkcol = MOBA ? h * 64 : (2 * h + comp) * 64, vcol = MOBA ? h * 64 : h * 128;
        const bf16* Kh = Kp + rowbase * PITCH + qkcol; const bf16* Vh = Vp + rowbase * PITCH + vcol;
        const bf16* ksrc = Kh + (long)lane * PITCH + wid * 8;
        const bf16* vsrc = Vh + (long)(16 * (wid & 3) + (lane >> 2)) * PITCH + (wid >> 2) * 32 + (lane & 3) * 8;
        const unsigned kdst = lds0 + LDS_K + wid * 1024, vdst = lds0 + LDS_V + wid * 1024;
#define ATT_KR0(n) (MODE == 2 ? q0 + 64 * (n) : ((n) < 4 ? q0 + 64 * (n) : 64 * ((n) - 4)))
#define ATT_DMA(n, ks_, vs_) do { const long kr_ = ATT_KR0(n); glds16(ksrc + kr_ * PITCH, (unsigned)__builtin_amdgcn_readfirstlane(kdst + (ks_) * 8192)); \
        glds16(vsrc + kr_ * PITCH, (unsigned)__builtin_amdgcn_readfirstlane(vdst + (vs_) * 16384)); \
        if (DV == 128) glds16(vsrc + kr_ * PITCH + 64, (unsigned)__builtin_amdgcn_readfirstlane(vdst + (vs_) * 16384 + 8192)); } while (0)
        if (!RES) { ATT_DMA(0, 0, 0); ATT_DMA(1, 1, 1); }
        int qi = q0 + qrel;
        if (MODE == 2) qi = (int)ql[qrel < nvalid ? qrel : 0];
        const bf16* Qw = Qp + (rowbase + qi) * PITCH + qkcol;
        bf16x8 qr[4];
#pragma unroll
        for (int d0 = 0; d0 < 4; ++d0) qr[d0] = *reinterpret_cast<const bf16x8*>(&Qw[d0 * 16 + hi * 8]);
        unsigned smq3 = 0u; float2 ml3[3] = {make_float2(-INFINITY, 0.f), make_float2(-INFINITY, 0.f), make_float2(-INFINITY, 0.f)};
        if (MODE == 3 && lane < 32) { const size_t qx = (size_t)(b * 8 + h) * S + q0 + wid * 32 + lane; smq3 = sel[qx]; const int ns = __popc(smq3);
#pragma unroll
            for (int k = 0; k < 3; ++k) if (k < ns) ml3[k] = *(const float2*)(mlp + (qx * 3 + k) * 2); }
        if (RES && blk_sync) asm volatile("s_waitcnt vmcnt(0)\n\ts_barrier" ::: "memory");
        float mref = 0.f;
        f32x16 ol = splat(0.f);
        const bf16x8 ones = (bf16x8){0x3F80, 0x3F80, 0x3F80, 0x3F80, 0x3F80, 0x3F80, 0x3F80, 0x3F80};
        f32x16 o[ND];
#pragma unroll
        for (int d = 0; d < ND; ++d) o[d] = splat(0.f);
        int slot = 0, vslot = 0;
        u32x4a pw[4];
        constexpr int NPV = 4 * ND, NM = 4 + NPV;
        const int vlane = ((lane >> 4) & 1) * 32 + (lane & 3) * 8 + (4 * hi + ((lane & 15) >> 2)) * 64;
#define ATT_KLD(d0) do { kf[2 * (d0)] = *(const __attribute__((address_space(3))) bf16x8*)(kb + (d0) * 2048); kf[2 * (d0) + 1] = *(const __attribute__((address_space(3))) bf16x8*)(kb + (d0) * 2048 + 512); } while (0)
#define ATT_QK(P0, P1) do { const lds_cptr kb = shm3 + LDS_K + slot * 8192 + hi * 1024 + r32 * 16; bf16x8 kf[8]; \
        ATT_KLD(0); ATT_KLD(1); if (DV == 64) { ATT_KLD(2); ATT_KLD(3); } \
        const f32x16 cop = splat(-mref); __builtin_amdgcn_sched_barrier(0);   \
        P0 = __builtin_amdgcn_mfma_f32_32x32x16_bf16(kf[0], qr[0], cop, 0, 0, 0); P1 = __builtin_amdgcn_mfma_f32_32x32x16_bf16(kf[1], qr[0], cop, 0, 0, 0); \
        if (DV == 128) { ATT_KLD(2); ATT_KLD(3); __builtin_amdgcn_sched_barrier(0); } \
        _Pragma("unroll") for (int d0 = 1; d0 < 4; ++d0) { P0 = __builtin_amdgcn_mfma_f32_32x32x16_bf16(kf[2 * d0], qr[d0], P0, 0, 0, 0); P1 = __builtin_amdgcn_mfma_f32_32x32x16_bf16(kf[2 * d0 + 1], qr[d0], P1, 0, 0, 0); } } while (0)
#define ATT_MASK(P0, P1, n) do { if (MODE != 2 && (n) < 4 && (64 * (n) + 63 > wid * 32)) { const int kb0 = 64 * (n) + 4 * hi; \
        _Pragma("unroll") for (int r = 0; r < 16; ++r) { const int kv = kb0 + (r & 3) + 8 * (r >> 2); if (kv > qrel) P0[r] = -INFINITY; if (kv + 32 > qrel) P1[r] = -INFINITY; } } } while (0)
#define ATT_ROWMAX(P0, P1, RM) do { asm volatile("s_nop 15\n\ts_nop 7" : "+v"(P0), "+v"(P1)); \
        float a_ = max3a(P0[0], P0[1], P1[0]), b_ = max3a(P0[2], P0[3], P1[1]); a_ = max3a(a_, P1[2], P1[3]); \
        _Pragma("unroll") for (int r = 4; r < 16; r += 4) { a_ = max3a(a_, P0[r], P0[r + 1]); b_ = max3a(b_, P0[r + 2], P0[r + 3]); a_ = max3a(a_, P1[r], P1[r + 1]); b_ = max3a(b_, P1[r + 2], P1[r + 3]); } \
        RM = swapmax(fmaxf(a_, b_)); } while (0)
#define ATT_VOFF(j) (((j) >> 2) * 4096 + ((j) & 3) * 1024)
        { if (!RES) { if (DV == 128) ATT_WAITBAR(3); else ATT_WAITBAR(2); ATT_DMA(2, 2, 2); }
          f32x16 p0, p1; ATT_QK(p0, p1); ATT_MASK(p0, p1, 0);
          float rm; ATT_ROWMAX(p0, p1, rm); mref = rm;
#pragma unroll
          for (int r = 0; r < 16; ++r) { p0[r] = __builtin_amdgcn_exp2f(p0[r] - rm); p1[r] = __builtin_amdgcn_exp2f(p1[r] - rm); }
#pragma unroll
          for (int k = 0; k < 2; ++k)
#pragma unroll
              for (int j = 0; j < 4; ++j) { pw[k][j] = pg8::cvt_pk_bf16(p0[8 * k + 2 * j], p0[8 * k + 2 * j + 1]); pw[2 + k][j] = pg8::cvt_pk_bf16(p1[8 * k + 2 * j], p1[8 * k + 2 * j + 1]); }
          slot = 1; vslot = 1; }
#pragma unroll 1
        for (int n = 1; n < NT; ++n) {
            if (!RES) { if (n + 1 < NT) { if (DV == 128) ATT_WAITBAR(3); else ATT_WAITBAR(2); } else ATT_WAITBAR(0);
                if (n + 2 < NT) { const int s2 = slot + 2 >= 3 ? slot - 1 : slot + 2; ATT_DMA(n + 2, s2, (vslot + 2) & 3); } }
            f32x16 p0, p1; ATT_QK(p0, p1); ATT_MASK(p0, p1, n);
            float rm; ATT_ROWMAX(p0, p1, rm);
            bool resc = false; float fsc = 1.f;
            if (__any(rm > THR)) {
                const float dl = fmaxf(rm, 0.f); mref += dl; fsc = __builtin_amdgcn_exp2f(-dl); resc = true;
#pragma unroll
                for (int r = 0; r < 16; ++r) { p0[r] -= dl; p1[r] -= dl; } }
            { const lds_cptr vp = shm3 + (RES ? RES_V + ((vslot + 3) & 3) * 8192 : LDS_V + ((vslot + 3) & 3) * 16384) + vlane;
              s16x4 vlo[4], vhi[4]; u32x4a pwn[4];
#pragma unroll
              for (int j = 0; j < 4; ++j) { vlo[j] = vtr(vp + ATT_VOFF(j)); vhi[j] = vtr(vp + ATT_VOFF(j) + 512); }
              __builtin_amdgcn_sched_barrier(0);
#pragma unroll
              for (int g = 0; g < NM; ++g) {
                  if (g < 4) ol = __builtin_amdgcn_mfma_f32_32x32x16_bf16(__builtin_bit_cast(bf16x8, pw[g]), ones, ol, 0, 0, 0);
                  else { const int j = g - 4; const bf16x8 vf = (bf16x8){vlo[j & 3][0], vlo[j & 3][1], vlo[j & 3][2], vlo[j & 3][3], vhi[j & 3][0], vhi[j & 3][1], vhi[j & 3][2], vhi[j & 3][3]};
                      o[j >> 2] = __builtin_amdgcn_mfma_f32_32x32x16_bf16(__builtin_bit_cast(bf16x8, pw[j & 3]), vf, o[j >> 2], 0, 0, 0);
                      if (j + 4 < NPV) { vlo[j & 3] = vtr(vp + ATT_VOFF(j + 4)); vhi[j & 3] = vtr(vp + ATT_VOFF(j + 4) + 512); } }
                  const int npair = (DV == 128) ? (g < 16 ? 1 : 0) : (g < 4 ? 2 : 1);
                  const int pbase = (DV == 128) ? g : (g < 4 ? 2 * g : g + 4);
#pragma unroll
                  for (int q2 = 0; q2 < npair; ++q2) { const int pi = pbase + q2;
                      const float ea = __builtin_amdgcn_exp2f(pi < 8 ? p0[2 * pi] : p1[2 * pi - 16]), eb = __builtin_amdgcn_exp2f(pi < 8 ? p0[2 * pi + 1] : p1[2 * pi - 15]);
                      pwn[pi >> 2][pi & 3] = pg8::cvt_pk_bf16(ea, eb); }
                  __builtin_amdgcn_sched_barrier(0);
              }
#pragma unroll
              for (int k = 0; k < 4; ++k) pw[k] = pwn[k]; }
            if (resc) {
                if (hi == 0) wsf[r32] = fsc;
                asm volatile("s_waitcnt lgkmcnt(0)" ::: "memory");
#pragma unroll
                for (int r = 0; r < 16; ++r) { const float fr = wsf[crow(r, hi)]; ol[r] *= fr;
#pragma unroll
                    for (int d = 0; d < ND; ++d) o[d][r] *= fr; }
            }
            slot = RES ? slot + 1 : (slot == 2 ? 0 : slot + 1); vslot = (vslot + 1) & 3;
        }
        { const lds_cptr vp = shm3 + (RES ? RES_V + ((vslot + 3) & 3) * 8192 : LDS_V + ((vslot + 3) & 3) * 16384) + vlane;
#pragma unroll
          for (int ks = 0; ks < 4; ++ks) ol = __builtin_amdgcn_mfma_f32_32x32x16_bf16(__builtin_bit_cast(bf16x8, pw[ks]), ones, ol, 0, 0, 0);
#pragma unroll
          for (int j = 0; j < NPV; ++j) { const s16x4 vlo = vtr(vp + ATT_VOFF(j)), vhi = vtr(vp + ATT_VOFF(j) + 512);
              const bf16x8 vf = (bf16x8){vlo[0], vlo[1], vlo[2], vlo[3], vhi[0], vhi[1], vhi[2], vhi[3]};
              o[j >> 2] = __builtin_amdgcn_mfma_f32_32x32x16_bf16(__builtin_bit_cast(bf16x8, pw[j & 3]), vf, o[j >> 2], 0, 0, 0);
              if ((j & 7) == 7) __builtin_amdgcn_sched_barrier(0); } }
#undef ATT_QK
#undef ATT_KLD
#undef ATT_MASK
#undef ATT_ROWMAX
#undef ATT_VOFF
        int lane_e = lane, q0_e = q0 + wbase, h_e = h; asm volatile("" : "+v"(lane_e), "+v"(q0_e), "+v"(h_e));
        float rli[16];
#pragma unroll
        for (int r = 0; r < 16; ++r) rli[r] = __builtin_amdgcn_rcpf(ol[r]);
        bf16* stg = (bf16*)(shm + LDS_OST) + wid * 2048;
        if (MOBA) {
#pragma unroll
            for (int r = 0; r < 16; ++r) { const int orow = crow(r, hi);
#pragma unroll
                for (int d = 0; d < 2; ++d) stg[orow * 64 + d * 32 + (lane_e & 31)] = (bf16)f2bf(o[d][r] * rli[r]); }
            if (MODE == 0) {
                asm volatile("s_waitcnt lgkmcnt(0)" ::: "memory");
                bf16* Ow = Op + (rowbase + q0_e) * PITCH + h_e * 64;
#pragma unroll
                for (int i = 0; i < 4; ++i) { const int row = i * 8 + (lane_e >> 3), ch = lane_e & 7; const u32x4a v = *(const u32x4a*)(stg + row * 64 + ch * 8); *(u32x4a*)(Ow + (long)row * PITCH + ch * 8) = v; }
            } else {
                if ((lane_e & 31) == 0) {
#pragma unroll
                    for (int r = 0; r < 16; ++r) wsf[crow(r, hi)] = ol[r]; }
                int* dtab = (int*)wsf + 32;
                float* wt = (float*)(shm + LDS_WT) + wid * 128;
                asm volatile("s_waitcnt lgkmcnt(0)" ::: "memory");
                const size_t bhq = (size_t)(b * 8 + h_e) * S;
                if (MODE == 2) {
                    if (lane_e < 32) { const int slotr = (q0_e - q0) + lane_e; const int qq = (int)ql[slotr < nvalid ? slotr : 0];
                        int d = -1;
                        if (slotr < nvalid) { const unsigned smq = sel[bhq + qq]; d = (int)((bhq + qq) * 3) + __popc(smq & ((1u << qb) - 1u));
                            *(float2*)(mlp + (size_t)d * 2) = make_float2(mref, wsf[lane_e]); }
                        dtab[lane_e] = d; }
                    asm volatile("s_waitcnt lgkmcnt(0)" ::: "memory");
#pragma unroll
                    for (int i = 0; i < 4; ++i) { const int row = i * 8 + (lane_e >> 3), ch = lane_e & 7; const int d = dtab[row];
                        if (d >= 0) { const u32x4a v = *(const u32x4a*)(stg + row * 64 + ch * 8); *(u32x4a*)(opart + (size_t)d * 64 + ch * 8) = v; } }
                } else {
                    u32x4a pv[4][3];
#pragma unroll
                    for (int i = 0; i < 4; ++i) { const int row = i * 8 + (lane_e >> 3), ch = lane_e & 7; const bf16* pp = opart + ((bhq + q0_e + row) * 3) * 64 + ch * 8;
#pragma unroll
                        for (int k = 0; k < 3; ++k) pv[i][k] = *(const u32x4a*)(pp + k * 64); }
                    if (lane_e < 32) { const int ns = __popc(smq3);
                        const float md = mref, ld = wsf[lane_e];
                        float M = md;
#pragma unroll
                        for (int k = 0; k < 3; ++k) if (k < ns) M = fmaxf(M, ml3[k].x);
                        float wd = ld * __builtin_amdgcn_exp2f(md - M), wk[3], tot = wd;
#pragma unroll
                        for (int k = 0; k < 3; ++k) { wk[k] = (k < ns) ? ml3[k].y * __builtin_amdgcn_exp2f(ml3[k].x - M) : 0.f; tot += wk[k]; }
                        const float inv = 1.f / tot;
                        *(f32x4*)(wt + lane_e * 4) = (f32x4){wd * inv, wk[0] * inv, wk[1] * inv, wk[2] * inv}; }
                    asm volatile("s_waitcnt lgkmcnt(0)" ::: "memory");
                    bf16* Ow = Op + (rowbase + q0_e) * PITCH + h_e * 64;
#pragma unroll
                    for (int i = 0; i < 4; ++i) { const int row = i * 8 + (lane_e >> 3), ch = lane_e & 7;
                        const f32x4 a = *(const f32x4*)(wt + row * 4); const u32x4a v = *(const u32x4a*)(stg + row * 64 + ch * 8);
                        f32x4 x0 = pg8::bflo(v.x, v.y) * a[0], x1 = pg8::bflo(v.z, v.w) * a[0];
#pragma unroll
                        for (int k = 0; k < 3; ++k) { const bool on = a[1 + k] != 0.f; const f32x4 y0 = pg8::bflo(pv[i][k].x, pv[i][k].y) * a[1 + k], y1 = pg8::bflo(pv[i][k].z, pv[i][k].w) * a[1 + k];
#pragma unroll
                            for (int e = 0; e < 4; ++e) { x0[e] += on ? y0[e] : 0.f; x1[e] += on ? y1[e] : 0.f; } }
                        *(u32x4a*)(Ow + (long)row * PITCH + ch * 8) = pg8::pack8(x0, x1); }
                }
            }
        } else {
            float* scr = o1scr + (size_t)comp * 32768 + (size_t)wid * 4096 + lane_e;
#pragma unroll
            for (int d = 0; d < ND; ++d) { float* sp = scr + d * 1024; asm volatile("" : "+v"(sp));
#pragma unroll
                for (int r = 0; r < 16; ++r) sp[r * 64] = o[d][r] * rli[r]; }
            if (comp == 1) {
                asm volatile("s_waitcnt vmcnt(0)" ::: "memory");
                const int row = lane_e >> 1, hf = lane_e & 1;
                const int hi_r = (row >> 2) & 1, rr = (row & 3) | ((row >> 3) << 2);
                const float* A0 = o1scr + (size_t)wid * 4096 + rr * 64 + hi_r * 32 + hf * 2048;
                const float* B0 = A0 + 32768;
                f32x4 v[16]; float ssq = 0.f;
#pragma unroll
                for (int d2 = 0; d2 < 2; ++d2)
#pragma unroll
                    for (int c4 = 0; c4 < 8; ++c4) { const f32x4 a = __builtin_nontemporal_load((const f32x4*)(A0 + d2 * 1024 + c4 * 4)), bb = __builtin_nontemporal_load((const f32x4*)(B0 + d2 * 1024 + c4 * 4));
                        const f32x4 w = a - bb * lam; v[d2 * 8 + c4] = w; ssq += (w[0] * w[0] + w[1] * w[1]) + (w[2] * w[2] + w[3] * w[3]); }
                ssq += __shfl_xor(ssq, 1);
                const float rstd = rsqrtf(ssq * (1.f / 128.f) + EPS) * 0.8f;
                bf16* Ow = Op + (rowbase + q0_e + row) * PITCH + h_e * 128 + hf * 64;
#pragma unroll
                for (int k = 0; k < 8; ++k) { const f32x4 g0 = *(const f32x4*)(subg + hf * 64 + k * 8), g1 = *(const f32x4*)(subg + hf * 64 + k * 8 + 4);
                    *(u32x4a*)(Ow + k * 8) = pg8::pack8(v[2 * k] * g0 * rstd, v[2 * k + 1] * g1 * rstd); }
            }
        }
        if (RES) asm volatile("s_waitcnt lgkmcnt(0)" ::: "memory"); else
        asm volatile("s_waitcnt vmcnt(0) lgkmcnt(0)\n\ts_barrier" ::: "memory");
    }
#undef ATT_KR0
#undef ATT_DMA
}
__device__ __forceinline__ void moba_block_issue(const bf16* __restrict__ Kp, const bf16* __restrict__ Vp, const int b, const int h, const int blk, char* shm) {
    const int tid = threadIdx.x, lane = tid & 63; const int wid = __builtin_amdgcn_readfirstlane(tid >> 6);
    const unsigned lds0 = (unsigned)(uintptr_t)shm;
    const bf16* ksrc = Kp + ((long)b * S + 256 * blk + lane) * PITCH + h * 64 + wid * 8;
    const bf16* vsrc = Vp + ((long)b * S + 256 * blk + 16 * (wid & 3) + (lane >> 2)) * PITCH + h * 64 + (wid >> 2) * 32 + (lane & 3) * 8;
    asm volatile("s_waitcnt lgkmcnt(0)\n\ts_barrier" ::: "memory");
#pragma unroll
    for (int n = 0; n < 4; ++n) { glds16(ksrc + (long)(64 * n) * PITCH, (unsigned)__builtin_amdgcn_readfirstlane(lds0 + n * 8192 + wid * 1024));
        glds16(vsrc + (long)(64 * n) * PITCH, (unsigned)__builtin_amdgcn_readfirstlane(lds0 + RES_V + n * 8192 + wid * 1024)); }
}
}

__device__ __forceinline__ float wave_sum(float v) {
#pragma unroll
    for (int o = 1; o < 64; o <<= 1) v += __shfl_xor(v, o);
    return v;
}
__device__ __forceinline__ void gate_wave(int b, int h, int chunk, int lane, const bf16* __restrict__ Qm, const LAS float* ksl, unsigned* __restrict__ sel, unsigned* qcnt, unsigned short* qlist) {
    const int qpos = chunk * 64 + lane, blk = chunk >> 2;
    const size_t t = (size_t)b * S + qpos;
    float q[64];
#pragma unroll
    for (int d8 = 0; d8 < 8; ++d8) { const v4u v = *(const v4u*)(Qm + t * 512 + h * 64 + d8 * 8);
        q[d8 * 8] = __uint_as_float(v.x << 16); q[d8 * 8 + 1] = __uint_as_float(v.x & 0xffff0000u); q[d8 * 8 + 2] = __uint_as_float(v.y << 16); q[d8 * 8 + 3] = __uint_as_float(v.y & 0xffff0000u);
        q[d8 * 8 + 4] = __uint_as_float(v.z << 16); q[d8 * 8 + 5] = __uint_as_float(v.z & 0xffff0000u); q[d8 * 8 + 6] = __uint_as_float(v.w << 16); q[d8 * 8 + 7] = __uint_as_float(v.w & 0xffff0000u); }
    float v0 = -3e38f, v1 = -3e38f, v2 = -3e38f; int i0 = -1, i1 = -1, i2 = -1;
    for (int j = 0; j < blk; ++j) {
        const LAS f32x4* kr = (const LAS f32x4*)(ksl + j * 64);
        float g = 0.f;
#pragma unroll
        for (int d4 = 0; d4 < 16; ++d4) { const f32x4 kv = kr[d4]; g += q[4 * d4] * kv[0] + q[4 * d4 + 1] * kv[1] + q[4 * d4 + 2] * kv[2] + q[4 * d4 + 3] * kv[3]; }
        if (g > v0) { v2 = v1; i2 = i1; v1 = v0; i1 = i0; v0 = g; i0 = j; }
        else if (g > v1) { v2 = v1; i2 = i1; v1 = g; i1 = j; }
        else if (g > v2) { v2 = g; i2 = j; }
    }
    unsigned m = 0u;
    if (i0 >= 0) m |= 1u << i0;
    if (i1 >= 0) m |= 1u << i1;
    if (i2 >= 0) m |= 1u << i2;
    sel[(size_t)(b * 8 + h) * S + qpos] = m;
    if (qcnt) {
        const int bh = b * 8 + h;
        int myc = 0;
        for (int j = 0; j < blk; ++j) { const unsigned long long bal = __ballot((m >> j) & 1u); if (lane == j) myc = (int)__popcll(bal); }
        int mybase = 0; if (lane < blk && myc) mybase = (int)atomicAdd(qcnt + bh * 32 + lane, (unsigned)myc);
        for (int j = 0; j < blk; ++j) { const bool sj = (m >> j) & 1u; const unsigned long long bal = __ballot(sj); const int base = __shfl(mybase, j);
            if (sj) qlist[(size_t)bh * QL_PER_BH + 256 * (31 * j - (j * (j - 1)) / 2) + base + __popcll(bal & ((1ull << lane) - 1ull))] = (unsigned short)qpos; }
    }
}
constexpr int NWAVES = 8;
constexpr int RING_OFF = 0, RING_BYTES = 131072;
constexpr int LDSCTL_OFF = RING_BYTES, MISC_OFF = LDSCTL_OFF + 320;
constexpr int TBL_OFF = LDSCTL_OFF + 512;
constexpr int ROWTAB_OFF = LDSCTL_OFF + 2048;
static_assert(att::LDS_TOTAL <= RING_BYTES && pg8::STAGE_BYTES <= RING_BYTES, "phase scratch fits the ring region");
constexpr int LDS_BYTES = 147456;
constexpr int CW_BAR = 4096;

struct Frame {
    LAS unsigned char* lds;
    volatile LAS unsigned* MISC;
    gu32* ctl;
    int tid, lane, wave, vcu, G;
};
struct Args { const float* in[23]; float* out; unsigned char* ws; int ph_lo, ph_hi, li, pad; };

template <int MODE> __device__ __forceinline__ int wmap(int c) {
    if (MODE == 1) { const int pn = c >> 8; const bool rp = (pn < 4) || (pn >= 6 && pn < 10); if (!rp) return c; const int o = c & 255; return (pn << 8) + (((o >> 5) & 1) << 7) + ((o >> 6) << 5) + (o & 31); }
    if (MODE == 2) return ((c >> 7) << 8) + (c & 127);
    if (MODE == 3) return ((c >> 7) << 8) + 128 + (c & 127);
    return c;
}
struct TrItem { const float* W; bf16* WT; int K, N, mode, item; };
__device__ __forceinline__ void tr_load(const TrItem& it, int lane, f32x4 (&v)[8]) {
    const int nblk = it.N / 32, kb = it.item / nblk, nb = it.item % nblk;
    const float* p = it.W + (size_t)(64 * kb + (lane >> 3)) * it.N + 32 * nb + 4 * (lane & 7);
#pragma unroll
    for (int i = 0; i < 8; ++i) v[i] = *(const GAS f32x4*)(p + (size_t)(8 * i) * it.N);
}
__device__ __forceinline__ void tr_store(const TrItem& it, int lane, const f32x4 (&v)[8], LAS float* scr) {
    const int nblk = it.N / 32, kb = it.item / nblk, nb = it.item % nblk, k0 = 64 * kb, n0 = 32 * nb;
#pragma unroll
    for (int i = 0; i < 8; ++i) { LAS float* d = scr + (8 * i + (lane >> 3)) * 33 + 4 * (lane & 7); d[0] = v[i][0]; d[1] = v[i][1]; d[2] = v[i][2]; d[3] = v[i][3]; }
    LDS_WAIT(); asm volatile("" ::: "memory");
    const int c = lane & 7;
#pragma unroll
    for (int j = 0; j < 4; ++j) { const int n = (lane >> 3) + 8 * j; const LAS float* s = scr + (8 * c) * 33 + n;
        v4u o; o.x = pk2(s[0 * 33], s[1 * 33]); o.y = pk2(s[2 * 33], s[3 * 33]); o.z = pk2(s[4 * 33], s[5 * 33]); o.w = pk2(s[6 * 33], s[7 * 33]);
        const int cc = n0 + n; const int row = it.mode == 1 ? wmap<1>(cc) : (it.mode == 2 ? wmap<2>(cc) : (it.mode == 3 ? wmap<3>(cc) : cc));
        *(GAS v4u*)(it.WT + (size_t)row * it.K + k0 + 8 * c) = o; }
    LDS_WAIT(); asm volatile("" ::: "memory");
}
__device__ __forceinline__ float silu_f(float v) { return v / (1.f + __expf(-v)); }

__device__ __forceinline__ void p0_prologue(Frame& F, const Args& args) {
    unsigned char* ws = args.ws;
    const int gw = F.vcu * NWAVES + F.wave, NGW = F.G * NWAVES, gt = gw * 64 + F.lane, NGT = NGW * 64;
    { const float* c = args.in[1]; const float* w = args.in[2]; float* modp = (float*)(ws + WS_MODP);
      LAS float* act = (LAS float*)(F.lds + RING_OFF + F.wave * 16384);
      for (int task = gw; task < 768; task += NGW) { const int n = (task % 96) * 64 + F.lane, ks = task / 96;
#pragma unroll
          for (int i = 0; i < 8; ++i) { const int idx = F.lane + 64 * i, bb = idx >> 7, kk = idx & 127; act[idx] = silu_f(c[bb * 1024 + ks * 128 + kk]); }
          LDS_WAIT(); asm volatile("" ::: "memory");
          float a0 = 0.f, a1 = 0.f, a2 = 0.f, a3 = 0.f;
#pragma unroll 8
          for (int kk = 0; kk < 128; ++kk) { const float wv = w[(size_t)(ks * 128 + kk) * 6144 + n];
              a0 += act[kk] * wv; a1 += act[128 + kk] * wv; a2 += act[256 + kk] * wv; a3 += act[384 + kk] * wv; }
          modp[(size_t)(ks * 4 + 0) * 6144 + n] = a0; modp[(size_t)(ks * 4 + 1) * 6144 + n] = a1; modp[(size_t)(ks * 4 + 2) * 6144 + n] = a2; modp[(size_t)(ks * 4 + 3) * 6144 + n] = a3;
          LDS_WAIT(); asm volatile("" ::: "memory"); } }
    { float2* tab = (float2*)(ws + WS_ROPE);
      for (int idx = gt; idx < S * 32; idx += NGT) { const int pos = idx >> 5, i = idx & 31;
          const float e = (float)(2 * i) / 64.f; const float inv = 1.0f / powf(10000.f, e); const float ang = (float)pos * inv;
          const double a = (double)ang; const double TWO_PI = 6.283185307179586476925286766559;
          const double n = rint(a / TWO_PI); const double r = a - n * TWO_PI; const double r2 = r * r;
          double sn = 0.0, cs = 0.0, ts = r, tc = 1.0;
          for (int k = 0; k < 16; ++k) { cs += tc; sn += ts; tc *= -r2 / (double)((2 * k + 1) * (2 * k + 2)); ts *= -r2 / (double)((2 * k + 2) * (2 * k + 3)); }
          tab[idx] = make_float2((float)cs, (float)sn); } }
    if (gt == 0) { float s1 = 0.f, s2 = 0.f; for (int i = 0; i < 64; ++i) { s1 += args.in[6][i] * args.in[7][i]; s2 += args.in[8][i] * args.in[9][i]; }
        *(float*)(ws + WS_LAM) = expf(s1) - expf(s2) + 0.2f; }
    { bf16* wr = (bf16*)(ws + WS_WR); const float* wg = args.in[15]; const float* we = args.in[17];
      for (int idx = gt; idx < 32 * 3 * 64 * 8; idx += NGT) { const int s = idx & 7, ln = (idx >> 3) & 63, nt = (idx >> 9) % 3, uu = idx / 1536;
          const int k = 32 * uu + 8 * (ln >> 4) + s, col = 16 * nt + (ln & 15);
          const float w = col < 4 ? wg[k * 4 + col] : (col < 36 ? we[k * 32 + col - 4] : 0.f);
          const unsigned hi = f2bf(w); const float rem = w - __uint_as_float(hi << 16);
          wr[idx] = (bf16)hi; wr[49152 + idx] = (bf16)f2bf(rem); } }
    LAS float* scr = (LAS float*)(F.lds + RING_OFF + F.wave * 16384);
    constexpr int I_IN = 16 * 160, I_PM = 8 * 32, I_PD = 8 * 32, I_OUT = 16 * 32, I_G = 32 * 256, I_U = 32 * 256, I_D = 32 * 256;
    constexpr int NITEMS = I_IN + I_PM + I_PD + I_OUT + I_G + I_U + I_D;
    unsigned char* wsb = ws;
#define TR_DECODE(IT, OUT) do { int r = (IT); \
        if (r < I_IN) { OUT = TrItem{args.in[5], (bf16*)(wsb + WS_WIN), 1024, 5120, 1, r}; break; } r -= I_IN; \
        if (r < I_PM) { OUT = TrItem{args.in[11], (bf16*)(wsb + WS_WPM), 512, 1024, 0, r}; break; } r -= I_PM; \
        if (r < I_PD) { OUT = TrItem{args.in[12], (bf16*)(wsb + WS_WPD), 512, 1024, 0, r}; break; } r -= I_PD; \
        if (r < I_OUT) { OUT = TrItem{args.in[13], (bf16*)(wsb + WS_WOUT), 1024, 1024, 0, r}; break; } r -= I_OUT; \
        if (r < I_G) { const int e = r >> 8; OUT = TrItem{args.in[19] + (size_t)e * 1024 * 512, (bf16*)(wsb + WS_WGU) + (size_t)e * 1024 * 1024, 1024, 512, 2, r & 255}; break; } r -= I_G; \
        if (r < I_U) { const int e = r >> 8; OUT = TrItem{args.in[20] + (size_t)e * 1024 * 512, (bf16*)(wsb + WS_WGU) + (size_t)e * 1024 * 1024, 1024, 512, 3, r & 255}; break; } r -= I_U; \
        { const int e = r >> 8; OUT = TrItem{args.in[21] + (size_t)e * 512 * 1024, (bf16*)(wsb + WS_WD) + (size_t)e * 1024 * 512, 512, 1024, 0, r & 255}; } } while (0)
    if (gw < NITEMS) {
        TrItem cur; TR_DECODE(gw, cur);
        f32x4 va[8], vb[8];
        tr_load(cur, F.lane, va);
        for (int it = gw; it < NITEMS; it += 2 * NGW) {
            TrItem nx1 = cur; const bool h1 = it + NGW < NITEMS; if (h1) { TR_DECODE(it + NGW, nx1); tr_load(nx1, F.lane, vb); }
            tr_store(cur, F.lane, va, scr);
            if (!h1) break;
            TrItem nx2 = nx1; const bool h2 = it + 2 * NGW < NITEMS; if (h2) { TR_DECODE(it + 2 * NGW, nx2); tr_load(nx2, F.lane, va); }
            tr_store(nx1, F.lane, vb, scr);
            if (!h2) break;
            cur = nx2;
        }
    }
#undef TR_DECODE
}
__device__ __forceinline__ void p1_xn(Frame& F, const Args& args) {
    unsigned char* ws = args.ws;
    LAS float* tA = (LAS float*)(F.lds + RING_OFF); LAS float* tS = tA + 1024;
    const int w = blockIdx.x, b = (w * 128) / S;
    const float* modp = (const float*)(ws + WS_MODP); const float* b_ada = args.in[3]; const float* g1n = args.in[4];
    for (int d = F.tid; d < 1024; d += NWAVES * 64) { float sc = b_ada[1024 + d], sh = b_ada[d];
#pragma unroll
        for (int p = 0; p < 8; ++p) { sc += modp[(size_t)(p * 4 + b) * 6144 + 1024 + d]; sh += modp[(size_t)(p * 4 + b) * 6144 + d]; }
        tA[d] = g1n[d] * (1.f + sc); tS[d] = sh; }
    if (F.tid < 96) { const int idx = w * 96 + F.tid, bb = idx / 6144, n = idx % 6144; float v = b_ada[n];
#pragma unroll
        for (int p = 0; p < 8; ++p) v += modp[(size_t)(p * 4 + bb) * 6144 + n];
        ((float*)(ws + WS_MOD))[idx] = v; }
    __syncthreads();
    const float* x = args.in[0]; bf16* XN = (bf16*)(ws + WS_XN);
    for (int i = 0; i < 16; ++i) {
        const int row = w * 128 + F.wave * 16 + i;
        const GAS f32x4* xr = (const GAS f32x4*)(x + (size_t)row * 1024) + F.lane;
        f32x4 v[4]; float ss = 0.f;
#pragma unroll
        for (int j = 0; j < 4; ++j) { v[j] = xr[64 * j]; ss += (v[j].x * v[j].x + v[j].y * v[j].y) + (v[j].z * v[j].z + v[j].w * v[j].w); }
        const float rstd = rsqrtf(wave_sum(ss) * (1.f / 1024.f) + EPS);
        GAS unsigned long long* o8 = (GAS unsigned long long*)(XN + (size_t)row * 1024) + F.lane;
#pragma unroll
        for (int j = 0; j < 4; ++j) { const f32x4 a = ((const LAS f32x4*)tA)[F.lane + 64 * j], s = ((const LAS f32x4*)tS)[F.lane + 64 * j];
            const f32x4 o = v[j] * rstd * a + s;
            o8[64 * j] = (unsigned long long)pg8::cvt_pk_bf16(o.x, o.y) | ((unsigned long long)pg8::cvt_pk_bf16(o.z, o.w) << 32); }
    }
}

__device__ __forceinline__ void moe_tables(Frame& F, const Args& args) {
    LAS int* tbl = (LAS int*)(F.lds + TBL_OFF);
    if (F.tid == 0) { const gu32* gc = F.ctl + CW_CNT; int o = 0;
        for (int e = 0; e < 32; ++e) { const int c = (int)__hip_atomic_load(gc + e, RLX_AGENT); tbl[e] = o; tbl[40 + e] = c; o += (c + 255) >> 8; }
        tbl[32] = o; }
    __syncthreads();
}
__device__ __forceinline__ void p7_router(Frame& F, const Args& args) {
    unsigned char* ws = args.ws;
    typedef float f32x4v __attribute__((ext_vector_type(4)));
    LAS float* tA = (LAS float*)(F.lds + RING_OFF); LAS float* tS = tA + 1024;
    LAS float* lgs = (LAS float*)(F.lds + RING_OFF + 8192) + F.wave * (16 * 48);
    LAS int* cntl = (LAS int*)(F.lds + RING_OFF + 8192 + 8 * 16 * 48 * 4); LAS int* basel = cntl + 32;
    const int w = blockIdx.x, b = (w * 128) / S;
    const float* mod = (const float*)(ws + WS_MOD); const float* g2n = args.in[14];
    for (int d = F.tid; d < 1024; d += NWAVES * 64) { tA[d] = g2n[d] * (1.f + mod[b * 6144 + 4096 + d]); tS[d] = mod[b * 6144 + 3072 + d]; }
    if (F.tid < 32) cntl[F.tid] = 0;
    __syncthreads();
    const int i16 = F.lane & 15, q = F.lane >> 4;
    const int row = w * 128 + F.wave * 16 + i16;
    const float* x1 = args.out; bf16* h2 = (bf16*)(ws + WS_XN); const bf16* wr = (const bf16*)(ws + WS_WR);
    float rstd;
    { const f32x4v* rp = (const f32x4v*)((const float*)(ws + WS_ROWSQ) + (size_t)row * 16); const f32x4v a = rp[0], c = rp[1], d = rp[2], e = rp[3];
      const float ss = ((a[0] + a[1]) + (a[2] + a[3])) + ((c[0] + c[1]) + (c[2] + c[3])) + ((d[0] + d[1]) + (d[2] + d[3])) + ((e[0] + e[1]) + (e[2] + e[3]));
      rstd = rsqrtf(ss * (1.f / 1024.f) + EPS); }
    f32x4v acc[3];
#pragma unroll
    for (int nt = 0; nt < 3; ++nt) acc[nt] = (f32x4v){0.f, 0.f, 0.f, 0.f};
    const float* xr = x1 + (size_t)row * 1024 + 8 * q;
    bf16* hr = h2 + (size_t)row * 1024 + 8 * q;
#pragma unroll 4
    for (int uu = 0; uu < 32; ++uu) {
        const f32x4v xa = *(const f32x4v*)(xr + 32 * uu), xb = *(const f32x4v*)(xr + 32 * uu + 4);
        const f32x4v aa = *(const LAS f32x4v*)(tA + 32 * uu + 8 * q), ab = *(const LAS f32x4v*)(tA + 32 * uu + 8 * q + 4);
        const f32x4v sa = *(const LAS f32x4v*)(tS + 32 * uu + 8 * q), sb = *(const LAS f32x4v*)(tS + 32 * uu + 8 * q + 4);
        const f32x4v ha = xa * rstd * aa + sa, hb = xb * rstd * ab + sb;
        const pg8::u32x4 hh = pg8::pack8(ha, hb);
        *(pg8::u32x4*)(hr + 32 * uu) = hh;
        const pg8::u32x4 hl = pg8::pack8(ha - pg8::bflo(hh.x, hh.y), hb - pg8::bflo(hh.z, hh.w));
        const bf16x8 ahi = __builtin_bit_cast(bf16x8, hh), alo = __builtin_bit_cast(bf16x8, hl);
#pragma unroll
        for (int nt = 0; nt < 3; ++nt) { const size_t bo = ((size_t)(uu * 3 + nt) * 64 + F.lane) * 8;
            const bf16x8 bhi = *(const bf16x8*)(wr + bo), blo = *(const bf16x8*)(wr + 49152 + bo);
            acc[nt] = __builtin_amdgcn_mfma_f32_16x16x32_bf16(ahi, bhi, acc[nt], 0, 0, 0);
            acc[nt] = __builtin_amdgcn_mfma_f32_16x16x32_bf16(alo, bhi, acc[nt], 0, 0, 0);
            acc[nt] = __builtin_amdgcn_mfma_f32_16x16x32_bf16(ahi, blo, acc[nt], 0, 0, 0); }
    }
#pragma unroll
    for (int nt = 0; nt < 3; ++nt)
#pragma unroll
        for (int r = 0; r < 4; ++r) lgs[(4 * q + r) * 48 + 16 * nt + i16] = acc[nt][r];
    LDS_WAIT(); asm volatile("" ::: "memory");
    int e0 = 0, e1 = 0, p0l = 0, p1l = 0; float w0 = 0.f, w1 = 0.f;
    if (F.lane < 16) {
        const LAS float* lr = lgs + F.lane * 48; const float* bg = args.in[16]; const float* be = args.in[18];
        float gl[4]; float gmx = -3e38f; int gi = 0;
#pragma unroll
        for (int i = 0; i < 4; ++i) { gl[i] = lr[i] + bg[i]; if (gl[i] > gmx) { gmx = gl[i]; gi = i; } }
        float gs = 0.f;
#pragma unroll
        for (int i = 0; i < 4; ++i) gs += expf(gl[i] - gmx);
        const float gw = 1.f / gs;
        float el[8]; float emx = -3e38f;
#pragma unroll
        for (int i = 0; i < 8; ++i) { el[i] = lr[4 + gi * 8 + i] + be[gi * 8 + i]; emx = fmaxf(emx, el[i]); }
        float es = 0.f, ep[8];
#pragma unroll
        for (int i = 0; i < 8; ++i) { ep[i] = expf(el[i] - emx); es += ep[i]; }
        int a0 = 0; float pa = -1.f;
#pragma unroll
        for (int i = 0; i < 8; ++i) if (ep[i] > pa) { pa = ep[i]; a0 = i; }
        int a1 = 0; float pb = -1.f;
#pragma unroll
        for (int i = 0; i < 8; ++i) if (i != a0 && ep[i] > pb) { pb = ep[i]; a1 = i; }
        pa /= es; pb /= es; const float sw = pa + pb;
        e0 = gi * 8 + a0; e1 = gi * 8 + a1; w0 = gw * (pa / sw); w1 = gw * (pb / sw);
        p0l = __hip_atomic_fetch_add(cntl + e0, 1, __ATOMIC_RELAXED, __HIP_MEMORY_SCOPE_WORKGROUP);
        p1l = __hip_atomic_fetch_add(cntl + e1, 1, __ATOMIC_RELAXED, __HIP_MEMORY_SCOPE_WORKGROUP);
    }
    __syncthreads();
    if (F.tid < 32) { const int c = cntl[F.tid]; basel[F.tid] = c ? (int)__hip_atomic_fetch_add(F.ctl + CW_CNT + F.tid, (unsigned)c, RLX_AGENT) : 0; }
    __syncthreads();
    if (F.lane < 16) {
        const int t = w * 128 + F.wave * 16 + F.lane;
        int* list = (int*)(ws + WS_LIST); int* toki = (int*)(ws + WS_TOKI); float* tokw = (float*)(ws + WS_TOKW);
        const int q0 = basel[e0] + p0l, q1 = basel[e1] + p1l;
        list[(size_t)e0 * T + q0] = t * 2; list[(size_t)e1 * T + q1] = t * 2 + 1;
        toki[t * 2] = (e0 << 20) | q0; toki[t * 2 + 1] = (e1 << 20) | q1; tokw[t * 2] = w0; tokw[t * 2 + 1] = w1;
    }
}
__device__ __forceinline__ void p10_final(Frame& F, const Args& args) {
    unsigned char* ws = args.ws;
    const LAS int* tbl = (const LAS int*)(F.lds + TBL_OFF);
    const int w = blockIdx.x, b = (w * 128) / S;
    const float* g2 = (const float*)(ws + WS_MOD) + (size_t)b * 6144 + 5120; const float* fg = args.in[22];
    const bf16* Yb = (const bf16*)(ws + WS_YB); const int* toki = (const int*)(ws + WS_TOKI);
    float* out = args.out;
    const int trow0 = w * 128 + F.wave * 16;
    size_t rall_a = 0, rall_b = 0;
    if (F.lane < 16) { const int i0 = toki[(trow0 + F.lane) * 2], i1 = toki[(trow0 + F.lane) * 2 + 1];
        rall_a = (size_t)(tbl[i0 >> 20] * 256 + (i0 & 0xfffff)); rall_b = (size_t)(tbl[i1 >> 20] * 256 + (i1 & 0xfffff)); }
    f32x4 xn[4]; uint2 yan[4], ybn[4];
#define P10_LOAD(i) do { const int t_ = trow0 + (i); const size_t ra_ = (size_t)__shfl((unsigned long long)rall_a, (i)), rb_ = (size_t)__shfl((unsigned long long)rall_b, (i)); \
        _Pragma("unroll") for (int j = 0; j < 4; ++j) { const int d0 = (F.lane + 64 * j) * 4; xn[j] = *(const f32x4*)(out + (size_t)t_ * 1024 + d0); yan[j] = *(const uint2*)(Yb + ra_ * 1024 + d0); ybn[j] = *(const uint2*)(Yb + rb_ * 1024 + d0); } } while (0)
    P10_LOAD(0);
    for (int i = 0; i < 16; ++i) {
        const int t = trow0 + i;
        f32x4 v[4]; float ss = 0.f;
#pragma unroll
        for (int j = 0; j < 4; ++j) { const int d0 = (F.lane + 64 * j) * 4; const f32x4 g = *(const f32x4*)(g2 + d0);
            v[j] = xn[j] + g * (pg8::bflo(yan[j].x, yan[j].y) + pg8::bflo(ybn[j].x, ybn[j].y));
            ss += (v[j].x * v[j].x + v[j].y * v[j].y) + (v[j].z * v[j].z + v[j].w * v[j].w); }
        if (i + 1 < 16) P10_LOAD(i + 1);
        const float rstd = rsqrtf(wave_sum(ss) * (1.f / 1024.f) + EPS);
#pragma unroll
        for (int j = 0; j < 4; ++j) { const int d0 = (F.lane + 64 * j) * 4; const f32x4 g = *(const f32x4*)(fg + d0); *(f32x4*)(out + (size_t)t * 1024 + d0) = v[j] * rstd * g; }
    }
#undef P10_LOAD
}

__global__ void __launch_bounds__(NWAVES * 64, 2) fwd(Args args) {
    extern __shared__ __attribute__((aligned(16))) unsigned char lds[];
    Frame F;
    F.lds = (LAS unsigned char*)lds;
    F.MISC = (volatile LAS unsigned*)(F.lds + MISC_OFF);
    F.tid = threadIdx.x; F.lane = F.tid & 63; F.wave = __builtin_amdgcn_readfirstlane(F.tid >> 6);
    F.G = gridDim.x; { const int bx = blockIdx.x; F.vcu = (F.G % 8 == 0) ? (bx % 8) * (F.G / 8) + bx / 8 : bx; }
    unsigned char* ws = args.ws;
    F.ctl = (gu32*)(ws + WS_CTL);
    for (int u = F.tid; u < (LDS_BYTES - LDSCTL_OFF) / 4; u += NWAVES * 64) ((LAS unsigned*)(F.lds + LDSCTL_OFF))[u] = 0u;
    __syncthreads();
    XcdBarrier bar = xcd_barrier_post((unsigned*)(F.ctl + CW_BAR) + args.li * XCD_BAR_WORDS, F.MISC + 8);
    const int lo = args.ph_lo, hi = args.ph_hi;
#define IN(k) (lo <= (k) && (k) < hi)
#define BOTH(k) (IN(k) && IN((k) + 1))
#define GRID_BAR() xcd_barrier(bar)

    if (IN(0)) { p0_prologue(F, args); if (BOTH(0)) GRID_BAR(); }
    if (IN(1)) { p1_xn(F, args); if (BOTH(1)) GRID_BAR(); }
    if (IN(2)) {
        __syncthreads();
        pg8::Gemm g{(const bf16*)(ws + WS_XN), (const bf16*)(ws + WS_WIN), 1024}; pg8::StaticOrder So; So.init(T, INW, F.G, (int)blockIdx.x);
        pg8::EpiInProj E{(bf16*)(ws + WS_QM), (bf16*)(ws + WS_GM), (float*)(ws + WS_KSUM), (const float*)(ws + WS_ROPE), T, S, C2};
        pg8::gemm_phase<pg8::EpiInProj, pg8::StaticOrder, true, true>(F.lds + RING_OFF, g, So, E);
        if (BOTH(2)) GRID_BAR();
    }
    if (IN(3)) {
        __syncthreads();
        const int bh = F.vcu >> 3, part = F.vcu & 7;
        LAS float* ksl = (LAS float*)(F.lds + RING_OFF);
        { const float* ks = (const float*)(ws + WS_KSUM);
          for (int i = F.tid; i < 32 * 64; i += NWAVES * 64) { const int j = i >> 6, d = i & 63; const size_t o = ((size_t)((bh >> 3) * 32 + j)) * 512 + (bh & 7) * 64 + d; ksl[i] = ks[o] + ks[128 * 512 + o]; } }
        __syncthreads();
#pragma unroll 1
        for (int hf = 0; hf < 2; ++hf) { const int cc = part * 8 + F.wave, chunk = hf ? 127 - cc : cc;
            gate_wave(bh >> 3, bh & 7, chunk, F.lane, (const bf16*)(ws + WS_QM), ksl, (unsigned*)(ws + WS_SEL), (unsigned*)(F.ctl + CW_QCNT), (unsigned short*)((char*)args.out + DO_QLIST)); }
        if (BOTH(3)) GRID_BAR();
    }
    if (IN(4)) {
        __syncthreads();
        const float lam = *(const float*)(ws + WS_LAM);
        float* o1scr = (float*)(ws + WS_XN) + (size_t)blockIdx.x * 65536;
        bf16* opart = (bf16*)args.out; float* mlp = (float*)((char*)args.out + DO_MLP); const unsigned short* qlist = (const unsigned short*)((char*)args.out + DO_QLIST);
        LAS int* pre = (LAS int*)(F.lds + ROWTAB_OFF); LAS int* tot = pre + 1040;
        if (F.tid < 32) { int run = 0; for (int j = 0; j < 32; ++j) { pre[F.tid * 32 + j] = run; run += ((int)__hip_atomic_load(F.ctl + CW_QCNT + F.tid * 32 + j, RLX_AGENT) + 511) >> 9; } tot[F.tid] = run; }
        __syncthreads();
        if (F.tid == 0) { int run = 0; for (int i = 0; i < 32; ++i) { const int c = tot[i]; tot[i] = run; run += c; } tot[32] = run; }
        __syncthreads();
        for (int e = F.tid; e < 1024; e += NWAVES * 64) pre[e] += tot[e >> 5];
        if (F.tid == 0) pre[1024] = tot[32];
        __syncthreads();
        const int nitems = pre[1024];
        { const int u = F.vcu, bh = u >> 4, s = u & 15;
#pragma unroll 1
          for (int kk = 0; kk < 2; ++kk) att::attn_unit<128, 1>(bh >> 2, bh & 3, (kk & 1) ? s : 31 - s, (const bf16*)(ws + WS_QD), (const bf16*)(ws + WS_KD), (const bf16*)(ws + WS_VD), (bf16*)(ws + WS_QD),
                                                                   nullptr, o1scr, lam, args.in[10], (char*)lds + RING_OFF); }
        __syncthreads();
        LAS int* claim = pre + 1100;
        if (F.tid == 0) claim[0] = (int)__hip_atomic_fetch_add(F.ctl + CW_ITEM, 1u, RLX_AGENT);
        __syncthreads();
        int I = claim[0], par = 0;
#pragma unroll 1
        while (I < nitems) {
            int nxt = 0; if (F.tid == 0) nxt = (int)__hip_atomic_fetch_add(F.ctl + CW_ITEM, 1u, RLX_AGENT);
            int lo_ = 0, hi_ = 1024;
            while (hi_ - lo_ > 1) { const int mid = (lo_ + hi_) >> 1; if (pre[mid] <= I) lo_ = mid; else hi_ = mid; }
            const int e = lo_, bh = e >> 5, j = e & 31, c = I - pre[e];
            const int cnt = (int)__hip_atomic_load(F.ctl + CW_QCNT + e, RLX_AGENT); int nv = cnt - 512 * c; nv = nv > 512 ? 512 : nv;
            att::moba_block_issue((const bf16*)(ws + WS_KM), (const bf16*)(ws + WS_VM), bh >> 3, bh & 7, j, (char*)lds + RING_OFF);
            const unsigned short* ql = qlist + (size_t)bh * QL_PER_BH + 256 * (31 * j - (j * (j - 1)) / 2) + 512 * c;
            if (F.wave * 32 >= nv) asm volatile("s_waitcnt vmcnt(0)\n\ts_barrier" ::: "memory");
#pragma unroll 1
            for (int g = F.wave; g * 32 < nv; g += NWAVES)
                att::attn_unit<64, 2, true>(bh >> 3, bh & 7, j, (const bf16*)(ws + WS_QM), (const bf16*)(ws + WS_KM), (const bf16*)(ws + WS_VM), nullptr, (const unsigned*)(ws + WS_SEL), nullptr, 0.f, nullptr,
                                            (char*)lds + RING_OFF, ql + g * 32, nv - g * 32 < 32 ? nv - g * 32 : 32, opart, mlp, g == F.wave);
            par ^= 1; if (F.tid == 0) claim[par] = nxt;
            __syncthreads();
            I = claim[par];
        }
        GRID_BAR();
#pragma unroll 1
        for (int k = 0; k < 4; ++k) { const int u = F.vcu * 4 + k, bh = u >> 5, qb = u & 31;
            att::moba_block_issue((const bf16*)(ws + WS_KM), (const bf16*)(ws + WS_VM), bh >> 3, bh & 7, qb, (char*)lds + RING_OFF);
            att::attn_unit<64, 3, true>(bh >> 3, bh & 7, qb, (const bf16*)(ws + WS_QM), (const bf16*)(ws + WS_KM), (const bf16*)(ws + WS_VM), (bf16*)(ws + WS_QM), (const unsigned*)(ws + WS_SEL), nullptr, 0.f, nullptr,
                                        (char*)lds + RING_OFF, nullptr, 0, opart, mlp, true); }
        __syncthreads();
        if (BOTH(4)) GRID_BAR();
    }
    if (IN(5)) {
        __syncthreads();
        pg8::StaticOrder So; So.init(T, 1024, F.G, (int)blockIdx.x);
        { pg8::Gemm g{(const bf16*)(ws + WS_QM), (const bf16*)(ws + WS_WPM), 512}; pg8::EpiGate<0> E{(const bf16*)(ws + WS_GM), (bf16*)(ws + WS_MERGED)};
          pg8::gemm_phase<pg8::EpiGate<0>, pg8::StaticOrder, true, true>(F.lds + RING_OFF, g, So, E); }
        __syncthreads();
        { pg8::Gemm g{(const bf16*)(ws + WS_QD), (const bf16*)(ws + WS_WPD), 512}; pg8::EpiGate<1> E{(const bf16*)(ws + WS_GD), (bf16*)(ws + WS_MERGED)};
          pg8::gemm_phase<pg8::EpiGate<1>, pg8::StaticOrder, true, true>(F.lds + RING_OFF, g, So, E); }
        if (BOTH(5)) GRID_BAR();
    }
    if (IN(6)) {
        __syncthreads();
        pg8::StaticOrder So; So.init(T, 1024, F.G, (int)blockIdx.x);
        pg8::Gemm g{(const bf16*)(ws + WS_MERGED), (const bf16*)(ws + WS_WOUT), 1024};
        pg8::EpiResid E{args.in[0], (const float*)(ws + WS_MOD) + 2048, args.out, (float*)(ws + WS_ROWSQ), S};
        pg8::gemm_phase<pg8::EpiResid, pg8::StaticOrder, true, true>(F.lds + RING_OFF, g, So, E);
        if (BOTH(6)) GRID_BAR();
    }
    if (IN(7)) { __syncthreads(); p7_router(F, args); if (BOTH(7)) GRID_BAR(); }
    if (IN(8)) {
        __syncthreads(); moe_tables(F, args);
        const LAS int* tbl = (const LAS int*)(F.lds + TBL_OFF); LAS int* rowtab = (LAS int*)(F.lds + ROWTAB_OFF);
        pg8::MoeOrder Mo{tbl, rowtab, tbl[32], 4, F.G, (int)blockIdx.x, 1024, true};
        { pg8::Unit u; const int* list = (const int*)(ws + WS_LIST);
          for (int ui = 0; ui < 8 && Mo.next(ui, u); ++ui)
              for (int r = F.tid; r < 256; r += NWAVES * 64) { const int rr = r < u.cnt ? r : u.cnt - 1; rowtab[ui * 256 + r] = list[(size_t)u.e * T + u.lo + rr] >> 1; } }
        __syncthreads();
        pg8::Gemm g{(const bf16*)(ws + WS_XN), (const bf16*)(ws + WS_WGU), 1024};
        pg8::EpiMoeHid E{(bf16*)(ws + WS_HID)};
        pg8::gemm_phase<pg8::EpiMoeHid, pg8::MoeOrder, true, true>(F.lds + RING_OFF, g, Mo, E);
        if (BOTH(8)) GRID_BAR();
    }
    if (IN(9)) {
        __syncthreads(); moe_tables(F, args);
        const LAS int* tbl = (const LAS int*)(F.lds + TBL_OFF);
        pg8::MoeOrder Mo{tbl, nullptr, tbl[32], 4, F.G, (int)blockIdx.x, 1024, false};
        pg8::Gemm g{(const bf16*)(ws + WS_HID), (const bf16*)(ws + WS_WD), 512};
        pg8::EpiMoeDown E{(bf16*)(ws + WS_YB), (const int*)(ws + WS_LIST), (const float*)(ws + WS_TOKW), T};
        pg8::gemm_phase<pg8::EpiMoeDown, pg8::MoeOrder, true, true>(F.lds + RING_OFF, g, Mo, E);
        if (BOTH(9)) GRID_BAR();
    }
    if (IN(10)) { __syncthreads(); moe_tables(F, args); p10_final(F, args); }
#undef IN
#undef BOTH
}
}


extern "C" void kernel_launch(void* const* d_in, const int* in_sizes, int n_in, void* d_out, int out_size, void* d_ws, size_t ws_size, hipStream_t stream) {
    char* ws = (char*)d_ws; float* out = (float*)d_out;
    static int grid = 0;
    if (grid == 0) {
        int dev = 0, cus = 0, per_cu = 0;
        if (hipGetDevice(&dev) != hipSuccess || hipDeviceGetAttribute(&cus, hipDeviceAttributeMultiprocessorCount, dev) != hipSuccess) { fprintf(stderr, "kernel_launch: device query failed\n"); grid = -1; return; }
        if (hipFuncSetAttribute((const void*)fwd, hipFuncAttributeMaxDynamicSharedMemorySize, LDS_BYTES) != hipSuccess) { fprintf(stderr, "kernel_launch: hipFuncSetAttribute failed\n"); grid = -1; return; }
        if (hipOccupancyMaxActiveBlocksPerMultiprocessor(&per_cu, (const void*)fwd, NWAVES * 64, LDS_BYTES) != hipSuccess || per_cu < 1) fprintf(stderr, "kernel_launch: occupancy query reports %d\n", per_cu);
        (void)hipGetLastError();
        grid = cus < 256 ? cus : 256;
        if (ws_size < 512 * MiB || n_in != 23 || out_size != T * D) { fprintf(stderr, "kernel_launch: built for 23 inputs, %d outputs and >= 512 MiB of workspace\n", T * D); grid = -1; return; }
    }
    if (grid < 0) return;
    (void)hipMemsetAsync(ws + WS_CTL, 0, 64 * 1024, stream);
    Args a{};
    for (int i = 0; i < 23; ++i) a.in[i] = (const float*)d_in[i];
    a.out = out; a.ws = (unsigned char*)d_ws;
    a.ph_lo = 0; a.ph_hi = 11; a.li = 0; a.pad = 0;
    hipLaunchKernelGGL(fwd, dim3(grid), dim3(NWAVES * 64), LDS_BYTES, stream, a);
}
```

```cpp
#include <hip/hip_runtime.h>
#include <cstdint>
#include <cstdio>

namespace {

constexpr int NB = 4, S = 8192, D = 1024, T = NB * S;
constexpr int INW = 5120;
constexpr float EPS = 1e-6f;
constexpr float C2 = 0.125f * 1.4426950408889634f;
constexpr size_t MiB = 1ull << 20;
constexpr size_t WS_CTL = 0;
constexpr size_t WS_MOD = 1 * MiB;
constexpr size_t WS_LAM = 1 * MiB + 128 * 1024;
constexpr size_t WS_OFF = 1 * MiB + 132 * 1024;
constexpr size_t WS_KSUM = 1 * MiB + 256 * 1024;
constexpr size_t WS_MODP = 2 * MiB;
constexpr size_t WS_WR = 3 * MiB;
constexpr size_t WS_ROPE = 4 * MiB;
constexpr size_t WS_WIN = 6 * MiB;
constexpr size_t WS_WPM = 16 * MiB, WS_WPD = 17 * MiB, WS_WOUT = 18 * MiB;
constexpr size_t WS_WGU = 20 * MiB;
constexpr size_t WS_WD = 84 * MiB;
constexpr size_t WS_XN = 116 * MiB;
constexpr size_t WS_QM = 180 * MiB, WS_KM = 212 * MiB, WS_VM = 244 * MiB, WS_QD = 276 * MiB, WS_KD = 308 * MiB, WS_VD = 340 * MiB;
constexpr size_t WS_GM = 372 * MiB, WS_GD = 436 * MiB;
constexpr size_t WS_LIST = 500 * MiB;
constexpr size_t WS_TOKI = 504 * MiB;
constexpr size_t WS_TOKW = 504 * MiB + 256 * 1024;
constexpr size_t WS_SEL = 505 * MiB;
constexpr size_t WS_ROWSQ = 506 * MiB;
constexpr size_t WS_MERGED = 212 * MiB;
constexpr size_t WS_HID = 372 * MiB;
constexpr size_t WS_YB = 180 * MiB;
constexpr int CW_QCNT = 8192;
constexpr size_t DO_MLP = 96 * MiB, DO_QLIST = 104 * MiB;
constexpr int QL_PER_BH = 126976;
constexpr int CW_ITEM = 2048;
constexpr int CW_CNT = 1024;


#define GAS __attribute__((address_space(1)))
#define LAS __attribute__((address_space(3)))
typedef unsigned short bf16;
typedef unsigned v4u __attribute__((ext_vector_type(4)));
typedef float f32x4 __attribute__((ext_vector_type(4)));
typedef short bf16x8 __attribute__((ext_vector_type(8)));
typedef GAS unsigned gu32;
typedef GAS unsigned long long gu64;
#define RLX_AGENT __ATOMIC_RELAXED, __HIP_MEMORY_SCOPE_AGENT
#define LDS_WAIT() asm volatile("s_waitcnt lgkmcnt(0)" ::: "memory")
#define VM_WAIT() asm volatile("s_waitcnt vmcnt(0)" ::: "memory")
__device__ __forceinline__ unsigned f2bf(float f) { unsigned u = __builtin_bit_cast(unsigned, f); return (u + 0x7fffu + ((u >> 16) & 1u)) >> 16; }
__device__ __forceinline__ unsigned pk2(float lo, float hi) { return f2bf(lo) | (f2bf(hi) << 16); }
__device__ __forceinline__ float bf2f(bf16 v) { return __uint_as_float((unsigned)v << 16); }
#define XB_TMO      128
#define XB_XCNT(j)  (256  + 64 * (j))
#define XB_XSUB(j)  (1280 + 64 * (j))
#define XB_XGEN(j)  (2304 + 64 * (j))
#define XB_TOP      3328
#define XB_TOPGEN   3392
#define XCD_BAR_WORDS 3456
#define XB_SPIN_CAP (1u << 18)

__device__ __forceinline__ unsigned xb_ld(unsigned* p)              { return __hip_atomic_load(p, __ATOMIC_RELAXED, __HIP_MEMORY_SCOPE_AGENT); }
__device__ __forceinline__ unsigned xb_add(unsigned* p, unsigned v) { return __hip_atomic_fetch_add(p, v, __ATOMIC_RELAXED, __HIP_MEMORY_SCOPE_AGENT); }
__device__ __forceinline__ unsigned xb_xcc_id() { return (unsigned)__builtin_amdgcn_s_getreg((3 << 11) | 20) & 0xFu; }
#define XB_SPIN(cond, bar) do { unsigned _sp = 0; while (cond) { __builtin_amdgcn_s_sleep(1); \
    if ((++_sp & 255u) == 0u) { if (xb_ld(&(bar)[XB_TMO])) break; if (_sp > XB_SPIN_CAP) { atomicAdd(&(bar)[XB_TMO], 1u); break; } } } } while (0)

struct XcdBarrier {
    unsigned* bar; unsigned x;
    volatile LAS unsigned* st;
};

__device__ __forceinline__ XcdBarrier xcd_barrier_post(unsigned* bar, volatile LAS unsigned* st) {
    XcdBarrier b; b.bar = bar; b.x = xb_xcc_id(); b.st = st;
    if (threadIdx.x == 0) (void)xb_add(&bar[XB_XCNT(b.x)], 1u);
    return b;
}
__device__ __forceinline__ void xcd_barrier_complete(unsigned* bar, unsigned x, unsigned& nloc, unsigned& nx) {
    const unsigned G = gridDim.x * gridDim.y * gridDim.z;
    unsigned sum, cnt, mine, sp = 0u;
    for (;;) {
        sum = 0u; cnt = 0u; mine = 0u;
#pragma unroll
        for (unsigned j = 0; j < 16; ++j) { const unsigned c = xb_ld(&bar[XB_XCNT(j)]); sum += c; cnt += (c > 0u) ? 1u : 0u; mine = (j == x) ? c : mine; }
        if (sum == G) break;
        __builtin_amdgcn_s_sleep(1);
        if ((++sp & 255u) == 0u) { if (xb_ld(&bar[XB_TMO])) break; if (sp > XB_SPIN_CAP) { atomicAdd(&bar[XB_TMO], 1u); break; } }
    }
    nloc = mine > 0u ? mine : 1u; nx = cnt > 0u ? cnt : 1u;
}

__device__ __forceinline__ void xcd_barrier(const XcdBarrier& b) {
    asm volatile("s_waitcnt vmcnt(0)" ::: "memory");
    __syncthreads();
    if (threadIdx.x == 0) {
        unsigned* bar = b.bar;
        __builtin_amdgcn_s_waitcnt(0);
        unsigned nloc = b.st[0], nx = b.st[1];
        if (nloc == 0u) { xcd_barrier_complete(bar, b.x, nloc, nx); b.st[0] = nloc; b.st[1] = nx; }
        const unsigned old = xb_add(&bar[XB_XSUB(b.x)], 1u);
        const unsigned gen = old / nloc;
        if (old + 1u == (gen + 1u) * nloc) {
            __builtin_amdgcn_fence(__ATOMIC_RELEASE, "agent");
            asm volatile("s_waitcnt vmcnt(0)" ::: "memory");
            const unsigned og = xb_add(&bar[XB_TOP], 1u);
            const unsigned tg = og / nx;
            if (og + 1u == (tg + 1u) * nx) xb_add(&bar[XB_TOPGEN], 1u);
            else XB_SPIN(xb_ld(&bar[XB_TOPGEN]) == tg, bar);
            __builtin_amdgcn_fence(__ATOMIC_ACQUIRE, "agent");
            xb_add(&bar[XB_XGEN(b.x)], 1u);
            asm volatile("s_waitcnt vmcnt(0)" ::: "memory");
        } else {
            XB_SPIN(xb_ld(&bar[XB_XGEN(b.x)]) == gen, bar);
            __builtin_amdgcn_fence(__ATOMIC_ACQUIRE, "agent");
            asm volatile("s_waitcnt vmcnt(0)" ::: "memory");
        }
    }
    __syncthreads();
}


namespace pg8 {
#define PG8_LAS __attribute__((address_space(3)))
typedef unsigned short bf16_t;
typedef short bf16x8 __attribute__((ext_vector_type(8)));
typedef float f32x4 __attribute__((ext_vector_type(4)));
typedef unsigned u32x4 __attribute__((ext_vector_type(4)));
constexpr int BM = 256, BK = 64, HALF = 128, HTB = HALF * BK * 2  , STAGE_BYTES = 8 * HTB, NXCD = 8, WGM = 8;

__host__ __device__ __forceinline__ int lds_byte(int r, int c) { const int st = (r >> 4) * 2 + (c >> 5), rr = r & 15, cc = c & 31, ob = rr * 64 + cc * 2; return st * 1024 + (ob ^ (((ob >> 9) & 1) << 5)); }
__host__ __device__ __forceinline__ void stage_rc(int b, int& R, int& C) { const int st = b / 1024, sb = b % 1024, swz = sb ^ (((sb >> 9) & 1) << 5); R = (st >> 1) * 16 + swz / 64; C = (st & 1) * 32 + (swz % 64) / 2; }
__host__ __device__ __forceinline__ int perm32(int rho) { const int n = rho >> 4, i = rho & 15; return 8 * (i >> 2) + 4 * n + (i & 3); }

struct Unit { int pm, pn, e, lo, cnt, ui; };
struct Gemm { const bf16_t* A; const bf16_t* Bt; int K; };

struct StaticOrder {
    int nM, nN, nwg, G, c;
    __host__ __device__ void init(int M, int N, int G_, int c_) { nM = M / BM; nN = N / BM; nwg = nM * nN; G = G_; c = c_; }
    __host__ __device__ bool next(int i, Unit& u) const {
        const long L = (long)i * G + c; if (L >= nwg) return false;
        int wgid = (int)L; { const int q = nwg / NXCD, r = nwg % NXCD, xcd = wgid % NXCD, off = wgid / NXCD; wgid = (xcd < r ? xcd * (q + 1) : r * (q + 1) + (xcd - r) * q) + off; }
        const int nig = WGM * nN, gid = wgid / nig, fm = gid * WGM, gsz = (nM - fm) < WGM ? (nM - fm) : WGM;
        u.pm = fm + ((wgid % nig) % gsz); u.pn = (wgid % nig) / gsz; u.e = 0; u.lo = 0; u.cnt = BM; u.ui = i; return true;
    }
    __device__ __forceinline__ int arow(int, const Unit& u, int r) const { return u.pm * BM + r; }
    __device__ __forceinline__ int brow(const Unit& u) const { return u.pn * BM; }
    __device__ __forceinline__ void a_ready(const Unit&) const {}
    __device__ __forceinline__ void done(const Unit&) const {}
};
typedef float f32x2_t __attribute__((ext_vector_type(2))); typedef __bf16 bf16x2_t __attribute__((ext_vector_type(2)));
__device__ __forceinline__ unsigned cvt_pk_bf16(float lo, float hi) { f32x2_t v = {lo, hi}; bf16x2_t b = __builtin_convertvector(v, bf16x2_t); return __builtin_bit_cast(unsigned, b); }
struct MoeOrder {
    const PG8_LAS int* tbl; const PG8_LAS int* rowtab; int ntile, nN, G, c, Nexp; bool gather;
    __device__ __forceinline__ bool next(int i, Unit& u) const {
        const int L = i * G + c; if (L >= ntile * nN) return false;
        const int mt = L / nN; int e = 0;
        while (tbl[e + 1] <= mt) ++e;
        u.pm = mt; u.pn = L - mt * nN; u.e = e; u.lo = (mt - tbl[e]) * BM; u.cnt = tbl[40 + e] - u.lo; u.ui = i; return true;
    }
    __device__ __forceinline__ int arow(int ui, const Unit& u, int r) const { return gather ? rowtab[ui * BM + r] : u.pm * BM + r; }
    __device__ __forceinline__ int brow(const Unit& u) const { return u.e * Nexp + u.pn * BM; }
    __device__ __forceinline__ void a_ready(const Unit&) const {}
    __device__ __forceinline__ void done(const Unit&) const {}
};
__device__ __forceinline__ float fast_sigmoid(float v) { return __builtin_amdgcn_rcpf(1.f + __builtin_amdgcn_exp2f(-1.4426950408889634f * v)); }
__device__ __forceinline__ u32x4 pack8(const f32x4& a, const f32x4& b) { u32x4 w; w.x = cvt_pk_bf16(a[0], a[1]); w.y = cvt_pk_bf16(a[2], a[3]); w.z = cvt_pk_bf16(b[0], b[1]); w.w = cvt_pk_bf16(b[2], b[3]); return w; }
__device__ __forceinline__ f32x4 bflo(unsigned a, unsigned b) { return (f32x4){__uint_as_float(a << 16), __uint_as_float(a & 0xffff0000u), __uint_as_float(b << 16), __uint_as_float(b & 0xffff0000u)}; }

struct EpiInProj {
    static constexpr bool PERM = true, AFTER_DRAIN = false;
    bf16_t* qkv;
    bf16_t* gates;
    float* ksum;
    const float* tab;
    int Trows, Srows; float c2;
    __device__ __forceinline__ void operator()(const f32x4 (&acc)[2][2][4][2], const Unit& u, int wr, int wc, int fr, int fq) const {
        const int pn = u.pn; const int rw = u.pm * BM + wr * 64 + fr;
        if (pn >= 12) {
            bf16_t* base = gates + (size_t)((pn - 12) >> 2) * ((size_t)Trows * 1024) + ((pn - 12) & 3) * 256 + wc * 32 + 8 * fq;
#pragma unroll
            for (int ai = 0; ai < 2; ++ai)
#pragma unroll
                for (int m = 0; m < 4; ++m) { bf16_t* rowp = base + (size_t)(rw + ai * HALF + m * 16) * 1024;
#pragma unroll
                    for (int bj = 0; bj < 2; ++bj) { f32x4 v0 = acc[ai][bj][m][0], v1 = acc[ai][bj][m][1];
#pragma unroll
                        for (int j = 0; j < 4; ++j) { v0[j] = fast_sigmoid(v0[j]); v1[j] = fast_sigmoid(v1[j]); }
                        *(u32x4*)(rowp + bj * HALF) = pack8(v0, v1); } }
            return;
        }
        const int seg = pn >> 1, ts = pn & 1;
        bf16_t* base = qkv + (size_t)seg * ((size_t)Trows * 512);
        if (seg == 2 || seg == 5) {
            bf16_t* b2 = base + ts * 256 + wc * 32 + 8 * fq;
#pragma unroll
            for (int ai = 0; ai < 2; ++ai)
#pragma unroll
                for (int m = 0; m < 4; ++m) { bf16_t* rowp = b2 + (size_t)(rw + ai * HALF + m * 16) * 512;
#pragma unroll
                    for (int bj = 0; bj < 2; ++bj) *(u32x4*)(rowp + bj * HALF) = pack8(acc[ai][bj][m][0], acc[ai][bj][m][1]); }
            return;
        }
        const float sc = (seg == 0 || seg == 3) ? c2 : 1.f;
        const int colh = (ts * 4 + wc) * 64 + 8 * fq;
        f32x4 ks[2][2];
#pragma unroll
        for (int a = 0; a < 2; ++a)
#pragma unroll
            for (int n = 0; n < 2; ++n) ks[a][n] = (f32x4){0.f, 0.f, 0.f, 0.f};
#pragma unroll
        for (int ai = 0; ai < 2; ++ai)
#pragma unroll
            for (int m = 0; m < 4; ++m) {
                const int r = rw + ai * HALF + m * 16, pos = r & (Srows - 1);
                const f32x4* tp = (const f32x4*)(tab + (size_t)pos * 64 + 16 * fq);
                const f32x4 t0 = tp[0], t1 = tp[1], t2 = tp[2], t3 = tp[3];
                f32x4 olo[2], ohi[2];
#pragma unroll
                for (int n = 0; n < 2; ++n) {
                    const f32x4 ta = n ? t2 : t0, tb = n ? t3 : t1;
                    const f32x4 cs = (f32x4){ta[0], ta[2], tb[0], tb[2]}, sn = (f32x4){ta[1], ta[3], tb[1], tb[3]};
                    const f32x4 lo = acc[ai][0][m][n], hi = acc[ai][1][m][n];
                    olo[n] = lo * cs - hi * sn; ohi[n] = hi * cs + lo * sn;
                }
                if (seg == 1) { ks[0][0] += olo[0]; ks[0][1] += olo[1]; ks[1][0] += ohi[0]; ks[1][1] += ohi[1]; }
                bf16_t* rowp = base + (size_t)r * 512 + colh;
                *(u32x4*)(rowp) = pack8(olo[0] * sc, olo[1] * sc); *(u32x4*)(rowp + 32) = pack8(ohi[0] * sc, ohi[1] * sc);
            }
        if (seg == 1) {
#pragma unroll
            for (int a = 0; a < 2; ++a)
#pragma unroll
                for (int n = 0; n < 2; ++n)
#pragma unroll
                    for (int j = 0; j < 4; ++j) { float v = ks[a][n][j]; v += __shfl_xor(v, 1); v += __shfl_xor(v, 2); v += __shfl_xor(v, 4); v += __shfl_xor(v, 8); ks[a][n][j] = v; }
            if (fr == 0) { float* kp = ksum + ((size_t)(wr * 128 + u.pm)) * 512 + colh; *(f32x4*)(kp) = ks[0][0]; *(f32x4*)(kp + 4) = ks[0][1]; *(f32x4*)(kp + 32) = ks[1][0]; *(f32x4*)(kp + 36) = ks[1][1]; }
        }
    }
};
template <int PASS> struct EpiGate {
    static constexpr bool PERM = true, AFTER_DRAIN = false;
    const bf16_t* G; bf16_t* out;
    __device__ __forceinline__ void operator()(const f32x4 (&acc)[2][2][4][2], const Unit& u, int wr, int wc, int fr, int fq) const {
        const int rw = u.pm * BM + wr * 64 + fr, col0 = u.pn * BM + wc * 32 + 8 * fq;
#pragma unroll
        for (int ai = 0; ai < 2; ++ai) {
            u32x4 g[4][2], p[4][2];
#pragma unroll
            for (int m = 0; m < 4; ++m)
#pragma unroll
                for (int bj = 0; bj < 2; ++bj) { const size_t off = (size_t)(rw + ai * HALF + m * 16) * 1024 + col0 + bj * HALF;
                    g[m][bj] = *(const u32x4*)(G + off); if (PASS == 1) p[m][bj] = __builtin_nontemporal_load((const u32x4*)(out + off)); }
#pragma unroll
            for (int m = 0; m < 4; ++m)
#pragma unroll
                for (int bj = 0; bj < 2; ++bj) { const size_t off = (size_t)(rw + ai * HALF + m * 16) * 1024 + col0 + bj * HALF;
                    f32x4 v0 = acc[ai][bj][m][0] * bflo(g[m][bj].x, g[m][bj].y), v1 = acc[ai][bj][m][1] * bflo(g[m][bj].z, g[m][bj].w);
                    if (PASS == 1) { v0 += bflo(p[m][bj].x, p[m][bj].y); v1 += bflo(p[m][bj].z, p[m][bj].w); }
                    *(u32x4*)(out + off) = pack8(v0, v1); }
        }
    }
};
struct EpiResid {
    static constexpr bool PERM = true, AFTER_DRAIN = false;
    const float* x; const float* g1; float* x1; float* rowsq; int Srows;
    __device__ __forceinline__ void operator()(const f32x4 (&acc)[2][2][4][2], const Unit& u, int wr, int wc, int fr, int fq) const {
        const int rw = u.pm * BM + wr * 64 + fr, col0 = u.pn * BM + wc * 32 + 8 * fq, b = (u.pm * BM) / Srows;
        f32x4 gv[2][2];
#pragma unroll
        for (int bj = 0; bj < 2; ++bj)
#pragma unroll
            for (int n = 0; n < 2; ++n) gv[bj][n] = *(const f32x4*)(g1 + (size_t)b * 6144 + col0 + bj * HALF + n * 4);
#pragma unroll
        for (int ai = 0; ai < 2; ++ai) {
            f32x4 xv[4][2][2];
#pragma unroll
            for (int m = 0; m < 4; ++m) { const size_t off = (size_t)(rw + ai * HALF + m * 16) * 1024 + col0;
#pragma unroll
                for (int bj = 0; bj < 2; ++bj)
#pragma unroll
                    for (int n = 0; n < 2; ++n) xv[m][bj][n] = *(const f32x4*)(x + off + bj * HALF + n * 4); }
#pragma unroll
            for (int m = 0; m < 4; ++m) { const int r = rw + ai * HALF + m * 16; const size_t off = (size_t)r * 1024 + col0; float s = 0.f;
#pragma unroll
                for (int bj = 0; bj < 2; ++bj)
#pragma unroll
                    for (int n = 0; n < 2; ++n) { const f32x4 o = xv[m][bj][n] + gv[bj][n] * acc[ai][bj][m][n];
                        *(f32x4*)(x1 + off + bj * HALF + n * 4) = o; s += (o[0] * o[0] + o[1] * o[1]) + (o[2] * o[2] + o[3] * o[3]); }
                s += __shfl_xor(s, 16); s += __shfl_xor(s, 32);
                if (fq == 0) rowsq[(size_t)r * 16 + u.pn * 4 + wc] = s; }
        }
    }
};
struct EpiMoeHid {
    static constexpr bool PERM = true, AFTER_DRAIN = false;
    bf16_t* hid;
    __device__ __forceinline__ void operator()(const f32x4 (&acc)[2][2][4][2], const Unit& u, int wr, int wc, int fr, int fq) const {
        const int rw = u.pm * BM + wr * 64 + fr, col0 = u.pn * 128 + wc * 32 + 8 * fq;
#pragma unroll
        for (int ai = 0; ai < 2; ++ai)
#pragma unroll
            for (int m = 0; m < 4; ++m) { f32x4 h[2];
#pragma unroll
                for (int n = 0; n < 2; ++n) { const f32x4 g = acc[ai][0][m][n], up = acc[ai][1][m][n];
#pragma unroll
                    for (int j = 0; j < 4; ++j) h[n][j] = g[j] * fast_sigmoid(g[j]) * up[j]; }
                *(u32x4*)(hid + (size_t)(rw + ai * HALF + m * 16) * 512 + col0) = pack8(h[0], h[1]); }
    }
};
struct EpiMoeDown {
    static constexpr bool PERM = true, AFTER_DRAIN = false;
    bf16_t* Yb; const PG8_LAS float* wtab;
    __device__ __forceinline__ void operator()(const f32x4 (&acc)[2][2][4][2], const Unit& u, int wr, int wc, int fr, int fq) const {
        const int rl = wr * 64 + fr, col0 = u.pn * BM + wc * 32 + 8 * fq;
        float w[2][4];
#pragma unroll
        for (int ai = 0; ai < 2; ++ai)
#pragma unroll
            for (int m = 0; m < 4; ++m) w[ai][m] = wtab[u.ui * BM + rl + ai * HALF + m * 16];
#pragma unroll
        for (int ai = 0; ai < 2; ++ai)
#pragma unroll
            for (int m = 0; m < 4; ++m) { const int rr = rl + ai * HALF + m * 16;
                bf16_t* rowp = Yb + (size_t)(u.pm * BM + rr) * 1024 + col0;
#pragma unroll
                for (int bj = 0; bj < 2; ++bj) *(u32x4*)(rowp + bj * HALF) = pack8(acc[ai][bj][m][0] * w[ai][m], acc[ai][bj][m][1] * w[ai][m]); }
    }
};

template <class Epi, class Sched, bool ALIGN_EPI = false, bool SP2 = false>
__device__ __forceinline__ void gemm_phase(PG8_LAS unsigned char* lds, const Gemm g, const Sched& S, const Epi& E) {
    const int tid = threadIdx.x, wid = __builtin_amdgcn_readfirstlane(tid >> 6), lane = tid & 63, wr = wid >> 2, wc = wid & 3, fr = lane & 15, fq = lane >> 4;
    const int K = g.K, nt = K / BK;
    unsigned voffB[2], CA2[2]; int RA[2];
#pragma unroll
    for (int i = 0; i < 2; ++i) { int R, C; stage_rc(tid * 16 + i * 8192, R, C); const int Rb = Epi::PERM ? ((R & ~31) + perm32(R & 31)) : R;
        RA[i] = R; CA2[i] = (unsigned)C * 2u; voffB[i] = (unsigned)(Rb * K + C) * 2u; }
    const unsigned K2 = (unsigned)K * 2u;
    const size_t kstep = (size_t)(BK * 2);
    const size_t hstep = (size_t)HALF * K * 2;
    const unsigned ldsw = (unsigned)wid * 1024u;
    const int aoff = lds_byte(wr * 64 + fr, fq * 8), boff = lds_byte(wc * 32 + fr, fq * 8);
#define PG8_SA(b, h) (((b) * 2 + (h)) * HTB)
#define PG8_SB(b, h) ((4 + (b) * 2 + (h)) * HTB)
#define PG8_STAGE(bufoff, gbase, voff) do { _Pragma("unroll") for (int _i = 0; _i < 2; ++_i) \
        __builtin_amdgcn_global_load_lds((const unsigned*)((const char*)(gbase) + (voff)[_i]), (PG8_LAS unsigned*)(lds + (bufoff) + ldsw + _i * 8192), 16, 0, 0); } while (0)
#define PG8_LDA(dst, b, h) do { _Pragma("unroll") for (int m = 0; m < 4; ++m) _Pragma("unroll") for (int k = 0; k < 2; ++k) dst[m][k] = *(const PG8_LAS bf16x8*)(lds + PG8_SA(b, h) + aoff + m * 2048 + k * 1024); } while (0)
#define PG8_LDB(dst, b, h) do { _Pragma("unroll") for (int n = 0; n < 2; ++n) _Pragma("unroll") for (int k = 0; k < 2; ++k) dst[n][k] = *(const PG8_LAS bf16x8*)(lds + PG8_SB(b, h) + boff + n * 2048 + k * 1024); } while (0)
#define PG8_MMA(ai, bj, At, Bt) do { __builtin_amdgcn_s_setprio(1); _Pragma("unroll") for (int m = 0; m < 4; ++m) _Pragma("unroll") for (int n = 0; n < 2; ++n) _Pragma("unroll") for (int k = 0; k < 2; ++k) \
        acc[ai][bj][m][n] = __builtin_amdgcn_mfma_f32_16x16x32_bf16(Bt[n][k], At[m][k], acc[ai][bj][m][n], 0, 0, 0); __builtin_amdgcn_s_setprio(0); } while (0)
#define PG8_WAIT_V(n) asm volatile("s_waitcnt vmcnt(" #n ")" ::: "memory")
#define PG8_WAIT_L(n) asm volatile("s_waitcnt lgkmcnt(" #n ")" ::: "memory")
#define PG8_BAR __builtin_amdgcn_s_barrier()
#define PG8_SCHED __builtin_amdgcn_sched_barrier(0)
    Unit cur, nxt; int ui = 0;
    if (!S.next(0, cur)) return;
    f32x4 acc[2][2][4][2];
#pragma unroll
    for (int a = 0; a < 2; ++a)
#pragma unroll
        for (int b = 0; b < 2; ++b)
#pragma unroll
            for (int m = 0; m < 4; ++m)
#pragma unroll
                for (int n = 0; n < 2; ++n) acc[a][b][m][n] = (f32x4){0.f, 0.f, 0.f, 0.f};
    bf16x8 At[4][2], B0[2][2], B1[2][2];
    unsigned vA0[2], vA1[2], nA0[2], nA1[2];
#pragma unroll
    for (int i = 0; i < 2; ++i) { vA0[i] = (unsigned)S.arow(0, cur, RA[i]) * K2 + CA2[i]; vA1[i] = (unsigned)S.arow(0, cur, HALF + RA[i]) * K2 + CA2[i]; }
    const char* const gA = (const char*)g.A; const char* cB = (const char*)g.Bt + (size_t)S.brow(cur) * K2;
    S.a_ready(cur);
    if constexpr (SP2) {
        PG8_STAGE(PG8_SB(0, 0), cB, voffB); PG8_STAGE(PG8_SB(0, 1), cB + hstep, voffB); PG8_STAGE(PG8_SA(0, 0), gA, vA0); PG8_STAGE(PG8_SA(0, 1), gA, vA1);
        if (wr == 1) PG8_BAR;
        PG8_WAIT_V(2); PG8_BAR;
        PG8_STAGE(PG8_SB(1, 0), cB + kstep, voffB); PG8_STAGE(PG8_SA(1, 0), gA + kstep, vA0); PG8_STAGE(PG8_SB(1, 1), cB + hstep + kstep, voffB);
        PG8_WAIT_V(6); PG8_BAR;
    } else {
        PG8_STAGE(PG8_SB(0, 0), cB, voffB); PG8_STAGE(PG8_SA(0, 0), gA, vA0); PG8_STAGE(PG8_SB(0, 1), cB + hstep, voffB); PG8_STAGE(PG8_SA(0, 1), gA, vA1);
        if (wr == 1) PG8_BAR;
        PG8_WAIT_V(4); PG8_BAR;
        PG8_STAGE(PG8_SB(1, 0), cB + kstep, voffB); PG8_STAGE(PG8_SA(1, 0), gA + kstep, vA0); PG8_STAGE(PG8_SB(1, 1), cB + hstep + kstep, voffB);
        PG8_WAIT_V(6); PG8_BAR;
    }
    for (;;) {
        const bool has_next = S.next(ui + 1, nxt);
#pragma unroll
        for (int i = 0; i < 2; ++i) { nA0[i] = has_next ? (unsigned)S.arow(ui + 1, nxt, RA[i]) * K2 + CA2[i] : vA0[i]; nA1[i] = has_next ? (unsigned)S.arow(ui + 1, nxt, HALF + RA[i]) * K2 + CA2[i] : vA1[i]; }
        const char* nB = has_next ? (const char*)g.Bt + (size_t)S.brow(nxt) * K2 : cB;
        for (int t = 0; t < nt; t += 2) {
            const bool last = (t == nt - 2);
            const char* a1 = gA + (size_t)(t + 1) * kstep;
            const char* a2 = last ? gA : gA + (size_t)(t + 2) * kstep; const unsigned x0[2] = {last ? nA0[0] : vA0[0], last ? nA0[1] : vA0[1]}, x1[2] = {last ? nA1[0] : vA1[0], last ? nA1[1] : vA1[1]}; const char* b2 = last ? nB : cB + (size_t)(t + 2) * kstep;
            const char* a3 = a2 + kstep; const char* b3 = b2 + kstep;
            if (last && has_next) S.a_ready(nxt);
            if constexpr (SP2) {
            PG8_LDB(B0, 0, 0); PG8_LDB(B1, 0, 1); PG8_SCHED; PG8_LDA(At, 0, 0); PG8_STAGE(PG8_SA(1, 1), a1, vA1);
            PG8_WAIT_V(8); PG8_WAIT_L(0); PG8_BAR; PG8_MMA(0, 0, At, B0); PG8_MMA(0, 1, At, B1); PG8_BAR; PG8_SCHED;
            PG8_LDA(At, 0, 1); PG8_STAGE(PG8_SB(0, 0), b2, voffB); PG8_STAGE(PG8_SB(0, 1), b2 + hstep, voffB); PG8_STAGE(PG8_SA(0, 0), a2, x0);
            PG8_WAIT_V(8); PG8_WAIT_L(0); PG8_BAR; PG8_MMA(1, 0, At, B0); PG8_MMA(1, 1, At, B1); PG8_BAR; PG8_SCHED;
            PG8_LDB(B0, 1, 0); PG8_LDB(B1, 1, 1); PG8_SCHED; PG8_LDA(At, 1, 0); PG8_STAGE(PG8_SA(0, 1), a2, x1);
            PG8_WAIT_V(8); PG8_WAIT_L(0); PG8_BAR; PG8_MMA(0, 0, At, B0); PG8_MMA(0, 1, At, B1); PG8_BAR; PG8_SCHED;
            PG8_LDA(At, 1, 1); PG8_STAGE(PG8_SB(1, 0), b3, voffB); PG8_STAGE(PG8_SB(1, 1), b3 + hstep, voffB); PG8_STAGE(PG8_SA(1, 0), a3, x0);
            PG8_WAIT_V(8); PG8_WAIT_L(0); PG8_BAR; PG8_MMA(1, 0, At, B0); PG8_MMA(1, 1, At, B1); PG8_BAR; PG8_SCHED;
            } else {
            PG8_LDB(B0, 0, 0); PG8_SCHED; PG8_LDA(At, 0, 0); PG8_STAGE(PG8_SA(1, 1), a1, vA1);
            PG8_WAIT_L(8); PG8_BAR; PG8_WAIT_L(0); PG8_MMA(0, 0, At, B0); PG8_BAR; PG8_SCHED;
            PG8_LDB(B1, 0, 1); PG8_STAGE(PG8_SB(0, 0), b2, voffB);
            PG8_BAR; PG8_WAIT_L(0); PG8_MMA(0, 1, At, B1); PG8_BAR;
            PG8_LDA(At, 0, 1); PG8_STAGE(PG8_SA(0, 0), a2, x0);
            PG8_BAR; PG8_WAIT_L(0); PG8_MMA(1, 0, At, B0); PG8_BAR; PG8_SCHED;
            PG8_STAGE(PG8_SB(0, 1), b2 + hstep, voffB);
            PG8_WAIT_V(6); PG8_BAR; PG8_MMA(1, 1, At, B1); PG8_BAR;
            PG8_LDB(B0, 1, 0); PG8_SCHED; PG8_LDA(At, 1, 0); PG8_STAGE(PG8_SA(0, 1), a2, x1);
            PG8_WAIT_L(8); PG8_BAR; PG8_WAIT_L(0); PG8_MMA(0, 0, At, B0); PG8_BAR; PG8_SCHED;
            PG8_LDB(B1, 1, 1); PG8_STAGE(PG8_SB(1, 0), b3, voffB);
            PG8_BAR; PG8_WAIT_L(0); PG8_MMA(0, 1, At, B1); PG8_BAR;
            PG8_LDA(At, 1, 1); PG8_STAGE(PG8_SA(1, 0), a3, x0);
            PG8_BAR; PG8_WAIT_L(0); PG8_MMA(1, 0, At, B0); PG8_BAR; PG8_SCHED;
            PG8_STAGE(PG8_SB(1, 1), b3 + hstep, voffB);
            PG8_WAIT_V(6); PG8_BAR; PG8_MMA(1, 1, At, B1); PG8_BAR;
            }
        }
        if constexpr (ALIGN_EPI) { if (wr == 0) PG8_BAR; }
        if constexpr (!Epi::AFTER_DRAIN) { E(acc, cur, wr, wc, fr, fq); S.done(cur); }
        if (!has_next) break;
#pragma unroll
        for (int a = 0; a < 2; ++a)
#pragma unroll
            for (int b = 0; b < 2; ++b)
#pragma unroll
                for (int m = 0; m < 4; ++m)
#pragma unroll
                    for (int n = 0; n < 2; ++n) acc[a][b][m][n] = (f32x4){0.f, 0.f, 0.f, 0.f};
        cur = nxt; cB = nB; ++ui;
#pragma unroll
        for (int i = 0; i < 2; ++i) { vA0[i] = nA0[i]; vA1[i] = nA1[i]; }
        if constexpr (ALIGN_EPI) { if (wr == 1) PG8_BAR; }
    }
    PG8_WAIT_V(0);
    if constexpr (!ALIGN_EPI) { if (wr == 0) PG8_BAR; }
    PG8_BAR;
    if constexpr (Epi::AFTER_DRAIN) { E.fused(acc, cur, wr, wc, fr, fq, lds, wid, lane); S.done(cur); }
#undef PG8_SA
#undef PG8_SB
#undef PG8_STAGE
#undef PG8_LDA
#undef PG8_LDB
#undef PG8_MMA
#undef PG8_WAIT_V
#undef PG8_WAIT_L
#undef PG8_BAR
#undef PG8_SCHED
}


}
namespace att {
typedef float f32x16 __attribute__((ext_vector_type(16)));
typedef short s16x4 __attribute__((ext_vector_type(4)));
typedef short v4i16_t __attribute__((ext_vector_type(4)));
typedef unsigned u32x4a __attribute__((ext_vector_type(4)));
constexpr int PITCH = 512;
constexpr int LDS_K = 0, LDS_V = 24576, LDS_WS = LDS_V + 4 * 16384, LDS_OST = LDS_WS + 2048, LDS_WT = LDS_OST + 8 * 4096, LDS_TOTAL = LDS_WT + 8 * 512, RES_V = 32768;
constexpr float THR = 5.0f;
__device__ __forceinline__ int crow(int r, int hi) { return (r & 3) + 8 * (r >> 2) + 4 * hi; }
__device__ __forceinline__ void glds16(const void* gsrc, unsigned lds_dst) { unsigned keep;
    asm volatile("s_mov_b32 %0, m0\n\ts_mov_b32 m0, %2\n\ts_nop 0\n\tglobal_load_lds_dwordx4 %1, off\n\ts_mov_b32 m0, %0" : "=&s"(keep) : "v"(gsrc), "s"(lds_dst) : "memory"); }
__device__ __forceinline__ f32x16 splat(float x) { f32x16 v;
#pragma unroll
    for (int r = 0; r < 16; ++r) v[r] = x;
    return v; }
typedef __attribute__((address_space(3))) const char* lds_cptr;
__device__ __forceinline__ s16x4 vtr(lds_cptr p) { return __builtin_bit_cast(s16x4, __builtin_amdgcn_ds_read_tr16_b64_v4i16((__attribute__((address_space(3))) v4i16_t*)p)); }
__device__ __forceinline__ float swapmax(float m) { auto rr = __builtin_amdgcn_permlane32_swap(__float_as_uint(m), __float_as_uint(m), false, false); return fmaxf(__uint_as_float(rr[0]), __uint_as_float(rr[1])); }
__device__ __forceinline__ float swapsum(float m) { auto rr = __builtin_amdgcn_permlane32_swap(__float_as_uint(m), __float_as_uint(m), false, false); return __uint_as_float(rr[0]) + __uint_as_float(rr[1]); }
__device__ __forceinline__ float max3a(float a, float b, float c) { float r; asm("v_max3_f32 %0, %1, %2, %3" : "=v"(r) : "v"(a), "v"(b), "v"(c)); return r; }
#define ATT_WAITBAR(N) asm volatile("s_waitcnt vmcnt(" #N ") lgkmcnt(0)\n\ts_barrier" ::: "memory")

template <int DV, int MODE, bool RES = false>
__device__ __forceinline__ void attn_unit(const int b, const int h, const int qb, const bf16* Qp, const bf16* __restrict__ Kp, const bf16* __restrict__ Vp, bf16* Op,
                                          const unsigned* __restrict__ sel, float* o1scr, const float lam, const float* __restrict__ subg, char* shm,
                                          const unsigned short* __restrict__ ql = nullptr, const int nvalid = 0, bf16* opart = nullptr, float* mlp = nullptr, const bool blk_sync = false) {
    constexpr bool MOBA = (MODE != 1);
    constexpr int ND = DV / 32;
    const int tid = threadIdx.x, lane = tid & 63, r32 = lane & 31, hi = lane >> 5;
    const int wid = __builtin_amdgcn_readfirstlane(tid >> 6);
    const long rowbase = (long)b * S; const int q0 = qb * 256;
    const unsigned lds0 = (unsigned)(uintptr_t)shm;
    float* wsf = (float*)(shm + LDS_WS) + wid * 64;
    const lds_cptr shm3 = (lds_cptr)shm;
    const int NT = (MODE == 3 && RES) ? (wid >> 1) + 1 : ((MODE >= 2) ? 4 : 4 * (qb + 1));
    const int wbase = (RES && MODE == 2) ? 0 : wid * 32;
    const int qrel = wbase + r32;
#pragma unroll 1
    for (int comp = 0; comp < (MOBA ? 1 : 2); ++comp) {
        const int qkcol = MOBA ? h * 64 : (2 * h + comp) * 64, vcol = MOBA ? h * 64 : h * 128;
        const bf16* Kh = Kp + rowbase * PITCH + qkcol; const bf16* Vh = Vp + rowbase * PITCH + vcol;
        const bf16* ksrc = Kh + (long)lane * PITCH + wid * 8;
        const bf16* vsrc = Vh + (long)(16 * (wid & 3) + (lane >> 2)) * PITCH + (wid >> 2) * 32 + (lane & 3) * 8;
        const unsigned kdst = lds0 + LDS_K + wid * 1024, vdst = lds0 + LDS_V + wid * 1024;
#define ATT_KR0(n) (MODE == 2 ? q0 + 64 * (n) : ((n) < 4 ? q0 + 64 * (n) : 64 * ((n) - 4)))
#define ATT_DMA(n, ks_, vs_) do { const long kr_ = ATT_KR0(n); glds16(ksrc + kr_ * PITCH, (unsigned)__builtin_amdgcn_readfirstlane(kdst + (ks_) * 8192)); \
        glds16(vsrc + kr_ * PITCH, (unsigned)__builtin_amdgcn_readfirstlane(vdst + (vs_) * 16384)); \
        if (DV == 128) glds16(vsrc + kr_ * PITCH + 64, (unsigned)__builtin_amdgcn_readfirstlane(vdst + (vs_) * 16384 + 8192)); } while (0)
        if (!RES) { ATT_DMA(0, 0, 0); ATT_DMA(1, 1, 1); }
        int qi = q0 + qrel;
        if (MODE == 2) qi = (int)ql[qrel < nvalid ? qrel : 0];
        const bf16* Qw = Qp + (rowbase + qi) * PITCH + qkcol;
        bf16x8 qr[4];
#pragma unroll
        for (int d0 = 0; d0 < 4; ++d0) qr[d0] = *reinterpret_cast<const bf16x8*>(&Qw[d0 * 16 + hi * 8]);
        unsigned smq3 = 0u; float2 ml3[3] = {make_float2(-INFINITY, 0.f), make_float2(-INFINITY, 0.f), make_float2(-INFINITY, 0.f)};
        if (MODE == 3 && lane < 32) { const size_t qx = (size_t)(b * 8 + h) * S + q0 + wid * 32 + lane; smq3 = sel[qx]; const int ns = __popc(smq3);
#pragma unroll
            for (int k = 0; k < 3; ++k) if (k < ns) ml3[k] = *(const float2*)(mlp + (qx * 3 + k) * 2); }
        if (RES && blk_sync) asm volatile("s_waitcnt vmcnt(0)\n\ts_barrier" ::: "memory");
        float mref = 0.f;
        f32x16 ol = splat(0.f);
        const bf16x8 ones = (bf16x8){0x3F80, 0x3F80, 0x3F80, 0x3F80, 0x3F80, 0x3F80, 0x3F80, 0x3F80};
        f32x16 o[ND];
#pragma unroll
        for (int d = 0; d < ND; ++d) o[d] = splat(0.f);
        int slot = 0, vslot = 0;
        u32x4a pw[4];
        constexpr int NPV = 4 * ND, NM = 4 + NPV;
        const int vlane = ((lane >> 4) & 1) * 32 + (lane & 3) * 8 + (4 * hi + ((lane & 15) >> 2)) * 64;
#define ATT_KLD(d0) do { kf[2 * (d0)] = *(const __attribute__((address_space(3))) bf16x8*)(kb + (d0) * 2048); kf[2 * (d0) + 1] = *(const __attribute__((address_space(3))) bf16x8*)(kb + (d0) * 2048 + 512); } while (0)
#define ATT_QK(P0, P1) do { const lds_cptr kb = shm3 + LDS_K + slot * 8192 + hi * 1024 + r32 * 16; bf16x8 kf[8]; \
        ATT_KLD(0); ATT_KLD(1); if (DV == 64) { ATT_KLD(2); ATT_KLD(3); } \
        const f32x16 cop = splat(-mref); __builtin_amdgcn_sched_barrier(0);   \
        P0 = __builtin_amdgcn_mfma_f32_32x32x16_bf16(kf[0], qr[0], cop, 0, 0, 0); P1 = __builtin_amdgcn_mfma_f32_32x32x16_bf16(kf[1], qr[0], cop, 0, 0, 0); \
        if (DV == 128) { ATT_KLD(2); ATT_KLD(3); __builtin_amdgcn_sched_barrier(0); } \
        _Pragma("unroll") for (int d0 = 1; d0 < 4; ++d0) { P0 = __builtin_amdgcn_mfma_f32_32x32x16_bf16(kf[2 * d0], qr[d0], P0, 0, 0, 0); P1 = __builtin_amdgcn_mfma_f32_32x32x16_bf16(kf[2 * d0 + 1], qr[d0], P1, 0, 0, 0); } } while (0)
#define ATT_MASK(P0, P1, n) do { if (MODE != 2 && (n) < 4 && (64 * (n) + 63 > wid * 32)) { const int kb0 = 64 * (n) + 4 * hi; \
        _Pragma("unroll") for (int r = 0; r < 16; ++r) { const int kv = kb0 + (r & 3) + 8 * (r >> 2); if (kv > qrel) P0[r] = -INFINITY; if (kv + 32 > qrel) P1[r] = -INFINITY; } } } while (0)
#define ATT_ROWMAX(P0, P1, RM) do { asm volatile("s_nop 15\n\ts_nop 7" : "+v"(P0), "+v"(P1)); \
        float a_ = max3a(P0[0], P0[1], P1[0]), b_ = max3a(P0[2], P0[3], P1[1]); a_ = max3a(a_, P1[2], P1[3]); \
        _Pragma("unroll") for (int r = 4; r < 16; r += 4) { a_ = max3a(a_, P0[r], P0[r + 1]); b_ = max3a(b_, P0[r + 2], P0[r + 3]); a_ = max3a(a_, P1[r], P1[r + 1]); b_ = max3a(b_, P1[r + 2], P1[r + 3]); } \
        RM = swapmax(fmaxf(a_, b_)); } while (0)
#define ATT_VOFF(j) (((j) >> 2) * 4096 + ((j) & 3) * 1024)
        { if (!RES) { if (DV == 128) ATT_WAITBAR(3); else ATT_WAITBAR(2); ATT_DMA(2, 2, 2); }
          f32x16 p0, p1; ATT_QK(p0, p1); ATT_MASK(p0, p1, 0);
          float rm; ATT_ROWMAX(p0, p1, rm); mref = rm;
#pragma unroll
          for (int r = 0; r < 16; ++r) { p0[r] = __builtin_amdgcn_exp2f(p0[r] - rm); p1[r] = __builtin_amdgcn_exp2f(p1[r] - rm); }
#pragma unroll
          for (int k = 0; k < 2; ++k)
#pragma unroll
              for (int j = 0; j < 4; ++j) { pw[k][j] = pg8::cvt_pk_bf16(p0[8 * k + 2 * j], p0[8 * k + 2 * j + 1]); pw[2 + k][j] = pg8::cvt_pk_bf16(p1[8 * k + 2 * j], p1[8 * k + 2 * j + 1]); }
          slot = 1; vslot = 1; }
#pragma unroll 1
        for (int n = 1; n < NT; ++n) {
            if (!RES) { if (n + 1 < NT) { if (DV == 128) ATT_WAITBAR(3); else ATT_WAITBAR(2); } else ATT_WAITBAR(0);
                if (n + 2 < NT) { const int s2 = slot + 2 >= 3 ? slot - 1 : slot + 2; ATT_DMA(n + 2, s2, (vslot + 2) & 3); } }
            f32x16 p0, p1; ATT_QK(p0, p1); ATT_MASK(p0, p1, n);
            float rm; ATT_ROWMAX(p0, p1, rm);
            bool resc = false; float fsc = 1.f;
            if (__any(rm > THR)) {
                const float dl = fmaxf(rm, 0.f); mref += dl; fsc = __builtin_amdgcn_exp2f(-dl); resc = true;
#pragma unroll
                for (int r = 0; r < 16; ++r) { p0[r] -= dl; p1[r] -= dl; } }
            { const lds_cptr vp = shm3 + (RES ? RES_V + ((vslot + 3) & 3) * 8192 : LDS_V + ((vslot + 3) & 3) * 16384) + vlane;
              s16x4 vlo[4], vhi[4]; u32x4a pwn[4];
#pragma unroll
              for (int j = 0; j < 4; ++j) { vlo[j] = vtr(vp + ATT_VOFF(j)); vhi[j] = vtr(vp + ATT_VOFF(j) + 512); }
              __builtin_amdgcn_sched_barrier(0);
#pragma unroll
              for (int g = 0; g < NM; ++g) {
                  if (g < 4) ol = __builtin_amdgcn_mfma_f32_32x32x16_bf16(__builtin_bit_cast(bf16x8, pw[g]), ones, ol, 0, 0, 0);
                  else { const int j = g - 4; const bf16x8 vf = (bf16x8){vlo[j & 3][0], vlo[j & 3][1], vlo[j & 3][2], vlo[j & 3][3], vhi[j & 3][0], vhi[j & 3][1], vhi[j & 3][2], vhi[j & 3][3]};
                      o[j >> 2] = __builtin_amdgcn_mfma_f32_32x32x16_bf16(__builtin_bit_cast(bf16x8, pw[j & 3]), vf, o[j >> 2], 0, 0, 0);
                      if (j + 4 < NPV) { vlo[j & 3] = vtr(vp + ATT_VOFF(j + 4)); vhi[j & 3] = vtr(vp + ATT_VOFF(j + 4) + 512); } }
                  const int npair = (DV == 128) ? (g < 16 ? 1 : 0) : (g < 4 ? 2 : 1);
                  const int pbase = (DV == 128) ? g : (g < 4 ? 2 * g : g + 4);
#pragma unroll
                  for (int q2 = 0; q2 < npair; ++q2) { const int pi = pbase + q2;
                      const float ea = __builtin_amdgcn_exp2f(pi < 8 ? p0[2 * pi] : p1[2 * pi - 16]), eb = __builtin_amdgcn_exp2f(pi < 8 ? p0[2 * pi + 1] : p1[2 * pi - 15]);
                      pwn[pi >> 2][pi & 3] = pg8::cvt_pk_bf16(ea, eb); }
                  __builtin_amdgcn_sched_barrier(0);
              }
#pragma unroll
              for (int k = 0; k < 4; ++k) pw[k] = pwn[k]; }
            if (resc) {
                if (hi == 0) wsf[r32] = fsc;
                asm volatile("s_waitcnt lgkmcnt(0)" ::: "memory");
#pragma unroll
                for (int r = 0; r < 16; ++r) { const float fr = wsf[crow(r, hi)]; ol[r] *= fr;
#pragma unroll
                    for (int d = 0; d < ND; ++d) o[d][r] *= fr; }
            }
            slot = RES ? slot + 1 : (slot == 2 ? 0 : slot + 1); vslot = (vslot + 1) & 3;
        }
        { const lds_cptr vp = shm3 + (RES ? RES_V + ((vslot + 3) & 3) * 8192 : LDS_V + ((vslot + 3) & 3) * 16384) + vlane;
#pragma unroll
          for (int ks = 0; ks < 4; ++ks) ol = __builtin_amdgcn_mfma_f32_32x32x16_bf16(__builtin_bit_cast(bf16x8, pw[ks]), ones, ol, 0, 0, 0);
#pragma unroll
          for (int j = 0; j < NPV; ++j) { const s16x4 vlo = vtr(vp + ATT_VOFF(j)), vhi = vtr(vp + ATT_VOFF(j) + 512);
              const bf16x8 vf = (bf16x8){vlo[0], vlo[1], vlo[2], vlo[3], vhi[0], vhi[1], vhi[2], vhi[3]};
              o[j >> 2] = __builtin_amdgcn_mfma_f32_32x32x16_bf16(__builtin_bit_cast(bf16x8, pw[j & 3]), vf, o[j >> 2], 0, 0, 0);
              if ((j & 7) == 7) __builtin_amdgcn_sched_barrier(0); } }
#undef ATT_QK
#undef ATT_KLD
#undef ATT_MASK
#undef ATT_ROWMAX
#undef ATT_VOFF
        int lane_e = lane, q0_e = q0 + wbase, h_e = h; asm volatile("" : "+v"(lane_e), "+v"(q0_e), "+v"(h_e));
        float rli[16];
#pragma unroll
        for (int r = 0; r < 16; ++r) rli[r] = __builtin_amdgcn_rcpf(ol[r]);
        bf16* stg = (bf16*)(shm + LDS_OST) + wid * 2048;
        if (MOBA) {
#pragma unroll
            for (int r = 0; r < 16; ++r) { const int orow = crow(r, hi);
#pragma unroll
                for (int d = 0; d < 2; ++d) stg[orow * 64 + d * 32 + (lane_e & 31)] = (bf16)f2bf(o[d][r] * rli[r]); }
            if (MODE == 0) {
                asm volatile("s_waitcnt lgkmcnt(0)" ::: "memory");
                bf16* Ow = Op + (rowbase + q0_e) * PITCH + h_e * 64;
#pragma unroll
                for (int i = 0; i < 4; ++i) { const int row = i * 8 + (lane_e >> 3), ch = lane_e & 7; const u32x4a v = *(const u32x4a*)(stg + row * 64 + ch * 8); *(u32x4a*)(Ow + (long)row * PITCH + ch * 8) = v; }
            } else {
                if ((lane_e & 31) == 0) {
#pragma unroll
                    for (int r = 0; r < 16; ++r) wsf[crow(r, hi)] = ol[r]; }
                int* dtab = (int*)wsf + 32;
                float* wt = (float*)(shm + LDS_WT) + wid * 128;
                asm volatile("s_waitcnt lgkmcnt(0)" ::: "memory");
                const size_t bhq = (size_t)(b * 8 + h_e) * S;
                if (MODE == 2) {
                    if (lane_e < 32) { const int slotr = (q0_e - q0) + lane_e; const int qq = (int)ql[slotr < nvalid ? slotr : 0];
                        int d = -1;
                        if (slotr < nvalid) { const unsigned smq = sel[bhq + qq]; d = (int)((bhq + qq) * 3) + __popc(smq & ((1u << qb) - 1u));
                            *(float2*)(mlp + (size_t)d * 2) = make_float2(mref, wsf[lane_e]); }
                        dtab[lane_e] = d; }
                    asm volatile("s_waitcnt lgkmcnt(0)" ::: "memory");
#pragma unroll
                    for (int i = 0; i < 4; ++i) { const int row = i * 8 + (lane_e >> 3), ch = lane_e & 7; const int d = dtab[row];
                        if (d >= 0) { const u32x4a v = *(const u32x4a*)(stg + row * 64 + ch * 8); *(u32x4a*)(opart + (size_t)d * 64 + ch * 8) = v; } }
                } else {
                    u32x4a pv[4][3];
#pragma unroll
                    for (int i = 0; i < 4; ++i) { const int row = i * 8 + (lane_e >> 3), ch = lane_e & 7; const bf16* pp = opart + ((bhq + q0_e + row) * 3) * 64 + ch * 8;
#pragma unroll
                        for (int k = 0; k < 3; ++k) pv[i][k] = *(const u32x4a*)(pp + k * 64); }
                    if (lane_e < 32) { const int ns = __popc(smq3);
                        const float md = mref, ld = wsf[lane_e];
                        float M = md;
#pragma unroll
                        for (int k = 0; k < 3; ++k) if (k < ns) M = fmaxf(M, ml3[k].x);
                        float wd = ld * __builtin_amdgcn_exp2f(md - M), wk[3], tot = wd;
#pragma unroll
                        for (int k = 0; k < 3; ++k) { wk[k] = (k < ns) ? ml3[k].y * __builtin_amdgcn_exp2f(ml3[k].x - M) : 0.f; tot += wk[k]; }
                        const float inv = 1.f / tot;
                        *(f32x4*)(wt + lane_e * 4) = (f32x4){wd * inv, wk[0] * inv, wk[1] * inv, wk[2] * inv}; }
                    asm volatile("s_waitcnt lgkmcnt(0)" ::: "memory");
                    bf16* Ow = Op + (rowbase + q0_e) * PITCH + h_e * 64;
#pragma unroll
                    for (int i = 0; i < 4; ++i) { const int row = i * 8 + (lane_e >> 3), ch = lane_e & 7;
                        const f32x4 a = *(const f32x4*)(wt + row * 4); const u32x4a v = *(const u32x4a*)(stg + row * 64 + ch * 8);
                        f32x4 x0 = pg8::bflo(v.x, v.y) * a[0], x1 = pg8::bflo(v.z, v.w) * a[0];
#pragma unroll
                        for (int k = 0; k < 3; ++k) { const bool on = a[1 + k] != 0.f; const f32x4 y0 = pg8::bflo(pv[i][k].x, pv[i][k].y) * a[1 + k], y1 = pg8::bflo(pv[i][k].z, pv[i][k].w) * a[1 + k];
#pragma unroll
                            for (int e = 0; e < 4; ++e) { x0[e] += on ? y0[e] : 0.f; x1[e] += on ? y1[e] : 0.f; } }
                        *(u32x4a*)(Ow + (long)row * PITCH + ch * 8) = pg8::pack8(x0, x1); }
                }
            }
        } else {
            float* scr = o1scr + (size_t)comp * 32768 + (size_t)wid * 4096 + lane_e;
#pragma unroll
            for (int d = 0; d < ND; ++d) { float* sp = scr + d * 1024; asm volatile("" : "+v"(sp));
#pragma unroll
                for (int r = 0; r < 16; ++r) sp[r * 64] = o[d][r] * rli[r]; }
            if (comp == 1) {
                asm volatile("s_waitcnt vmcnt(0)" ::: "memory");
                const int row = lane_e >> 1, hf = lane_e & 1;
                const int hi_r = (row >> 2) & 1, rr = (row & 3) | ((row >> 3) << 2);
                const float* A0 = o1scr + (size_t)wid * 4096 + rr * 64 + hi_r * 32 + hf * 2048;
                const float* B0 = A0 + 32768;
                f32x4 v[16]; float ssq = 0.f;
#pragma unroll
                for (int d2 = 0; d2 < 2; ++d2)
#pragma unroll
                    for (int c4 = 0; c4 < 8; ++c4) { const f32x4 a = __builtin_nontemporal_load((const f32x4*)(A0 + d2 * 1024 + c4 * 4)), bb = __builtin_nontemporal_load((const f32x4*)(B0 + d2 * 1024 + c4 * 4));
                        const f32x4 w = a - bb * lam; v[d2 * 8 + c4] = w; ssq += (w[0] * w[0] + w[1] * w[1]) + (w[2] * w[2] + w[3] * w[3]); }
                ssq += __shfl_xor(ssq, 1);
                const float rstd = rsqrtf(ssq * (1.f / 128.f) + EPS) * 0.8f;
                bf16* Ow = Op + (rowbase + q0_e + row) * PITCH + h_e * 128 + hf * 64;
#pragma unroll
                for (int k = 0; k < 8; ++k) { const f32x4 g0 = *(const f32x4*)(subg + hf * 64 + k * 8), g1 = *(const f32x4*)(subg + hf * 64 + k * 8 + 4);
                    *(u32x4a*)(Ow + k * 8) = pg8::pack8(v[2 * k] * g0 * rstd, v[2 * k + 1] * g1 * rstd); }
            }
        }
        if (RES) asm volatile("s_waitcnt lgkmcnt(0)" ::: "memory"); else
        asm volatile("s_waitcnt vmcnt(0) lgkmcnt(0)\n\ts_barrier" ::: "memory");
    }
#undef ATT_KR0
#undef ATT_DMA
}
__device__ __forceinline__ void moba_block_issue(const bf16* __restrict__ Kp, const bf16* __restrict__ Vp, const int b, const int h, const int blk, char* shm) {
    const int tid = threadIdx.x, lane = tid & 63; const int wid = __builtin_amdgcn_readfirstlane(tid >> 6);
    const unsigned lds0 = (unsigned)(uintptr_t)shm;
    const bf16* ksrc = Kp + ((long)b * S + 256 * blk + lane) * PITCH + h * 64 + wid * 8;
    const bf16* vsrc = Vp + ((long)b * S + 256 * blk + 16 * (wid & 3) + (lane >> 2)) * PITCH + h * 64 + (wid >> 2) * 32 + (lane & 3) * 8;
    asm volatile("s_waitcnt lgkmcnt(0)\n\ts_barrier" ::: "memory");
#pragma unroll
    for (int n = 0; n < 4; ++n) { glds16(ksrc + (long)(64 * n) * PITCH, (unsigned)__builtin_amdgcn_readfirstlane(lds0 + n * 8192 + wid * 1024));
        glds16(vsrc + (long)(64 * n) * PITCH, (unsigned)__builtin_amdgcn_readfirstlane(lds0 + RES_V + n * 8192 + wid * 1024)); }
}
}

__device__ __forceinline__ float wave_sum(float v) {
#pragma unroll
    for (int o = 1; o < 64; o <<= 1) v += __shfl_xor(v, o);
    return v;
}
__device__ __forceinline__ void gate_wave(int b, int h, int chunk, int lane, const bf16* __restrict__ Qm, const LAS float* ksl, unsigned* __restrict__ sel, unsigned* qcnt, unsigned short* qlist) {
    const int qpos = chunk * 64 + lane, blk = chunk >> 2;
    const size_t t = (size_t)b * S + qpos;
    float q[64];
#pragma unroll
    for (int d8 = 0; d8 < 8; ++d8) { const v4u v = *(const v4u*)(Qm + t * 512 + h * 64 + d8 * 8);
        q[d8 * 8] = __uint_as_float(v.x << 16); q[d8 * 8 + 1] = __uint_as_float(v.x & 0xffff0000u); q[d8 * 8 + 2] = __uint_as_float(v.y << 16); q[d8 * 8 + 3] = __uint_as_float(v.y & 0xffff0000u);
        q[d8 * 8 + 4] = __uint_as_float(v.z << 16); q[d8 * 8 + 5] = __uint_as_float(v.z & 0xffff0000u); q[d8 * 8 + 6] = __uint_as_float(v.w << 16); q[d8 * 8 + 7] = __uint_as_float(v.w & 0xffff0000u); }
    float v0 = -3e38f, v1 = -3e38f, v2 = -3e38f; int i0 = -1, i1 = -1, i2 = -1;
    for (int j = 0; j < blk; ++j) {
        const LAS f32x4* kr = (const LAS f32x4*)(ksl + j * 64);
        float g = 0.f;
#pragma unroll
        for (int d4 = 0; d4 < 16; ++d4) { const f32x4 kv = kr[d4]; g += q[4 * d4] * kv[0] + q[4 * d4 + 1] * kv[1] + q[4 * d4 + 2] * kv[2] + q[4 * d4 + 3] * kv[3]; }
        if (g > v0) { v2 = v1; i2 = i1; v1 = v0; i1 = i0; v0 = g; i0 = j; }
        else if (g > v1) { v2 = v1; i2 = i1; v1 = g; i1 = j; }
        else if (g > v2) { v2 = g; i2 = j; }
    }
    unsigned m = 0u;
    if (i0 >= 0) m |= 1u << i0;
    if (i1 >= 0) m |= 1u << i1;
    if (i2 >= 0) m |= 1u << i2;
    sel[(size_t)(b * 8 + h) * S + qpos] = m;
    if (qcnt) {
        const int bh = b * 8 + h;
        int myc = 0;
        for (int j = 0; j < blk; ++j) { const unsigned long long bal = __ballot((m >> j) & 1u); if (lane == j) myc = (int)__popcll(bal); }
        int mybase = 0; if (lane < blk && myc) mybase = (int)atomicAdd(qcnt + bh * 32 + lane, (unsigned)myc);
        for (int j = 0; j < blk; ++j) { const bool sj = (m >> j) & 1u; const unsigned long long bal = __ballot(sj); const int base = __shfl(mybase, j);
            if (sj) qlist[(size_t)bh * QL_PER_BH + 256 * (31 * j - (j * (j - 1)) / 2) + base + __popcll(bal & ((1ull << lane) - 1ull))] = (unsigned short)qpos; }
    }
}
constexpr int NWAVES = 8;
constexpr int RING_OFF = 0, RING_BYTES = 131072;
constexpr int LDSCTL_OFF = RING_BYTES, MISC_OFF = LDSCTL_OFF + 320;
constexpr int TBL_OFF = LDSCTL_OFF + 512;
constexpr int ROWTAB_OFF = LDSCTL_OFF + 2048;
static_assert(att::LDS_TOTAL <= RING_BYTES && pg8::STAGE_BYTES <= RING_BYTES, "phase scratch fits the ring region");
constexpr int LDS_BYTES = 147456;
constexpr int CW_BAR = 4096;

struct Frame {
    LAS unsigned char* lds;
    volatile LAS unsigned* MISC;
    gu32* ctl;
    int tid, lane, wave, vcu, G;
};
struct Args { const float* in[23]; float* out; unsigned char* ws; int ph_lo, ph_hi, li, pad; };

template <int MODE> __device__ __forceinline__ int wmap(int c) {
    if (MODE == 1) { const int pn = c >> 8; const bool rp = (pn < 4) || (pn >= 6 && pn < 10); if (!rp) return c; const int o = c & 255; return (pn << 8) + (((o >> 5) & 1) << 7) + ((o >> 6) << 5) + (o & 31); }
    if (MODE == 2) return ((c >> 7) << 8) + (c & 127);
    if (MODE == 3) return ((c >> 7) << 8) + 128 + (c & 127);
    return c;
}
struct TrItem { const float* W; bf16* WT; int K, N, mode, item; };
__device__ __forceinline__ void tr_load(const TrItem& it, int lane, f32x4 (&v)[8]) {
    const int nblk = it.N / 32, kb = it.item / nblk, nb = it.item % nblk;
    const float* p = it.W + (size_t)(64 * kb + (lane >> 3)) * it.N + 32 * nb + 4 * (lane & 7);
#pragma unroll
    for (int i = 0; i < 8; ++i) v[i] = *(const GAS f32x4*)(p + (size_t)(8 * i) * it.N);
}
__device__ __forceinline__ void tr_store(const TrItem& it, int lane, const f32x4 (&v)[8], LAS float* scr) {
    const int nblk = it.N / 32, kb = it.item / nblk, nb = it.item % nblk, k0 = 64 * kb, n0 = 32 * nb;
#pragma unroll
    for (int i = 0; i < 8; ++i) { LAS float* d = scr + (8 * i + (lane >> 3)) * 33 + 4 * (lane & 7); d[0] = v[i][0]; d[1] = v[i][1]; d[2] = v[i][2]; d[3] = v[i][3]; }
    LDS_WAIT(); asm volatile("" ::: "memory");
    const int c = lane & 7;
#pragma unroll
    for (int j = 0; j < 4; ++j) { const int n = (lane >> 3) + 8 * j; const LAS float* s = scr + (8 * c) * 33 + n;
        v4u o; o.x = pk2(s[0 * 33], s[1 * 33]); o.y = pk2(s[2 * 33], s[3 * 33]); o.z = pk2(s[4 * 33], s[5 * 33]); o.w = pk2(s[6 * 33], s[7 * 33]);
        const int cc = n0 + n; const int row = it.mode == 1 ? wmap<1>(cc) : (it.mode == 2 ? wmap<2>(cc) : (it.mode == 3 ? wmap<3>(cc) : cc));
        *(GAS v4u*)(it.WT + (size_t)row * it.K + k0 + 8 * c) = o; }
    LDS_WAIT(); asm volatile("" ::: "memory");
}
__device__ __forceinline__ float silu_f(float v) { return v / (1.f + __expf(-v)); }

__device__ __forceinline__ void p0_prologue(Frame& F, const Args& args) {
    unsigned char* ws = args.ws;
    const int gw = F.vcu * NWAVES + F.wave, NGW = F.G * NWAVES, gt = gw * 64 + F.lane, NGT = NGW * 64;
    { const float* c = args.in[1]; const float* w = args.in[2]; float* modp = (float*)(ws + WS_MODP);
      LAS float* act = (LAS float*)(F.lds + RING_OFF + F.wave * 16384);
      for (int task = gw; task < 768; task += NGW) { const int n = (task % 96) * 64 + F.lane, ks = task / 96;
#pragma unroll
          for (int i = 0; i < 8; ++i) { const int idx = F.lane + 64 * i, bb = idx >> 7, kk = idx & 127; act[idx] = silu_f(c[bb * 1024 + ks * 128 + kk]); }
          LDS_WAIT(); asm volatile("" ::: "memory");
          float a0 = 0.f, a1 = 0.f, a2 = 0.f, a3 = 0.f;
#pragma unroll 8
          for (int kk = 0; kk < 128; ++kk) { const float wv = w[(size_t)(ks * 128 + kk) * 6144 + n];
              a0 += act[kk] * wv; a1 += act[128 + kk] * wv; a2 += act[256 + kk] * wv; a3 += act[384 + kk] * wv; }
          modp[(size_t)(ks * 4 + 0) * 6144 + n] = a0; modp[(size_t)(ks * 4 + 1) * 6144 + n] = a1; modp[(size_t)(ks * 4 + 2) * 6144 + n] = a2; modp[(size_t)(ks * 4 + 3) * 6144 + n] = a3;
          LDS_WAIT(); asm volatile("" ::: "memory"); } }
    { float2* tab = (float2*)(ws + WS_ROPE);
      for (int idx = gt; idx < S * 32; idx += NGT) { const int pos = idx >> 5, i = idx & 31;
          const float e = (float)(2 * i) / 64.f; const float inv = 1.0f / powf(10000.f, e); const float ang = (float)pos * inv;
          const double a = (double)ang; const double TWO_PI = 6.283185307179586476925286766559;
          const double n = rint(a / TWO_PI); const double r = a - n * TWO_PI; const double r2 = r * r;
          double sn = 0.0, cs = 0.0, ts = r, tc = 1.0;
          for (int k = 0; k < 16; ++k) { cs += tc; sn += ts; tc *= -r2 / (double)((2 * k + 1) * (2 * k + 2)); ts *= -r2 / (double)((2 * k + 2) * (2 * k + 3)); }
          tab[idx] = make_float2((float)cs, (float)sn); } }
    if (gt == 0) { float s1 = 0.f, s2 = 0.f; for (int i = 0; i < 64; ++i) { s1 += args.in[6][i] * args.in[7][i]; s2 += args.in[8][i] * args.in[9][i]; }
        *(float*)(ws + WS_LAM) = expf(s1) - expf(s2) + 0.2f; }
    { bf16* wr = (bf16*)(ws + WS_WR); const float* wg = args.in[15]; const float* we = args.in[17];
      for (int idx = gt; idx < 32 * 3 * 64 * 8; idx += NGT) { const int s = idx & 7, ln = (idx >> 3) & 63, nt = (idx >> 9) % 3, uu = idx / 1536;
          const int k = 32 * uu + 8 * (ln >> 4) + s, col = 16 * nt + (ln & 15);
          const float w = col < 4 ? wg[k * 4 + col] : (col < 36 ? we[k * 32 + col - 4] : 0.f);
          const unsigned hi = f2bf(w); const float rem = w - __uint_as_float(hi << 16);
          wr[idx] = (bf16)hi; wr[49152 + idx] = (bf16)f2bf(rem); } }
    LAS float* scr = (LAS float*)(F.lds + RING_OFF + F.wave * 16384);
    constexpr int I_IN = 16 * 160, I_PM = 8 * 32, I_PD = 8 * 32, I_OUT = 16 * 32, I_G = 32 * 256, I_U = 32 * 256, I_D = 32 * 256;
    constexpr int NITEMS = I_IN + I_PM + I_PD + I_OUT + I_G + I_U + I_D;
    unsigned char* wsb = ws;
#define TR_DECODE(IT, OUT) do { int r = (IT); \
        if (r < I_IN) { OUT = TrItem{args.in[5], (bf16*)(wsb + WS_WIN), 1024, 5120, 1, r}; break; } r -= I_IN; \
        if (r < I_PM) { OUT = TrItem{args.in[11], (bf16*)(wsb + WS_WPM), 512, 1024, 0, r}; break; } r -= I_PM; \
        if (r < I_PD) { OUT = TrItem{args.in[12], (bf16*)(wsb + WS_WPD), 512, 1024, 0, r}; break; } r -= I_PD; \
        if (r < I_OUT) { OUT = TrItem{args.in[13], (bf16*)(wsb + WS_WOUT), 1024, 1024, 0, r}; break; } r -= I_OUT; \
        if (r < I_G) { const int e = r >> 8; OUT = TrItem{args.in[19] + (size_t)e * 1024 * 512, (bf16*)(wsb + WS_WGU) + (size_t)e * 1024 * 1024, 1024, 512, 2, r & 255}; break; } r -= I_G; \
        if (r < I_U) { const int e = r >> 8; OUT = TrItem{args.in[20] + (size_t)e * 1024 * 512, (bf16*)(wsb + WS_WGU) + (size_t)e * 1024 * 1024, 1024, 512, 3, r & 255}; break; } r -= I_U; \
        { const int e = r >> 8; OUT = TrItem{args.in[21] + (size_t)e * 512 * 1024, (bf16*)(wsb + WS_WD) + (size_t)e * 1024 * 512, 512, 1024, 0, r & 255}; } } while (0)
    if (gw < NITEMS) {
        TrItem cur; TR_DECODE(gw, cur);
        f32x4 va[8], vb[8];
        tr_load(cur, F.lane, va);
        for (int it = gw; it < NITEMS; it += 2 * NGW) {
            TrItem nx1 = cur; const bool h1 = it + NGW < NITEMS; if (h1) { TR_DECODE(it + NGW, nx1); tr_load(nx1, F.lane, vb); }
            tr_store(cur, F.lane, va, scr);
            if (!h1) break;
            TrItem nx2 = nx1; const bool h2 = it + 2 * NGW < NITEMS; if (h2) { TR_DECODE(it + 2 * NGW, nx2); tr_load(nx2, F.lane, va); }
            tr_store(nx1, F.lane, vb, scr);
            if (!h2) break;
            cur = nx2;
        }
    }
#undef TR_DECODE
}
__device__ __forceinline__ void p1_xn(Frame& F, const Args& args) {
    unsigned char* ws = args.ws;
    LAS float* tA = (LAS float*)(F.lds + RING_OFF); LAS float* tS = tA + 1024;
    const int w = blockIdx.x, b = (w * 128) / S;
    const float* modp = (const float*)(ws + WS_MODP); const float* b_ada = args.in[3]; const float* g1n = args.in[4];
    for (int d = F.tid; d < 1024; d += NWAVES * 64) { float sc = b_ada[1024 + d], sh = b_ada[d];
#pragma unroll
        for (int p = 0; p < 8; ++p) { sc += modp[(size_t)(p * 4 + b) * 6144 + 1024 + d]; sh += modp[(size_t)(p * 4 + b) * 6144 + d]; }
        tA[d] = g1n[d] * (1.f + sc); tS[d] = sh; }
    if (F.tid < 96) { const int idx = w * 96 + F.tid, bb = idx / 6144, n = idx % 6144; float v = b_ada[n];
#pragma unroll
        for (int p = 0; p < 8; ++p) v += modp[(size_t)(p * 4 + bb) * 6144 + n];
        ((float*)(ws + WS_MOD))[idx] = v; }
    __syncthreads();
    const float* x = args.in[0]; bf16* XN = (bf16*)(ws + WS_XN);
    for (int i = 0; i < 16; ++i) {
        const int row = w * 128 + F.wave * 16 + i;
        const GAS f32x4* xr = (const GAS f32x4*)(x + (size_t)row * 1024) + F.lane;
        f32x4 v[4]; float ss = 0.f;
#pragma unroll
        for (int j = 0; j < 4; ++j) { v[j] = xr[64 * j]; ss += (v[j].x * v[j].x + v[j].y * v[j].y) + (v[j].z * v[j].z + v[j].w * v[j].w); }
        const float rstd = rsqrtf(wave_sum(ss) * (1.f / 1024.f) + EPS);
        GAS unsigned long long* o8 = (GAS unsigned long long*)(XN + (size_t)row * 1024) + F.lane;
#pragma unroll
        for (int j = 0; j < 4; ++j) { const f32x4 a = ((const LAS f32x4*)tA)[F.lane + 64 * j], s = ((const LAS f32x4*)tS)[F.lane + 64 * j];
            const f32x4 o = v[j] * rstd * a + s;
            o8[64 * j] = (unsigned long long)pg8::cvt_pk_bf16(o.x, o.y) | ((unsigned long long)pg8::cvt_pk_bf16(o.z, o.w) << 32); }
    }
}

__device__ __forceinline__ void moe_tables(Frame& F, const Args& args) {
    LAS int* tbl = (LAS int*)(F.lds + TBL_OFF);
    if (F.tid == 0) { const gu32* gc = F.ctl + CW_CNT; int o = 0;
        for (int e = 0; e < 32; ++e) { const int c = (int)__hip_atomic_load(gc + e, RLX_AGENT); tbl[e] = o; tbl[40 + e] = c; o += (c + 255) >> 8; }
        tbl[32] = o; }
    __syncthreads();
}
__device__ __forceinline__ void p7_router(Frame& F, const Args& args) {
    unsigned char* ws = args.ws;
    typedef float f32x4v __attribute__((ext_vector_type(4)));
    LAS float* tA = (LAS float*)(F.lds + RING_OFF); LAS float* tS = tA + 1024;
    LAS float* lgs = (LAS float*)(F.lds + RING_OFF + 8192) + F.wave * (16 * 48);
    LAS int* cntl = (LAS int*)(F.lds + RING_OFF + 8192 + 8 * 16 * 48 * 4); LAS int* basel = cntl + 32;
    const int w = blockIdx.x, b = (w * 128) / S;
    const float* mod = (const float*)(ws + WS_MOD); const float* g2n = args.in[14];
    for (int d = F.tid; d < 1024; d += NWAVES * 64) { tA[d] = g2n[d] * (1.f + mod[b * 6144 + 4096 + d]); tS[d] = mod[b * 6144 + 3072 + d]; }
    if (F.tid < 32) cntl[F.tid] = 0;
    __syncthreads();
    const int i16 = F.lane & 15, q = F.lane >> 4;
    const int row = w * 128 + F.wave * 16 + i16;
    const float* x1 = args.out; bf16* h2 = (bf16*)(ws + WS_XN); const bf16* wr = (const bf16*)(ws + WS_WR);
    float rstd;
    { const f32x4v* rp = (const f32x4v*)((const float*)(ws + WS_ROWSQ) + (size_t)row * 16); const f32x4v a = rp[0], c = rp[1], d = rp[2], e = rp[3];
      const float ss = ((a[0] + a[1]) + (a[2] + a[3])) + ((c[0] + c[1]) + (c[2] + c[3])) + ((d[0] + d[1]) + (d[2] + d[3])) + ((e[0] + e[1]) + (e[2] + e[3]));
      rstd = rsqrtf(ss * (1.f / 1024.f) + EPS); }
    f32x4v acc[3];
#pragma unroll
    for (int nt = 0; nt < 3; ++nt) acc[nt] = (f32x4v){0.f, 0.f, 0.f, 0.f};
    const float* xr = x1 + (size_t)row * 1024 + 8 * q;
    bf16* hr = h2 + (size_t)row * 1024 + 8 * q;
#pragma unroll 4
    for (int uu = 0; uu < 32; ++uu) {
        const f32x4v xa = *(const f32x4v*)(xr + 32 * uu), xb = *(const f32x4v*)(xr + 32 * uu + 4);
        const f32x4v aa = *(const LAS f32x4v*)(tA + 32 * uu + 8 * q), ab = *(const LAS f32x4v*)(tA + 32 * uu + 8 * q + 4);
        const f32x4v sa = *(const LAS f32x4v*)(tS + 32 * uu + 8 * q), sb = *(const LAS f32x4v*)(tS + 32 * uu + 8 * q + 4);
        const f32x4v ha = xa * rstd * aa + sa, hb = xb * rstd * ab + sb;
        const pg8::u32x4 hh = pg8::pack8(ha, hb);
        *(pg8::u32x4*)(hr + 32 * uu) = hh;
        const pg8::u32x4 hl = pg8::pack8(ha - pg8::bflo(hh.x, hh.y), hb - pg8::bflo(hh.z, hh.w));
        const bf16x8 ahi = __builtin_bit_cast(bf16x8, hh), alo = __builtin_bit_cast(bf16x8, hl);
#pragma unroll
        for (int nt = 0; nt < 3; ++nt) { const size_t bo = ((size_t)(uu * 3 + nt) * 64 + F.lane) * 8;
            const bf16x8 bhi = *(const bf16x8*)(wr + bo), blo = *(const bf16x8*)(wr + 49152 + bo);
            acc[nt] = __builtin_amdgcn_mfma_f32_16x16x32_bf16(ahi, bhi, acc[nt], 0, 0, 0);
            acc[nt] = __builtin_amdgcn_mfma_f32_16x16x32_bf16(alo, bhi, acc[nt], 0, 0, 0);
            acc[nt] = __builtin_amdgcn_mfma_f32_16x16x32_bf16(ahi, blo, acc[nt], 0, 0, 0); }
    }
#pragma unroll
    for (int nt = 0; nt < 3; ++nt)
#pragma unroll
        for (int r = 0; r < 4; ++r) lgs[(4 * q + r) * 48 + 16 * nt + i16] = acc[nt][r];
    LDS_WAIT(); asm volatile("" ::: "memory");
    int e0 = 0, e1 = 0, p0l = 0, p1l = 0; float w0 = 0.f, w1 = 0.f;
    if (F.lane < 16) {
        const LAS float* lr = lgs + F.lane * 48; const float* bg = args.in[16]; const float* be = args.in[18];
        float gl[4]; float gmx = -3e38f; int gi = 0;
#pragma unroll
        for (int i = 0; i < 4; ++i) { gl[i] = lr[i] + bg[i]; if (gl[i] > gmx) { gmx = gl[i]; gi = i; } }
        float gs = 0.f;
#pragma unroll
        for (int i = 0; i < 4; ++i) gs += expf(gl[i] - gmx);
        const float gw = 1.f / gs;
        float el[8]; float emx = -3e38f;
#pragma unroll
        for (int i = 0; i < 8; ++i) { el[i] = lr[4 + gi * 8 + i] + be[gi * 8 + i]; emx = fmaxf(emx, el[i]); }
        float es = 0.f, ep[8];
#pragma unroll
        for (int i = 0; i < 8; ++i) { ep[i] = expf(el[i] - emx); es += ep[i]; }
        int a0 = 0; float pa = -1.f;
#pragma unroll
        for (int i = 0; i < 8; ++i) if (ep[i] > pa) { pa = ep[i]; a0 = i; }
        int a1 = 0; float pb = -1.f;
#pragma unroll
        for (int i = 0; i < 8; ++i) if (i != a0 && ep[i] > pb) { pb = ep[i]; a1 = i; }
        pa /= es; pb /= es; const float sw = pa + pb;
        e0 = gi * 8 + a0; e1 = gi * 8 + a1; w0 = gw * (pa / sw); w1 = gw * (pb / sw);
        p0l = __hip_atomic_fetch_add(cntl + e0, 1, __ATOMIC_RELAXED, __HIP_MEMORY_SCOPE_WORKGROUP);
        p1l = __hip_atomic_fetch_add(cntl + e1, 1, __ATOMIC_RELAXED, __HIP_MEMORY_SCOPE_WORKGROUP);
    }
    __syncthreads();
    if (F.tid < 32) { const int c = cntl[F.tid]; basel[F.tid] = c ? (int)__hip_atomic_fetch_add(F.ctl + CW_CNT + F.tid, (unsigned)c, RLX_AGENT) : 0; }
    __syncthreads();
    if (F.lane < 16) {
        const int t = w * 128 + F.wave * 16 + F.lane;
        int* list = (int*)(ws + WS_LIST); int* toki = (int*)(ws + WS_TOKI); float* tokw = (float*)(ws + WS_TOKW);
        const int q0 = basel[e0] + p0l, q1 = basel[e1] + p1l;
        list[(size_t)e0 * T + q0] = t * 2; list[(size_t)e1 * T + q1] = t * 2 + 1;
        toki[t * 2] = (e0 << 20) | q0; toki[t * 2 + 1] = (e1 << 20) | q1; tokw[t * 2] = w0; tokw[t * 2 + 1] = w1;
    }
}
__device__ __forceinline__ void p10_final(Frame& F, const Args& args) {
    unsigned char* ws = args.ws;
    const LAS int* tbl = (const LAS int*)(F.lds + TBL_OFF);
    const int w = blockIdx.x, b = (w * 128) / S;
    const float* g2 = (const float*)(ws + WS_MOD) + (size_t)b * 6144 + 5120; const float* fg = args.in[22];
    const bf16* Yb = (const bf16*)(ws + WS_YB); const int* toki = (const int*)(ws + WS_TOKI);
    float* out = args.out;
    const int trow0 = w * 128 + F.wave * 16;
    size_t rall_a = 0, rall_b = 0;
    if (F.lane < 16) { const int i0 = toki[(trow0 + F.lane) * 2], i1 = toki[(trow0 + F.lane) * 2 + 1];
        rall_a = (size_t)(tbl[i0 >> 20] * 256 + (i0 & 0xfffff)); rall_b = (size_t)(tbl[i1 >> 20] * 256 + (i1 & 0xfffff)); }
    f32x4 xn[4]; uint2 yan[4], ybn[4];
#define P10_LOAD(i) do { const int t_ = trow0 + (i); const size_t ra_ = (size_t)__shfl((unsigned long long)rall_a, (i)), rb_ = (size_t)__shfl((unsigned long long)rall_b, (i)); \
        _Pragma("unroll") for (int j = 0; j < 4; ++j) { const int d0 = (F.lane + 64 * j) * 4; xn[j] = *(const f32x4*)(out + (size_t)t_ * 1024 + d0); yan[j] = *(const uint2*)(Yb + ra_ * 1024 + d0); ybn[j] = *(const uint2*)(Yb + rb_ * 1024 + d0); } } while (0)
    P10_LOAD(0);
    for (int i = 0; i < 16; ++i) {
        const int t = trow0 + i;
        f32x4 v[4]; float ss = 0.f;
#pragma unroll
        for (int j = 0; j < 4; ++j) { const int d0 = (F.lane + 64 * j) * 4; const f32x4 g = *(const f32x4*)(g2 + d0);
            v[j] = xn[j] + g * (pg8::bflo(yan[j].x, yan[j].y) + pg8::bflo(ybn[j].x, ybn[j].y));
            ss += (v[j].x * v[j].x + v[j].y * v[j].y) + (v[j].z * v[j].z + v[j].w * v[j].w); }
        if (i + 1 < 16) P10_LOAD(i + 1);
        const float rstd = rsqrtf(wave_sum(ss) * (1.f / 1024.f) + EPS);
#pragma unroll
        for (int j = 0; j < 4; ++j) { const int d0 = (F.lane + 64 * j) * 4; const f32x4 g = *(const f32x4*)(fg + d0); *(f32x4*)(out + (size_t)t * 1024 + d0) = v[j] * rstd * g; }
    }
#undef P10_LOAD
}

__global__ void __launch_bounds__(NWAVES * 64, 2) fwd(Args args) {
    extern __shared__ __attribute__((aligned(16))) unsigned char lds[];
    Frame F;
    F.lds = (LAS unsigned char*)lds;
    F.MISC = (volatile LAS unsigned*)(F.lds + MISC_OFF);
    F.tid = threadIdx.x; F.lane = F.tid & 63; F.wave = __builtin_amdgcn_readfirstlane(F.tid >> 6);
    F.G = gridDim.x; { const int bx = blockIdx.x; F.vcu = (F.G % 8 == 0) ? (bx % 8) * (F.G / 8) + bx / 8 : bx; }
    unsigned char* ws = args.ws;
    F.ctl = (gu32*)(ws + WS_CTL);
    for (int u = F.tid; u < (LDS_BYTES - LDSCTL_OFF) / 4; u += NWAVES * 64) ((LAS unsigned*)(F.lds + LDSCTL_OFF))[u] = 0u;
    __syncthreads();
    XcdBarrier bar = xcd_barrier_post((unsigned*)(F.ctl + CW_BAR) + args.li * XCD_BAR_WORDS, F.MISC + 8);
    const int lo = args.ph_lo, hi = args.ph_hi;
#define IN(k) (lo <= (k) && (k) < hi)
#define BOTH(k) (IN(k) && IN((k) + 1))
#define GRID_BAR() xcd_barrier(bar)

    if (IN(0)) { p0_prologue(F, args); if (BOTH(0)) GRID_BAR(); }
    if (IN(1)) { p1_xn(F, args); if (BOTH(1)) GRID_BAR(); }
    if (IN(2)) {
        __syncthreads();
        pg8::Gemm g{(const bf16*)(ws + WS_XN), (const bf16*)(ws + WS_WIN), 1024}; pg8::StaticOrder So; So.init(T, INW, F.G, (int)blockIdx.x);
        pg8::EpiInProj E{(bf16*)(ws + WS_QM), (bf16*)(ws + WS_GM), (float*)(ws + WS_KSUM), (const float*)(ws + WS_ROPE), T, S, C2};
        pg8::gemm_phase<pg8::EpiInProj, pg8::StaticOrder, true, true>(F.lds + RING_OFF, g, So, E);
        if (BOTH(2)) GRID_BAR();
    }
    if (IN(3)) {
        __syncthreads();
        const int bh = F.vcu >> 3, part = F.vcu & 7;
        LAS float* ksl = (LAS float*)(F.lds + RING_OFF);
        { const float* ks = (const float*)(ws + WS_KSUM);
          for (int i = F.tid; i < 32 * 64; i += NWAVES * 64) { const int j = i >> 6, d = i & 63; const size_t o = ((size_t)((bh >> 3) * 32 + j)) * 512 + (bh & 7) * 64 + d; ksl[i] = ks[o] + ks[128 * 512 + o]; } }
        __syncthreads();
#pragma unroll 1
        for (int hf = 0; hf < 2; ++hf) { const int cc = part * 8 + F.wave, chunk = hf ? 127 - cc : cc;
            gate_wave(bh >> 3, bh & 7, chunk, F.lane, (const bf16*)(ws + WS_QM), ksl, (unsigned*)(ws + WS_SEL), (unsigned*)(F.ctl + CW_QCNT), (unsigned short*)((char*)args.out + DO_QLIST)); }
        if (BOTH(3)) GRID_BAR();
    }
    if (IN(4)) {
        __syncthreads();
        const float lam = *(const float*)(ws + WS_LAM);
        float* o1scr = (float*)(ws + WS_XN) + (size_t)blockIdx.x * 65536;
        bf16* opart = (bf16*)args.out; float* mlp = (float*)((char*)args.out + DO_MLP); const unsigned short* qlist = (const unsigned short*)((char*)args.out + DO_QLIST);
        LAS int* pre = (LAS int*)(F.lds + ROWTAB_OFF); LAS int* tot = pre + 1040;
        if (F.tid < 32) { int run = 0; for (int j = 0; j < 32; ++j) { pre[F.tid * 32 + j] = run; run += ((int)__hip_atomic_load(F.ctl + CW_QCNT + F.tid * 32 + j, RLX_AGENT) + 511) >> 9; } tot[F.tid] = run; }
        __syncthreads();
        if (F.tid == 0) { int run = 0; for (int i = 0; i < 32; ++i) { const int c = tot[i]; tot[i] = run; run += c; } tot[32] = run; }
        __syncthreads();
        for (int e = F.tid; e < 1024; e += NWAVES * 64) pre[e] += tot[e >> 5];
        if (F.tid == 0) pre[1024] = tot[32];
        __syncthreads();
        const int nitems = pre[1024];
        { const int u = F.vcu, bh = u >> 4, s = u & 15;
#pragma unroll 1
          for (int kk = 0; kk < 2; ++kk) att::attn_unit<128, 1>(bh >> 2, bh & 3, (kk & 1) ? s : 31 - s, (const bf16*)(ws + WS_QD), (const bf16*)(ws + WS_KD), (const bf16*)(ws + WS_VD), (bf16*)(ws + WS_QD),
                                                                   nullptr, o1scr, lam, args.in[10], (char*)lds + RING_OFF); }
        __syncthreads();
        LAS int* claim = pre + 1100;
        if (F.tid == 0) claim[0] = (int)__hip_atomic_fetch_add(F.ctl + CW_ITEM, 1u, RLX_AGENT);
        __syncthreads();
        int I = claim[0], par = 0;
#pragma unroll 1
        while (I < nitems) {
            int nxt = 0; if (F.tid == 0) nxt = (int)__hip_atomic_fetch_add(F.ctl + CW_ITEM, 1u, RLX_AGENT);
            int lo_ = 0, hi_ = 1024;
            while (hi_ - lo_ > 1) { const int mid = (lo_ + hi_) >> 1; if (pre[mid] <= I) lo_ = mid; else hi_ = mid; }
            const int e = lo_, bh = e >> 5, j = e & 31, c = I - pre[e];
            const int cnt = (int)__hip_atomic_load(F.ctl + CW_QCNT + e, RLX_AGENT); int nv = cnt - 512 * c; nv = nv > 512 ? 512 : nv;
            att::moba_block_issue((const bf16*)(ws + WS_KM), (const bf16*)(ws + WS_VM), bh >> 3, bh & 7, j, (char*)lds + RING_OFF);
            const unsigned short* ql = qlist + (size_t)bh * QL_PER_BH + 256 * (31 * j - (j * (j - 1)) / 2) + 512 * c;
            if (F.wave * 32 >= nv) asm volatile("s_waitcnt vmcnt(0)\n\ts_barrier" ::: "memory");
#pragma unroll 1
            for (int g = F.wave; g * 32 < nv; g += NWAVES)
                att::attn_unit<64, 2, true>(bh >> 3, bh & 7, j, (const bf16*)(ws + WS_QM), (const bf16*)(ws + WS_KM), (const bf16*)(ws + WS_VM), nullptr, (const unsigned*)(ws + WS_SEL), nullptr, 0.f, nullptr,
                                            (char*)lds + RING_OFF, ql + g * 32, nv - g * 32 < 32 ? nv - g * 32 : 32, opart, mlp, g == F.wave);
            par ^= 1; if (F.tid == 0) claim[par] = nxt;
            __syncthreads();
            I = claim[par];
        }
        GRID_BAR();
#pragma unroll 1
        for (int k = 0; k < 4; ++k) { const int u = F.vcu * 4 + k, bh = u >> 5, qb = u & 31;
            att::moba_block_issue((const bf16*)(ws + WS_KM), (const bf16*)(ws + WS_VM), bh >> 3, bh & 7, qb, (char*)lds + RING_OFF);
            att::attn_unit<64, 3, true>(bh >> 3, bh & 7, qb, (const bf16*)(ws + WS_QM), (const bf16*)(ws + WS_KM), (const bf16*)(ws + WS_VM), (bf16*)(ws + WS_QM), (const unsigned*)(ws + WS_SEL), nullptr, 0.f, nullptr,
                                        (char*)lds + RING_OFF, nullptr, 0, opart, mlp, true); }
        __syncthreads();
        if (BOTH(4)) GRID_BAR();
    }
    if (IN(5)) {
        __syncthreads();
        pg8::StaticOrder So; So.init(T, 1024, F.G, (int)blockIdx.x);
        { pg8::Gemm g{(const bf16*)(ws + WS_QM), (const bf16*)(ws + WS_WPM), 512}; pg8::EpiGate<0> E{(const bf16*)(ws + WS_GM), (bf16*)(ws + WS_MERGED)};
          pg8::gemm_phase<pg8::EpiGate<0>, pg8::StaticOrder, true, true>(F.lds + RING_OFF, g, So, E); }
        __syncthreads();
        { pg8::Gemm g{(const bf16*)(ws + WS_QD), (const bf16*)(ws + WS_WPD), 512}; pg8::EpiGate<1> E{(const bf16*)(ws + WS_GD), (bf16*)(ws + WS_MERGED)};
          pg8::gemm_phase<pg8::EpiGate<1>, pg8::StaticOrder, true, true>(F.lds + RING_OFF, g, So, E); }
        if (BOTH(5)) GRID_BAR();
    }
    if (IN(6)) {
        __syncthreads();
        pg8::StaticOrder So; So.init(T, 1024, F.G, (int)blockIdx.x);
        pg8::Gemm g{(const bf16*)(ws + WS_MERGED), (const bf16*)(ws + WS_WOUT), 1024};
        pg8::EpiResid E{args.in[0], (const float*)(ws + WS_MOD) + 2048, args.out, (float*)(ws + WS_ROWSQ), S};
        pg8::gemm_phase<pg8::EpiResid, pg8::StaticOrder, true, true>(F.lds + RING_OFF, g, So, E);
        if (BOTH(6)) GRID_BAR();
    }
    if (IN(7)) { __syncthreads(); p7_router(F, args); if (BOTH(7)) GRID_BAR(); }
    if (IN(8)) {
        __syncthreads(); moe_tables(F, args);
        const LAS int* tbl = (const LAS int*)(F.lds + TBL_OFF); LAS int* rowtab = (LAS int*)(F.lds + ROWTAB_OFF);
        pg8::MoeOrder Mo{tbl, rowtab, tbl[32], 4, F.G, F.vcu, 1024, true};
        { pg8::Unit u; const int* list = (const int*)(ws + WS_LIST);
          for (int ui = 0; ui < 8 && Mo.next(ui, u); ++ui)
              for (int r = F.tid; r < 256; r += NWAVES * 64) { const int rr = r < u.cnt ? r : u.cnt - 1; rowtab[ui * 256 + r] = list[(size_t)u.e * T + u.lo + rr] >> 1; } }
        __syncthreads();
        pg8::Gemm g{(const bf16*)(ws + WS_XN), (const bf16*)(ws + WS_WGU), 1024};
        pg8::EpiMoeHid E{(bf16*)(ws + WS_HID)};
        pg8::gemm_phase<pg8::EpiMoeHid, pg8::MoeOrder, true, true>(F.lds + RING_OFF, g, Mo, E);
        if (BOTH(8)) GRID_BAR();
    }
    if (IN(9)) {
        __syncthreads(); moe_tables(F, args);
        const LAS int* tbl = (const LAS int*)(F.lds + TBL_OFF);
        pg8::MoeOrder Mo{tbl, nullptr, tbl[32], 4, F.G, F.vcu, 1024, false};
        LAS float* wtab = (LAS float*)(F.lds + ROWTAB_OFF);
        { pg8::Unit u; const int* list = (const int*)(ws + WS_LIST); const float* tokw = (const float*)(ws + WS_TOKW);
          for (int ui = 0; ui < 8 && Mo.next(ui, u); ++ui)
              for (int r = F.tid; r < 256; r += NWAVES * 64) wtab[ui * 256 + r] = r < u.cnt ? tokw[list[(size_t)u.e * T + u.lo + r]] : 0.f; }
        __syncthreads();
        pg8::Gemm g{(const bf16*)(ws + WS_HID), (const bf16*)(ws + WS_WD), 512};
        pg8::EpiMoeDown E{(bf16*)(ws + WS_YB), wtab};
        pg8::gemm_phase<pg8::EpiMoeDown, pg8::MoeOrder, true, true>(F.lds + RING_OFF, g, Mo, E);
        if (BOTH(9)) GRID_BAR();
    }
    if (IN(10)) { __syncthreads(); moe_tables(F, args); p10_final(F, args); }
#undef IN
#undef BOTH
}
}


extern "C" void kernel_launch(void* const* d_in, const int* in_sizes, int n_in, void* d_out, int out_size, void* d_ws, size_t ws_size, hipStream_t stream) {
    char* ws = (char*)d_ws; float* out = (float*)d_out;
    static int grid = 0;
    if (grid == 0) {
        int dev = 0, cus = 0, per_cu = 0;
        if (hipGetDevice(&dev) != hipSuccess || hipDeviceGetAttribute(&cus, hipDeviceAttributeMultiprocessorCount, dev) != hipSuccess) { fprintf(stderr, "kernel_launch: device query failed\n"); grid = -1; return; }
        if (hipFuncSetAttribute((const void*)fwd, hipFuncAttributeMaxDynamicSharedMemorySize, LDS_BYTES) != hipSuccess) { fprintf(stderr, "kernel_launch: hipFuncSetAttribute failed\n"); grid = -1; return; }
        if (hipOccupancyMaxActiveBlocksPerMultiprocessor(&per_cu, (const void*)fwd, NWAVES * 64, LDS_BYTES) != hipSuccess || per_cu < 1) fprintf(stderr, "kernel_launch: occupancy query reports %d\n", per_cu);
        (void)hipGetLastError();
        grid = cus < 256 ? cus : 256;
        if (ws_size < 512 * MiB || n_in != 23 || out_size != T * D) { fprintf(stderr, "kernel_launch: built for 23 inputs, %d outputs and >= 512 MiB of workspace\n", T * D); grid = -1; return; }
    }
    if (grid < 0) return;
    (void)hipMemsetAsync(ws + WS_CTL, 0, 64 * 1024, stream);
    Args a{};
    for (int i = 0; i < 23; ++i) a.in[i] = (const float*)d_in[i];
    a.out = out; a.ws = (unsigned char*)d_ws;
    a.ph_lo = 0; a.ph_hi = 11; a.li = 0; a.pad = 0;
    hipLaunchKernelGGL(fwd, dim3(grid), dim3(NWAVES * 64), LDS_BYTES, stream, a);
}
```
